# Optimizing an MI355X kernel written in HIP

```python
import jax, jax.numpy as jnp
from jax import lax
import numpy as np

D_MODEL = 1024
BATCH = 2
SEQ = 16384
DEPTH = 2

N_MIXERS = 2
N_META = 16
CHUNK = 64
FRONT_PAD = CHUNK - N_META
MLSTM_HEADS = 4
MLSTM_DQK = 128
MLSTM_DV = 256
GLA_HEADS = 4
GLA_DK = 128
GLA_DV = 256
GLA_GATE_RANK = 16
GLA_TAU = 16.0
N_GROUPS = 4
EXPERTS_PER_GROUP = 8
N_EXPERTS = N_GROUPS * EXPERTS_PER_GROUP
TOP_K = 2
D_EXPERT = 512
MOE_BLOCK = 128
DEEPNORM_ALPHA = (2.0 * DEPTH) ** 0.25
DEEPNORM_BETA = (8.0 * DEPTH) ** -0.25
LN_EPS = 1e-5
NEG = -1e30

kernel_name = "hybrid_mlstm_gla_hier_moe_deepnorm"


def layer_norm(x, g, b):
    xf = x.astype(jnp.float32)
    mu = xf.mean(-1, keepdims=True)
    var = jnp.mean(jnp.square(xf - mu), -1, keepdims=True)
    return ((xf - mu) * lax.rsqrt(var + LN_EPS) * g.astype(jnp.float32) + b.astype(jnp.float32)).astype(x.dtype)


def to_chunks(t, pad_value):
    t = jnp.pad(t, ((0, 0), (FRONT_PAD, 0), (0, 0), (0, 0)), constant_values=pad_value)
    b, lp, h, d = t.shape
    return t.reshape(b, lp // CHUNK, CHUNK, h, d).transpose(1, 0, 3, 2, 4)


def from_chunks(y):
    n, b, h, c, d = y.shape
    return y.transpose(1, 0, 3, 2, 4).reshape(b, n * c, h, d)[:, FRONT_PAD:]


def mlstm_mixer(x, w_in, b_gates, head_norm_w, w_out):
    bsz, length, _ = x.shape
    H, dqk, dv = MLSTM_HEADS, MLSTM_DQK, MLSTM_DV
    qk_w, v_w = H * dqk, H * dv
    proj = x @ w_in
    q = proj[..., :qk_w].reshape(bsz, length, H, dqk).astype(jnp.float32) * (dqk ** -0.5)
    k = proj[..., qk_w:2 * qk_w].reshape(bsz, length, H, dqk).astype(jnp.float32)
    v = proj[..., 2 * qk_w:2 * qk_w + v_w].reshape(bsz, length, H, dv).astype(jnp.float32)
    o_pre = proj[..., 2 * qk_w + v_w:2 * qk_w + 2 * v_w].astype(jnp.float32)
    gates = proj[..., 2 * qk_w + 2 * v_w:].astype(jnp.float32) + b_gates.astype(jnp.float32)
    log_i = gates[..., :H]
    log_f = jax.nn.log_sigmoid(gates[..., H:])
    xs = (to_chunks(q, 0.0), to_chunks(k, 0.0), to_chunks(v, 0.0),
          to_chunks(log_i[..., None], NEG)[..., 0], to_chunks(log_f[..., None], 0.0)[..., 0])
    causal = jnp.tril(jnp.ones((CHUNK, CHUNK), bool))

    def step(carry, inp):
        C, n, m = carry
        qc, kc, vc, li, lf = inp
        b = jnp.cumsum(lf, axis=-1)
        d_mat = jnp.where(causal, b[..., :, None] - b[..., None, :] + li[..., None, :], NEG)
        g = b + m[..., None]
        m_t = jnp.maximum(g, d_mat.max(-1))
        w_intra = jnp.exp(d_mat - m_t[..., None])
        w_inter = jnp.exp(g - m_t)
        s = jnp.einsum('bhtd,bhsd->bhts', qc, kc) * w_intra
        num = jnp.einsum('bhts,bhsv->bhtv', s, vc) + w_inter[..., None] * jnp.einsum('bhtd,bhdv->bhtv', qc, C)
        den = s.sum(-1) + w_inter * jnp.einsum('bhtd,bhd->bht', qc, n)
        h = num / jnp.maximum(jnp.abs(den), jnp.exp(-m_t))[..., None]
        b_last = b[..., -1]
        decay_s = b_last[..., None] - b + li
        m_new = jnp.maximum(b_last + m, decay_s.max(-1))
        w_s = jnp.exp(decay_s - m_new[..., None])
        w_prev = jnp.exp(b_last + m - m_new)
        C_new = w_prev[..., None, None] * C + jnp.einsum('bhs,bhsd,bhsv->bhdv', w_s, kc, vc)
        n_new = w_prev[..., None] * n + jnp.einsum('bhs,bhsd->bhd', w_s, kc)
        return (C_new, n_new, m_new), h

    init = (jnp.zeros((bsz, H, dqk, dv), jnp.float32), jnp.zeros((bsz, H, dqk), jnp.float32),
            jnp.zeros((bsz, H), jnp.float32))
    _, hc = lax.scan(step, init, xs)
    hs = from_chunks(hc)
    mu = hs.mean(-1, keepdims=True)
    var = jnp.mean(jnp.square(hs - mu), -1, keepdims=True)
    hs = ((hs - mu) * lax.rsqrt(var + LN_EPS)).reshape(bsz, length, v_w) * head_norm_w.astype(jnp.float32)
    out = (hs * jax.nn.sigmoid(o_pre)).astype(x.dtype)
    return out @ w_out


def gla_mixer(x, w_in, w_gate_up, b_gate, head_norm_w, w_out):
    bsz, length, _ = x.shape
    H, dk, dv = GLA_HEADS, GLA_DK, GLA_DV
    k_w, v_w = H * dk, H * dv
    proj = x @ w_in
    q = proj[..., :k_w].reshape(bsz, length, H, dk).astype(jnp.float32) * (dk ** -0.5)
    k = proj[..., k_w:2 * k_w].reshape(bsz, length, H, dk).astype(jnp.float32)
    v = proj[..., 2 * k_w:2 * k_w + v_w].reshape(bsz, length, H, dv).astype(jnp.float32)
    r = proj[..., 2 * k_w + v_w:2 * k_w + 2 * v_w].astype(jnp.float32)
    glr = proj[..., 2 * k_w + 2 * v_w:].astype(jnp.float32)
    log_a = jax.nn.log_sigmoid(glr @ w_gate_up.astype(jnp.float32) + b_gate.astype(jnp.float32)) / GLA_TAU
    log_a = log_a.reshape(bsz, length, H, dk)
    xs = (to_chunks(q, 0.0), to_chunks(k, 0.0), to_chunks(v, 0.0), to_chunks(log_a, 0.0))
    causal = jnp.tril(jnp.ones((CHUNK, CHUNK), bool))

    def step(S, inp):
        qc, kc, vc, la = inp
        bc = jnp.cumsum(la, axis=2)
        diff = bc[:, :, :, None, :] - bc[:, :, None, :, :]
        decay = jnp.exp(jnp.where(causal[:, :, None], diff, NEG))
        attn = jnp.einsum('bhtd,bhsd,bhtsd->bhts', qc, kc, decay)
        o = jnp.einsum('bhts,bhsv->bhtv', attn, vc) + jnp.einsum('bhtd,bhdv->bhtv', qc * jnp.exp(bc), S)
        b_last = bc[:, :, -1]
        k_dec = kc * jnp.exp(b_last[:, :, None] - bc)
        S_new = jnp.exp(b_last)[..., None] * S + jnp.einsum('bhsd,bhsv->bhdv', k_dec, vc)
        return S_new, o

    _, oc = lax.scan(step, jnp.zeros((bsz, H, dk, dv), jnp.float32), xs)
    o = from_chunks(oc)
    o = o * lax.rsqrt(jnp.mean(jnp.square(o), -1, keepdims=True) + LN_EPS)
    o = o.reshape(bsz, length, v_w) * head_norm_w.astype(jnp.float32)
    out = (o * jax.nn.silu(r)).astype(x.dtype)
    return out @ w_out


def hier_moe(x, w_group, b_group, w_router, b_router, w_gate, w_up, w_down):
    bsz, length, D = x.shape
    T = bsz * length
    xf = x.reshape(T, D)
    grp_logits = (xf @ w_group).astype(jnp.float32) + b_group.astype(jnp.float32)
    grp_prob = jax.nn.softmax(grp_logits, axis=-1)
    g_top = jnp.argmax(grp_logits, axis=-1).astype(jnp.int32)
    p_g = jnp.take_along_axis(grp_prob, g_top[:, None], axis=1)[:, 0]
    exp_logits = ((xf @ w_router).astype(jnp.float32) + b_router.astype(jnp.float32)).reshape(T, N_GROUPS, EXPERTS_PER_GROUP)
    idx = jnp.broadcast_to(g_top[:, None, None], (T, 1, EXPERTS_PER_GROUP))
    within = jnp.take_along_axis(exp_logits, idx, axis=1)[:, 0]
    top_vals, top_idx = lax.top_k(within, TOP_K)
    weights = p_g[:, None] * jax.nn.softmax(top_vals, axis=-1)
    expert_ids = g_top[:, None] * EXPERTS_PER_GROUP + top_idx.astype(jnp.int32)
    A = T * TOP_K
    flat_e = expert_ids.reshape(A)
    flat_tok = jnp.repeat(jnp.arange(T, dtype=jnp.int32), TOP_K)
    flat_w = weights.reshape(A)
    order = jnp.argsort(flat_e)
    se, stok, sw = flat_e[order], flat_tok[order], flat_w[order]
    counts = jnp.bincount(flat_e, length=N_EXPERTS).astype(jnp.int32)
    starts = jnp.cumsum(counts) - counts
    pcounts = ((counts + MOE_BLOCK - 1) // MOE_BLOCK) * MOE_BLOCK
    pends = jnp.cumsum(pcounts)
    pstarts = pends - pcounts
    dest = pstarts[se] + jnp.arange(A, dtype=jnp.int32) - starts[se]
    n_blocks = (A + MOE_BLOCK - 1) // MOE_BLOCK + N_EXPERTS
    P = n_blocks * MOE_BLOCK
    row_tok = jnp.full((P,), T, jnp.int32).at[dest].set(stok)
    row_w = jnp.zeros((P,), jnp.float32).at[dest].set(sw)
    block_e = jnp.minimum(jnp.searchsorted(pends, jnp.arange(n_blocks, dtype=jnp.int32) * MOE_BLOCK, side='right'),
                          N_EXPERTS - 1).astype(jnp.int32)
    x_pad = jnp.concatenate([xf, jnp.zeros((1, D), xf.dtype)], axis=0)
    xb = x_pad[row_tok].reshape(n_blocks, MOE_BLOCK, D)

    def expert_block(args):
        xblk, e = args
        hdn = jax.nn.silu(xblk @ w_gate[e]) * (xblk @ w_up[e])
        return hdn @ w_down[e]

    yb = lax.map(expert_block, (xb, block_e)).reshape(P, D)
    out = jnp.zeros((T + 1, D), yb.dtype).at[row_tok].add(yb * row_w[:, None].astype(yb.dtype))
    return out[:T].reshape(bsz, length, D)


def _normal(key, shape, scale):
    return jax.random.normal(key, shape, jnp.float32) * scale


def _moe_params(keys):
    D, F = D_MODEL, D_EXPERT
    return (_normal(next(keys), (D, N_GROUPS), D ** -0.5),
            _normal(next(keys), (N_GROUPS,), 0.01),
            _normal(next(keys), (D, N_EXPERTS), D ** -0.5),
            _normal(next(keys), (N_EXPERTS,), 0.01),
            _normal(next(keys), (N_EXPERTS, D, F), D ** -0.5),
            _normal(next(keys), (N_EXPERTS, D, F), D ** -0.5),
            _normal(next(keys), (N_EXPERTS, F, D), DEEPNORM_BETA * F ** -0.5))


def _ln_params(keys):
    return (1.0 + _normal(next(keys), (D_MODEL,), 0.02), _normal(next(keys), (D_MODEL,), 0.02))


def setup_inputs(seed: int = 0) -> dict:
    key = jax.random.key(seed)
    keys = iter(jax.random.split(key, 64))
    D = D_MODEL
    x = _normal(next(keys), (BATCH, SEQ, D), 1.0)
    meta_tokens = _normal(next(keys), (N_META, D), 1.0)
    H = MLSTM_HEADS
    qk_w, v_w = H * MLSTM_DQK, H * MLSTM_DV
    l0_w_in = jnp.concatenate([
        _normal(next(keys), (D, 2 * qk_w), D ** -0.5),
        _normal(next(keys), (D, v_w), DEEPNORM_BETA * D ** -0.5),
        _normal(next(keys), (D, v_w), D ** -0.5),
        _normal(next(keys), (D, 2 * H), D ** -0.5)], axis=1)
    l0_b_gates = jnp.concatenate([
        _normal(next(keys), (H,), 0.1),
        jnp.linspace(3.0, 6.0, H, dtype=jnp.float32) + _normal(next(keys), (H,), 0.1)])
    l0_head_norm_w = 1.0 + _normal(next(keys), (v_w,), 0.02)
    l0_w_out = _normal(next(keys), (v_w, D), DEEPNORM_BETA * v_w ** -0.5)
    l0_ln1_g, l0_ln1_b = _ln_params(keys)
    l0_w_group, l0_b_group, l0_w_router, l0_b_router, l0_w_gate, l0_w_up, l0_w_down = _moe_params(keys)
    l0_ln2_g, l0_ln2_b = _ln_params(keys)
    k_w, gv_w = GLA_HEADS * GLA_DK, GLA_HEADS * GLA_DV
    l1_w_in = jnp.concatenate([
        _normal(next(keys), (D, 2 * k_w), D ** -0.5),
        _normal(next(keys), (D, gv_w), DEEPNORM_BETA * D ** -0.5),
        _normal(next(keys), (D, gv_w), D ** -0.5),
        _normal(next(keys), (D, GLA_GATE_RANK), D ** -0.5)], axis=1)
    l1_w_gate_up = _normal(next(keys), (GLA_GATE_RANK, k_w), GLA_GATE_RANK ** -0.5)
    l1_b_gate = _normal(next(keys), (k_w,), 0.1)
    l1_head_norm_w = 1.0 + _normal(next(keys), (gv_w,), 0.02)
    l1_w_out = _normal(next(keys), (gv_w, D), DEEPNORM_BETA * gv_w ** -0.5)
    l1_ln1_g, l1_ln1_b = _ln_params(keys)
    l1_w_group, l1_b_group, l1_w_router, l1_b_router, l1_w_gate, l1_w_up, l1_w_down = _moe_params(keys)
    l1_ln2_g, l1_ln2_b = _ln_params(keys)
    return {"x": x, "meta_tokens": meta_tokens,
            "l0_w_in": l0_w_in, "l0_b_gates": l0_b_gates, "l0_head_norm_w": l0_head_norm_w, "l0_w_out": l0_w_out,
            "l0_ln1_g": l0_ln1_g, "l0_ln1_b": l0_ln1_b,
            "l0_w_group": l0_w_group, "l0_b_group": l0_b_group, "l0_w_router": l0_w_router, "l0_b_router": l0_b_router,
            "l0_w_gate": l0_w_gate, "l0_w_up": l0_w_up, "l0_w_down": l0_w_down,
            "l0_ln2_g": l0_ln2_g, "l0_ln2_b": l0_ln2_b,
            "l1_w_in": l1_w_in, "l1_w_gate_up": l1_w_gate_up, "l1_b_gate": l1_b_gate, "l1_head_norm_w": l1_head_norm_w,
            "l1_w_out": l1_w_out, "l1_ln1_g": l1_ln1_g, "l1_ln1_b": l1_ln1_b,
            "l1_w_group": l1_w_group, "l1_b_group": l1_b_group, "l1_w_router": l1_w_router, "l1_b_router": l1_b_router,
            "l1_w_gate": l1_w_gate, "l1_w_up": l1_w_up, "l1_w_down": l1_w_down,
            "l1_ln2_g": l1_ln2_g, "l1_ln2_b": l1_ln2_b}


def reference(x, meta_tokens,
              l0_w_in, l0_b_gates, l0_head_norm_w, l0_w_out, l0_ln1_g, l0_ln1_b,
              l0_w_group, l0_b_group, l0_w_router, l0_b_router, l0_w_gate, l0_w_up, l0_w_down,
              l0_ln2_g, l0_ln2_b,
              l1_w_in, l1_w_gate_up, l1_b_gate, l1_head_norm_w, l1_w_out, l1_ln1_g, l1_ln1_b,
              l1_w_group, l1_b_group, l1_w_router, l1_b_router, l1_w_gate, l1_w_up, l1_w_down,
              l1_ln2_g, l1_ln2_b):
    bsz = x.shape[0]
    meta = jnp.broadcast_to(meta_tokens.astype(x.dtype)[None], (bsz, N_META, D_MODEL))
    h = jnp.concatenate([meta, x], axis=1)
    mixers = (mlstm_mixer, gla_mixer)
    mixer_params = ((l0_w_in, l0_b_gates, l0_head_norm_w, l0_w_out),
                    (l1_w_in, l1_w_gate_up, l1_b_gate, l1_head_norm_w, l1_w_out))
    ln1 = ((l0_ln1_g, l0_ln1_b), (l1_ln1_g, l1_ln1_b))
    moe_params = ((l0_w_group, l0_b_group, l0_w_router, l0_b_router, l0_w_gate, l0_w_up, l0_w_down),
                  (l1_w_group, l1_b_group, l1_w_router, l1_b_router, l1_w_gate, l1_w_up, l1_w_down))
    ln2 = ((l0_ln2_g, l0_ln2_b), (l1_ln2_g, l1_ln2_b))
    for i in range(DEPTH):
        y = mixers[i % N_MIXERS](h, *mixer_params[i])
        h = layer_norm(DEEPNORM_ALPHA * h + y, *ln1[i])
        y = hier_moe(h, *moe_params[i])
        h = layer_norm(DEEPNORM_ALPHA * h + y, *ln2[i])
    return h[:, N_META:]
```

```cpp
#include <hip/hip_runtime.h>
#include <cstdio>
#include <cstdint>
namespace pg8 {
#define PG8_LAS __attribute__((address_space(3)))
typedef unsigned short bf16_t;
typedef short bf16x8 __attribute__((ext_vector_type(8)));
typedef float f32x4 __attribute__((ext_vector_type(4)));
typedef unsigned u32x4 __attribute__((ext_vector_type(4)));
constexpr int BM = 256, BK = 64, HALF = 128, HTB = HALF * BK * 2  , STAGE_BYTES = 8 * HTB, NXCD = 8, WGM = 8;

__host__ __device__ __forceinline__ int lds_byte(int r, int c) { const int st = (r >> 4) * 2 + (c >> 5), rr = r & 15, cc = c & 31, ob = rr * 64 + cc * 2; return st * 1024 + (ob ^ (((ob >> 9) & 1) << 5)); }
__host__ __device__ __forceinline__ void stage_rc(int b, int& R, int& C) { const int st = b / 1024, sb = b % 1024, swz = sb ^ (((sb >> 9) & 1) << 5); R = (st >> 1) * 16 + swz / 64; C = (st & 1) * 32 + (swz % 64) / 2; }
__host__ __device__ __forceinline__ int perm32(int rho) { const int n = rho >> 4, i = rho & 15; return 8 * (i >> 2) + 4 * n + (i & 3); }

struct Unit { int pm, pn; };
struct Gemm { const bf16_t* A; const bf16_t* Bt; int M, N, K; };

struct StaticOrder {
    int nM, nN, nwg, G, c;
    __host__ __device__ void init(int M, int N, int G_, int c_) { nM = M / BM; nN = N / BM; nwg = nM * nN; G = G_; c = c_; }
    __host__ __device__ bool next(int i, Unit& u) const {
        const long L = (long)i * G + c; if (L >= nwg) return false;
        int wgid = (int)L; { const int q = nwg / NXCD, r = nwg % NXCD, xcd = wgid % NXCD, off = wgid / NXCD; wgid = (xcd < r ? xcd * (q + 1) : r * (q + 1) + (xcd - r) * q) + off; }
        const int nig = WGM * nN, gid = wgid / nig, fm = gid * WGM, gsz = (nM - fm) < WGM ? (nM - fm) : WGM;
        u.pm = fm + ((wgid % nig) % gsz); u.pn = (wgid % nig) / gsz; return true;
    }
    __device__ __forceinline__ void a_ready(const Unit&) const {}
    __device__ __forceinline__ void done(const Unit&) const {}
};

__device__ __forceinline__ unsigned cvt_pk_bf16(float lo, float hi) { unsigned r; asm volatile("v_cvt_pk_bf16_f32 %0, %1, %2" : "=v"(r) : "v"(lo), "v"(hi)); return r; }
template <class Epi, class Sched, bool ALIGN_EPI = false, bool SP2 = false>
__device__ __forceinline__ void gemm_phase(PG8_LAS unsigned char* lds, const Gemm g, const Sched& S, const Epi& E) {
    const int tid = threadIdx.x, wid = __builtin_amdgcn_readfirstlane(tid >> 6), lane = tid & 63, wr = wid >> 2, wc = wid & 3, fr = lane & 15, fq = lane >> 4;
    const int K = g.K, nt = K / BK;
    unsigned voffA[2], voffB[2];
#pragma unroll
    for (int i = 0; i < 2; ++i) { int R, C; stage_rc(tid * 16 + i * 8192, R, C); const int Rb = Epi::PERM ? ((R & ~31) + perm32(R & 31)) : R;
        voffA[i] = (unsigned)(R * K + C) * 2u; voffB[i] = (unsigned)(Rb * K + C) * 2u; }
    const size_t kstep = (size_t)(BK * 2);
    const size_t hstep = (size_t)HALF * K * 2;
    const size_t tstep = 2 * hstep;
    const unsigned ldsw = (unsigned)wid * 1024u;
    const int aoff = lds_byte(wr * 64 + fr, fq * 8), boff = lds_byte(wc * 32 + fr, fq * 8);
#define PG8_SA(b, h) (((b) * 2 + (h)) * HTB)
#define PG8_SB(b, h) ((4 + (b) * 2 + (h)) * HTB)
#define PG8_STAGE(bufoff, gbase, voff) do { _Pragma("unroll") for (int _i = 0; _i < 2; ++_i) \
        __builtin_amdgcn_global_load_lds((const unsigned*)((const char*)(gbase) + (voff)[_i]), (PG8_LAS unsigned*)(lds + (bufoff) + ldsw + _i * 8192), 16, 0, 0); } while (0)
#define PG8_LDA(dst, b, h) do { _Pragma("unroll") for (int m = 0; m < 4; ++m) _Pragma("unroll") for (int k = 0; k < 2; ++k) dst[m][k] = *(const PG8_LAS bf16x8*)(lds + PG8_SA(b, h) + aoff + m * 2048 + k * 1024); } while (0)
#define PG8_LDB(dst, b, h) do { _Pragma("unroll") for (int n = 0; n < 2; ++n) _Pragma("unroll") for (int k = 0; k < 2; ++k) dst[n][k] = *(const PG8_LAS bf16x8*)(lds + PG8_SB(b, h) + boff + n * 2048 + k * 1024); } while (0)
#define PG8_MMA(ai, bj, At, Bt) do { __builtin_amdgcn_s_setprio(1); _Pragma("unroll") for (int m = 0; m < 4; ++m) _Pragma("unroll") for (int n = 0; n < 2; ++n) _Pragma("unroll") for (int k = 0; k < 2; ++k) \
        acc[ai][bj][m][n] = __builtin_amdgcn_mfma_f32_16x16x32_bf16(Bt[n][k], At[m][k], acc[ai][bj][m][n], 0, 0, 0); __builtin_amdgcn_s_setprio(0); } while (0)
#define PG8_WAIT_V(n) asm volatile("s_waitcnt vmcnt(" #n ")" ::: "memory")
#define PG8_WAIT_L(n) asm volatile("s_waitcnt lgkmcnt(" #n ")" ::: "memory")
#define PG8_BAR __builtin_amdgcn_s_barrier()
#define PG8_SCHED __builtin_amdgcn_sched_barrier(0)
    Unit cur, nxt; int ui = 0;
    if (!S.next(0, cur)) return;
    f32x4 acc[2][2][4][2];
#pragma unroll
    for (int a = 0; a < 2; ++a)
#pragma unroll
        for (int b = 0; b < 2; ++b)
#pragma unroll
            for (int m = 0; m < 4; ++m)
#pragma unroll
                for (int n = 0; n < 2; ++n) acc[a][b][m][n] = (f32x4){0.f, 0.f, 0.f, 0.f};
    bf16x8 At[4][2], B0[2][2], B1[2][2];
    const char* cA = (const char*)g.A + (size_t)cur.pm * tstep; const char* cB = (const char*)g.Bt + (size_t)cur.pn * tstep;
    S.a_ready(cur);
    if constexpr (SP2) {
        PG8_STAGE(PG8_SB(0, 0), cB, voffB); PG8_STAGE(PG8_SB(0, 1), cB + hstep, voffB); PG8_STAGE(PG8_SA(0, 0), cA, voffA); PG8_STAGE(PG8_SA(0, 1), cA + hstep, voffA);
        if (wr == 1) PG8_BAR;
        PG8_WAIT_V(2); PG8_BAR;
        PG8_STAGE(PG8_SB(1, 0), cB + kstep, voffB); PG8_STAGE(PG8_SA(1, 0), cA + kstep, voffA); PG8_STAGE(PG8_SB(1, 1), cB + hstep + kstep, voffB);
        PG8_WAIT_V(6); PG8_BAR;
    } else {
        PG8_STAGE(PG8_SB(0, 0), cB, voffB); PG8_STAGE(PG8_SA(0, 0), cA, voffA); PG8_STAGE(PG8_SB(0, 1), cB + hstep, voffB); PG8_STAGE(PG8_SA(0, 1), cA + hstep, voffA);
        if (wr == 1) PG8_BAR;
        PG8_WAIT_V(4); PG8_BAR;
        PG8_STAGE(PG8_SB(1, 0), cB + kstep, voffB); PG8_STAGE(PG8_SA(1, 0), cA + kstep, voffA); PG8_STAGE(PG8_SB(1, 1), cB + hstep + kstep, voffB);
        PG8_WAIT_V(6); PG8_BAR;
    }
    for (;;) {
        const bool has_next = S.next(ui + 1, nxt);
        const char* nA = has_next ? (const char*)g.A + (size_t)nxt.pm * tstep : cA; const char* nB = has_next ? (const char*)g.Bt + (size_t)nxt.pn * tstep : cB;
        for (int t = 0; t < nt; t += 2) {
            const bool last = (t == nt - 2);
            const char* a1 = cA + (size_t)(t + 1) * kstep;
            const char* a2 = last ? nA : cA + (size_t)(t + 2) * kstep; const char* b2 = last ? nB : cB + (size_t)(t + 2) * kstep;
            const char* a3 = a2 + kstep; const char* b3 = b2 + kstep;
            if (last && has_next) S.a_ready(nxt);
            if constexpr (SP2) {
            PG8_LDB(B0, 0, 0); PG8_LDB(B1, 0, 1); PG8_SCHED; PG8_LDA(At, 0, 0); PG8_STAGE(PG8_SA(1, 1), a1 + hstep, voffA);
            PG8_WAIT_V(8); PG8_WAIT_L(0); PG8_BAR; PG8_MMA(0, 0, At, B0); PG8_MMA(0, 1, At, B1); PG8_BAR; PG8_SCHED;
            PG8_LDA(At, 0, 1); PG8_STAGE(PG8_SB(0, 0), b2, voffB); PG8_STAGE(PG8_SB(0, 1), b2 + hstep, voffB); PG8_STAGE(PG8_SA(0, 0), a2, voffA);
            PG8_WAIT_V(8); PG8_WAIT_L(0); PG8_BAR; PG8_MMA(1, 0, At, B0); PG8_MMA(1, 1, At, B1); PG8_BAR; PG8_SCHED;
            PG8_LDB(B0, 1, 0); PG8_LDB(B1, 1, 1); PG8_SCHED; PG8_LDA(At, 1, 0); PG8_STAGE(PG8_SA(0, 1), a2 + hstep, voffA);
            PG8_WAIT_V(8); PG8_WAIT_L(0); PG8_BAR; PG8_MMA(0, 0, At, B0); PG8_MMA(0, 1, At, B1); PG8_BAR; PG8_SCHED;
            PG8_LDA(At, 1, 1); PG8_STAGE(PG8_SB(1, 0), b3, voffB); PG8_STAGE(PG8_SB(1, 1), b3 + hstep, voffB); PG8_STAGE(PG8_SA(1, 0), a3, voffA);
            PG8_WAIT_V(8); PG8_WAIT_L(0); PG8_BAR; PG8_MMA(1, 0, At, B0); PG8_MMA(1, 1, At, B1); PG8_BAR; PG8_SCHED;
            } else {
            PG8_LDB(B0, 0, 0); PG8_SCHED; PG8_LDA(At, 0, 0); PG8_STAGE(PG8_SA(1, 1), a1 + hstep, voffA);
            PG8_WAIT_L(8); PG8_BAR; PG8_WAIT_L(0); PG8_MMA(0, 0, At, B0); PG8_BAR; PG8_SCHED;
            PG8_LDB(B1, 0, 1); PG8_STAGE(PG8_SB(0, 0), b2, voffB);
            PG8_BAR; PG8_WAIT_L(0); PG8_MMA(0, 1, At, B1); PG8_BAR;
            PG8_LDA(At, 0, 1); PG8_STAGE(PG8_SA(0, 0), a2, voffA);
            PG8_BAR; PG8_WAIT_L(0); PG8_MMA(1, 0, At, B0); PG8_BAR; PG8_SCHED;
            PG8_STAGE(PG8_SB(0, 1), b2 + hstep, voffB);
            PG8_WAIT_V(6); PG8_BAR; PG8_MMA(1, 1, At, B1); PG8_BAR;
            PG8_LDB(B0, 1, 0); PG8_SCHED; PG8_LDA(At, 1, 0); PG8_STAGE(PG8_SA(0, 1), a2 + hstep, voffA);
            PG8_WAIT_L(8); PG8_BAR; PG8_WAIT_L(0); PG8_MMA(0, 0, At, B0); PG8_BAR; PG8_SCHED;
            PG8_LDB(B1, 1, 1); PG8_STAGE(PG8_SB(1, 0), b3, voffB);
            PG8_BAR; PG8_WAIT_L(0); PG8_MMA(0, 1, At, B1); PG8_BAR;
            PG8_LDA(At, 1, 1); PG8_STAGE(PG8_SA(1, 0), a3, voffA);
            PG8_BAR; PG8_WAIT_L(0); PG8_MMA(1, 0, At, B0); PG8_BAR; PG8_SCHED;
            PG8_STAGE(PG8_SB(1, 1), b3 + hstep, voffB);
            PG8_WAIT_V(6); PG8_BAR; PG8_MMA(1, 1, At, B1); PG8_BAR;
            }
        }
        if constexpr (ALIGN_EPI) { if (wr == 0) PG8_BAR; }
        if constexpr (!Epi::AFTER_DRAIN) { E(acc, cur, wr, wc, fr, fq); S.done(cur); }
        if (!has_next) break;
#pragma unroll
        for (int a = 0; a < 2; ++a)
#pragma unroll
            for (int b = 0; b < 2; ++b)
#pragma unroll
                for (int m = 0; m < 4; ++m)
#pragma unroll
                    for (int n = 0; n < 2; ++n) acc[a][b][m][n] = (f32x4){0.f, 0.f, 0.f, 0.f};
        cur = nxt; cA = nA; cB = nB; ++ui;
        if constexpr (ALIGN_EPI) { if (wr == 1) PG8_BAR; }
    }
    PG8_WAIT_V(0);
    if constexpr (!ALIGN_EPI) { if (wr == 0) PG8_BAR; }
    PG8_BAR;
    if constexpr (Epi::AFTER_DRAIN) { E.fused(acc, cur, wr, wc, fr, fq, lds, wid, lane); S.done(cur); }
#undef PG8_SA
#undef PG8_SB
#undef PG8_STAGE
#undef PG8_LDA
#undef PG8_LDB
#undef PG8_MMA
#undef PG8_WAIT_V
#undef PG8_WAIT_L
#undef PG8_BAR
#undef PG8_SCHED
}
}

#define DI __device__ __forceinline__
#define GAS __attribute__((address_space(1)))
#define LAS __attribute__((address_space(3)))
typedef unsigned short bf16;
typedef unsigned v4u __attribute__((ext_vector_type(4)));
typedef unsigned v2u __attribute__((ext_vector_type(2)));
typedef float f32x4 __attribute__((ext_vector_type(4)));
typedef short bf16x8 __attribute__((ext_vector_type(8)));
typedef GAS unsigned gu32;

constexpr int D = 1024, NMAIN = 32768, SEQ = 16384, MR = 33024, CH0ROW = 32768, METAROW = 32816, NMETA = 16, NTOK = NMAIN + NMETA;
constexpr int NCHUNK = 257, NUNIT = 2 * NCHUNK * 4;
constexpr int NPROJ = 3072, NE = 32, FF = 512, PMAXT = 289;
constexpr float ALPHA = 1.41421356237f, LN_EPS = 1e-5f, QSCALE = 0.08838834764831845f, NEGBIG = -1e30f;
constexpr int NWAVES = 8, NTHR = 512;

constexpr size_t MiB = 1u << 20;
constexpr size_t WS_CTL = 0, CTL_ZERO_BYTES = 1 * MiB;
constexpr size_t WS_GATES = 1 * MiB;
constexpr size_t WS_A = WS_GATES + (size_t)MR * 32;
constexpr size_t WS_MX = WS_A + (size_t)MR * 16;
constexpr size_t WS_MT = WS_MX + (size_t)MR * 16;
constexpr size_t WS_GLR = WS_MT + (size_t)MR * 16;
constexpr size_t WS_EID = WS_GLR + (size_t)MR * 64;
constexpr size_t WS_EW = WS_EID + (size_t)NTOK * 8;
constexpr size_t WS_SLOT = WS_EW + (size_t)NTOK * 8;
constexpr size_t WS_GDEC = WS_SLOT + (size_t)NTOK * 8;
constexpr size_t WS_DN = WS_GDEC + (size_t)NUNIT * 512;
constexpr size_t WS_METAF = WS_DN + (size_t)NUNIT * 512;
static_assert(WS_METAF + 65536 <= 10 * MiB, "small buffers");
constexpr size_t WS_WIN = 10 * MiB, WS_WOUT = 16 * MiB, WS_WGU = 18 * MiB, WS_WD = 82 * MiB;
constexpr size_t WS_HB = 114 * MiB;
constexpr size_t WS_ARENA = 179 * MiB;
constexpr size_t WS_Q = WS_ARENA, WS_K = WS_Q + (size_t)MR * 1024, WS_V = WS_K + (size_t)MR * 1024, WS_O = WS_V + (size_t)MR * 2048, WS_ST = WS_O + (size_t)MR * 2048;
constexpr size_t WS_YB = WS_Q;
constexpr size_t WS_XB = WS_V;
constexpr size_t WS_HDN = WS_XB + (size_t)PMAXT * 256 * 2048;
constexpr size_t WS_END = WS_ST + (size_t)NUNIT * 65536;
static_assert(WS_HDN + (size_t)PMAXT * 256 * 1024 <= WS_END, "moe overlay");
static_assert(WS_END == 501 * MiB, "ws map");
constexpr int CW_BAR = 4096;
constexpr int CW_CNT = 16384;
constexpr int CW_CUR = 16384 + 256;
constexpr int LDS_BYTES = 155648, TAB_OFF = 131072, TOP_OFF = 154624;

DI unsigned f2bf(float f) { unsigned u = __builtin_bit_cast(unsigned, f); return (u + 0x7fffu + ((u >> 16) & 1u)) >> 16; }
DI unsigned pk2(float lo, float hi) { return f2bf(lo) | (f2bf(hi) << 16); }
DI float bflo(unsigned w) { return __builtin_bit_cast(float, w << 16); }
DI float bfhi(unsigned w) { return __builtin_bit_cast(float, w & 0xffff0000u); }
DI float bf2f(bf16 b) { return __builtin_bit_cast(float, (unsigned)b << 16); }
#define LDS_WAIT() asm volatile("s_waitcnt lgkmcnt(0)" ::: "memory")
DI float wave_sum(float v) {
#pragma unroll
    for (int o = 1; o < 64; o <<= 1) v += __shfl_xor(v, o);
    return v;
}
template <int N, int OFF> struct FoldStep {
    template <int NP> static DI float run(float (&p)[NP], int lane) {
        constexpr int half = N / 2; const bool hi = (lane & OFF) != 0;
#pragma unroll
        for (int i = 0; i < half; ++i) { const float keep = hi ? p[half + i] : p[i], send = hi ? p[i] : p[half + i]; p[i] = keep + __shfl_xor(send, OFF); }
        return FoldStep<half, OFF / 2>::run(p, lane);
    }
};
template <int OFF> struct FoldStep<1, OFF> {
    template <int NP> static DI float run(float (&p)[NP], int lane) { float r = p[0];
#pragma unroll
        for (int off = OFF; off >= 1; off >>= 1) r += __shfl_xor(r, off);
        return r; }
};
template <int N> DI float fold_reduce(float (&p)[N], int lane) { return FoldStep<N, 32>::run(p, lane); }
DI float logsig(float z) { return fminf(z, 0.f) - log1pf(expf(-fabsf(z))); }
DI f32x4 mma16(bf16x8 x, bf16x8 y, f32x4 c) { return __builtin_amdgcn_mfma_f32_16x16x32_bf16(x, y, c, 0, 0, 0); }
#define XB_TMO      128
#define XB_XCNT(j)  (256  + 64 * (j))
#define XB_XSUB(j)  (1280 + 64 * (j))
#define XB_XGEN(j)  (2304 + 64 * (j))
#define XB_TOP      3328
#define XB_TOPGEN   3392
#define XCD_BAR_WORDS 3456
#define XB_SPIN_CAP (1u << 18)

__device__ __forceinline__ unsigned xb_ld(unsigned* p)              { return __hip_atomic_load(p, __ATOMIC_RELAXED, __HIP_MEMORY_SCOPE_AGENT); }
__device__ __forceinline__ unsigned xb_add(unsigned* p, unsigned v) { return __hip_atomic_fetch_add(p, v, __ATOMIC_RELAXED, __HIP_MEMORY_SCOPE_AGENT); }
__device__ __forceinline__ unsigned xb_xcc_id() { return (unsigned)__builtin_amdgcn_s_getreg((3 << 11) | 20) & 0xFu; }
#define XB_SPIN(cond, bar) do { unsigned _sp = 0; while (cond) { __builtin_amdgcn_s_sleep(1); \
    if ((++_sp & 255u) == 0u) { if (xb_ld(&(bar)[XB_TMO])) break; if (_sp > XB_SPIN_CAP) { atomicAdd(&(bar)[XB_TMO], 1u); break; } } } } while (0)

struct XcdBarrier {
    unsigned* bar; unsigned x;
    volatile LAS unsigned* st;
};

__device__ __forceinline__ XcdBarrier xcd_barrier_post(unsigned* bar, volatile LAS unsigned* st) {
    XcdBarrier b; b.bar = bar; b.x = xb_xcc_id(); b.st = st;
    if (threadIdx.x == 0) (void)xb_add(&bar[XB_XCNT(b.x)], 1u);
    return b;
}
__device__ __forceinline__ void xcd_barrier_complete(unsigned* bar, unsigned x, unsigned& nloc, unsigned& nx) {
    const unsigned G = gridDim.x * gridDim.y * gridDim.z;
    unsigned sum, cnt, mine, sp = 0u;
    for (;;) {
        sum = 0u; cnt = 0u; mine = 0u;
#pragma unroll
        for (unsigned j = 0; j < 16; ++j) { const unsigned c = xb_ld(&bar[XB_XCNT(j)]); sum += c; cnt += (c > 0u) ? 1u : 0u; mine = (j == x) ? c : mine; }
        if (sum == G) break;
        __builtin_amdgcn_s_sleep(1);
        if ((++sp & 255u) == 0u) { if (xb_ld(&bar[XB_TMO])) break; if (sp > XB_SPIN_CAP) { atomicAdd(&bar[XB_TMO], 1u); break; } }
    }
    nloc = mine > 0u ? mine : 1u; nx = cnt > 0u ? cnt : 1u;
}

__device__ __forceinline__ void xcd_barrier(const XcdBarrier& b) {
    asm volatile("s_waitcnt vmcnt(0)" ::: "memory");
    __syncthreads();
    if (threadIdx.x == 0) {
        unsigned* bar = b.bar;
        __builtin_amdgcn_s_waitcnt(0);
        unsigned nloc = b.st[0], nx = b.st[1];
        if (nloc == 0u) { xcd_barrier_complete(bar, b.x, nloc, nx); b.st[0] = nloc; b.st[1] = nx; }
        const unsigned old = xb_add(&bar[XB_XSUB(b.x)], 1u);
        const unsigned gen = old / nloc;
        if (old + 1u == (gen + 1u) * nloc) {
            __builtin_amdgcn_fence(__ATOMIC_RELEASE, "agent");
            asm volatile("s_waitcnt vmcnt(0)" ::: "memory");
            const unsigned og = xb_add(&bar[XB_TOP], 1u);
            const unsigned tg = og / nx;
            if (og + 1u == (tg + 1u) * nx) xb_add(&bar[XB_TOPGEN], 1u);
            else XB_SPIN(xb_ld(&bar[XB_TOPGEN]) == tg, bar);
            __builtin_amdgcn_fence(__ATOMIC_ACQUIRE, "agent");
            xb_add(&bar[XB_XGEN(b.x)], 1u);
            asm volatile("s_waitcnt vmcnt(0)" ::: "memory");
        } else {
            XB_SPIN(xb_ld(&bar[XB_XGEN(b.x)]) == gen, bar);
            __builtin_amdgcn_fence(__ATOMIC_ACQUIRE, "agent");
            asm volatile("s_waitcnt vmcnt(0)" ::: "memory");
        }
    }
    __syncthreads();
}

struct Args { const float* in[33]; float* out; unsigned char* ws; int ph_lo, ph_hi; };
struct Frame {
    LAS unsigned char* lds;
    gu32* ctl;
    int tid, lane, wave, G, vcu;
    const float* const* in;
    float* out; unsigned char* ws;
};
DI int tok_row(int tok) { return tok < NMAIN ? tok : tok + (METAROW - NMAIN); }

DI void transpose_item(const float* W, int ldw, int k0, int n0, bf16* WT, int Kd, int drow0, LAS float* scr, int lane) {
#pragma unroll 8
    for (int i = 0; i < 32; ++i) { const int kk = 2 * i + (lane >> 5); scr[kk * 33 + (lane & 31)] = W[(size_t)(k0 + kk) * ldw + n0 + (lane & 31)]; }
    LDS_WAIT(); asm volatile("" ::: "memory");
    const int c = lane & 7;
#pragma unroll
    for (int j = 0; j < 4; ++j) { const int n = (lane >> 3) + 8 * j; const LAS float* s = scr + (8 * c) * 33 + n;
        v4u o; o.x = pk2(s[0 * 33], s[1 * 33]); o.y = pk2(s[2 * 33], s[3 * 33]); o.z = pk2(s[4 * 33], s[5 * 33]); o.w = pk2(s[6 * 33], s[7 * 33]);
        *(v4u*)(WT + (size_t)(drow0 + n) * Kd + k0 + 8 * c) = o; }
    LDS_WAIT(); asm volatile("" ::: "memory");
}
template <int L> DI void convert_weights(Frame& F) {
    constexpr int IB = L ? 17 : 2;
    const float* w_in = F.in[IB]; const int ld_in = L ? 3088 : 3080;
    const float* w_out = F.in[L ? 21 : 5];
    const float* w_g = F.in[L ? 28 : 12]; const float* w_u = F.in[L ? 29 : 13]; const float* w_d = F.in[L ? 30 : 14];
    bf16* WIN = (bf16*)(F.ws + WS_WIN); bf16* WOUT = (bf16*)(F.ws + WS_WOUT); bf16* WGU = (bf16*)(F.ws + WS_WGU); bf16* WD = (bf16*)(F.ws + WS_WD);
    LAS float* scr = (LAS float*)(F.lds + F.wave * 16384);
    const int gw = F.vcu * NWAVES + F.wave, NGW = F.G * NWAVES;
    constexpr int I_IN = 16 * 96, I_OUT = 16 * 32, I_G = 32 * 256, I_D = 32 * 256, NITEMS = I_IN + I_OUT + 2 * I_G + I_D;
    for (int it = gw; it < NITEMS; it += NGW) {
        int r = it;
        if (r < I_IN) { const int kb = r / 96, nb = r % 96; transpose_item(w_in, ld_in, 64 * kb, 32 * nb, WIN, 1024, 32 * nb, scr, F.lane); continue; } r -= I_IN;
        if (r < I_OUT) { const int kb = r / 32, nb = r % 32; transpose_item(w_out, 1024, 64 * kb, 32 * nb, WOUT, 1024, 32 * nb, scr, F.lane); continue; } r -= I_OUT;
        if (r < 2 * I_G) { const int up = r >= I_G; if (up) r -= I_G; const int e = r >> 8, rr = r & 255, kb = rr >> 4, nb = rr & 15, n0 = 32 * nb;
            transpose_item((up ? w_u : w_g) + (size_t)e * 1024 * 512, 512, 64 * kb, n0, WGU, 1024, e * 1024 + (n0 >> 7) * 256 + up * 128 + (n0 & 127), scr, F.lane); continue; } r -= 2 * I_G;
        { const int e = r >> 8, rr = r & 255, kb = rr >> 5, nb = rr & 31; transpose_item(w_d + (size_t)e * 512 * 1024, 1024, 64 * kb, 32 * nb, WD, 512, e * 1024 + 32 * nb, scr, F.lane); }
    }
}
template <int NC, int STR> DI void stage_cols(const float* W, int ldw, int col0, LAS float* dst, int tid) {
#pragma unroll 4
    for (int idx = tid; idx < NC * 1024; idx += NTHR) { const int e = idx % NC, k = idx / NC; dst[e * STR + k] = W[(size_t)k * ldw + col0 + e]; }
}
DI void ln_row(f32x4 (&v)[4], const float* lg, const float* lb, int lane) {
    float s = 0.f;
#pragma unroll
    for (int j = 0; j < 4; ++j) s += (v[j].x + v[j].y) + (v[j].z + v[j].w);
    const float mean = wave_sum(s) * (1.f / D); float s2 = 0.f;
#pragma unroll
    for (int j = 0; j < 4; ++j) { v[j] = v[j] - mean; s2 += (v[j].x * v[j].x + v[j].y * v[j].y) + (v[j].z * v[j].z + v[j].w * v[j].w); }
    const float rstd = 1.f / sqrtf(wave_sum(s2) * (1.f / D) + LN_EPS);
#pragma unroll
    for (int j = 0; j < 4; ++j) { const f32x4 g = *(const f32x4*)(lg + 256 * j + 4 * lane), b = *(const f32x4*)(lb + 256 * j + 4 * lane); v[j] = v[j] * rstd * g + b; }
}
DI void store_row_bf16(bf16* orow, const f32x4 (&v)[4], int lane) {
    unsigned long long* o8 = (unsigned long long*)orow + lane;
#pragma unroll
    for (int j = 0; j < 4; ++j) o8[64 * j] = (unsigned long long)pk2(v[j].x, v[j].y) | ((unsigned long long)pk2(v[j].z, v[j].w) << 32);
}
template <int NC, int STR> DI float row_dots(const f32x4 (&v)[4], const LAS float* wl, int lane) {
    float p[NC];
#pragma unroll
    for (int e = 0; e < NC; ++e) { float a = 0.f;
#pragma unroll
        for (int j = 0; j < 4; ++j) { const f32x4 w = *(const LAS f32x4*)(wl + e * STR + 256 * j + 4 * lane); a += (v[j].x * w.x + v[j].y * w.y) + (v[j].z * w.z + v[j].w * w.w); }
        p[e] = a; if ((e & 3) == 3) asm volatile("" : "+v"(p[e - 3]), "+v"(p[e - 2]), "+v"(p[e - 1]), "+v"(p[e]) :: "memory"); }
    return fold_reduce<NC>(p, lane);
}

DI void phase_p0(Frame& F) {
    bf16* HB = (bf16*)(F.ws + WS_HB);
    for (int i = blockIdx.x * NTHR + F.tid; i < 240 * 128; i += F.G * NTHR) { const int ri = i >> 7, r = ri < 48 ? CH0ROW + ri : 32832 + (ri - 48);
        *(v4u*)(HB + (size_t)r * D + (i & 127) * 8) = (v4u){0u, 0u, 0u, 0u}; }
    convert_weights<0>(F);
    __syncthreads();
    LAS float* wg = (LAS float*)F.lds;
    stage_cols<8, 1028>(F.in[2], 3080, 3072, wg, F.tid);
    __syncthreads();
    const float* x = F.in[0]; const float* meta = F.in[1]; const float* bg = F.in[3];
    float* GATES = (float*)(F.ws + WS_GATES);
    const int gw = F.vcu * NWAVES + F.wave, NGW = F.G * NWAVES;
#pragma unroll 1
    for (int tok = gw; tok < NTOK; tok += NGW) {
        const float* src = tok < NMAIN ? x + (size_t)tok * D : meta + (size_t)(tok - NMAIN) * D; const int row = tok_row(tok);
        f32x4 v[4];
#pragma unroll
        for (int j = 0; j < 4; ++j) v[j] = *(const f32x4*)(src + 256 * j + 4 * F.lane);
        store_row_bf16(HB + (size_t)row * D, v, F.lane);
        const float r = row_dots<8, 1028>(v, wg, F.lane);
        if ((F.lane & 7) == 0) GATES[(size_t)row * 8 + (F.lane >> 3)] = r + bg[F.lane >> 3];
    }
}

template <bool MAXOP> DI float block_scan_excl(float val, LAS float* sb, int tid) {
    sb[tid] = val; __syncthreads();
#pragma unroll 1
    for (int off = 1; off < NTHR; off <<= 1) { float t = MAXOP ? -3.0e38f : 0.f; if (tid >= off) t = sb[tid - off]; __syncthreads(); sb[tid] = MAXOP ? fmaxf(sb[tid], t) : sb[tid] + t; __syncthreads(); }
    const float r = tid ? sb[tid - 1] : (MAXOP ? -3.0e38f : 0.f); __syncthreads();
    return r;
}
DI void phase_s1(Frame& F) {
    if (blockIdx.x >= 8) return;
    const int b = blockIdx.x >> 2, h = blockIdx.x & 3, tid = F.tid;
    const float* GATES = (const float*)(F.ws + WS_GATES);
    float* A = (float*)(F.ws + WS_A); float* MX = (float*)(F.ws + WS_MX); float* MT = (float*)(F.ws + WS_MT);
    LAS float* sb = (LAS float*)F.lds; LAS float* bc = sb + 512;
    if (tid == 0) { float B = 0.f, M = 0.f;
        for (int j = 0; j < NMETA; ++j) { const int row = METAROW + j; const float li = GATES[row * 8 + h], lf = logsig(GATES[row * 8 + 4 + h]); B += lf; const float a = li - B; M = fmaxf(M, a);
            if (b == 0) { A[row * 4 + h] = a; MX[row * 4 + h] = M; MT[row * 4 + h] = B + M; } }
        bc[0] = B; bc[1] = M; }
    if (b == 0 && tid < 48) { const int row = CH0ROW + tid; A[row * 4 + h] = NEGBIG; MX[row * 4 + h] = 0.f; MT[row * 4 + h] = 0.f; }
    __syncthreads();
    const float Bm = bc[0], Mm = bc[1];
    const int r0 = b * SEQ + 32 * tid;
    float run = 0.f;
#pragma unroll 4
    for (int j = 0; j < 32; ++j) run += logsig(GATES[(size_t)(r0 + j) * 8 + 4 + h]);
    const float off = block_scan_excl<false>(run, sb, tid) + Bm;
    float Bc = off, mx = -3.0e38f;
#pragma unroll 4
    for (int j = 0; j < 32; ++j) { const size_t row = r0 + j; Bc += logsig(GATES[row * 8 + 4 + h]); const float a = GATES[row * 8 + h] - Bc; mx = fmaxf(mx, a); A[row * 4 + h] = a; MT[row * 4 + h] = Bc; }
    const float pre = fmaxf(block_scan_excl<true>(mx, sb, tid), Mm);
    float M = pre;
#pragma unroll 4
    for (int j = 0; j < 32; ++j) { const size_t row = r0 + j; M = fmaxf(M, A[row * 4 + h]); MX[row * 4 + h] = M; MT[row * 4 + h] += M; }
}

template <int L> DI void phase_t1(Frame& F) {
    LAS float* wr = (LAS float*)F.lds;
    LAS int* hist = (LAS int*)(F.lds + 148032);
    stage_cols<32, 1028>(F.in[L ? 26 : 10], 32, 0, wr, F.tid);
    stage_cols<4, 1028>(F.in[L ? 24 : 8], 4, 0, wr + 32 * 1028, F.tid);
    if (F.tid < 32) hist[F.tid] = 0;
    __syncthreads();
    const float* lg = F.in[L ? 22 : 6]; const float* lb = F.in[L ? 23 : 7]; const float* b_grp = F.in[L ? 25 : 9]; const float* b_rt = F.in[L ? 27 : 11];
    const bf16* YB = (const bf16*)(F.ws + WS_YB); bf16* HB = (bf16*)(F.ws + WS_HB); float* METAF = (float*)(F.ws + WS_METAF);
    int* EID = (int*)(F.ws + WS_EID); float* EW = (float*)(F.ws + WS_EW);
    const int gw = F.vcu * NWAVES + F.wave, NGW = F.G * NWAVES;
#pragma unroll 1
    for (int tok = gw; tok < NTOK; tok += NGW) {
        const int row = tok_row(tok);
        const float* hp = (L == 0) ? (tok < NMAIN ? F.in[0] + (size_t)tok * D : F.in[1] + (size_t)(tok - NMAIN) * D)
                                   : (tok < NMAIN ? F.out + (size_t)tok * D : METAF + (size_t)(tok - NMAIN) * D);
        float* hf = tok < NMAIN ? F.out + (size_t)tok * D : METAF + (size_t)(tok - NMAIN) * D;
        f32x4 v[4];
#pragma unroll
        for (int j = 0; j < 4; ++j) { const f32x4 hv = *(const f32x4*)(hp + 256 * j + 4 * F.lane); const v2u yw = *(const v2u*)(YB + (size_t)row * D + 256 * j + 4 * F.lane);
            v[j].x = ALPHA * hv.x + bflo(yw.x); v[j].y = ALPHA * hv.y + bfhi(yw.x); v[j].z = ALPHA * hv.z + bflo(yw.y); v[j].w = ALPHA * hv.w + bfhi(yw.y); }
        ln_row(v, lg, lb, F.lane);
#pragma unroll
        for (int j = 0; j < 4; ++j) *(f32x4*)(hf + 256 * j + 4 * F.lane) = v[j];
        store_row_bf16(HB + (size_t)row * D, v, F.lane);
        const float r16a = row_dots<16, 1028>(v, wr, F.lane);
        const float r16b = row_dots<16, 1028>(v, wr + 16 * 1028, F.lane);
        const float r4 = row_dots<4, 1028>(v, wr + 32 * 1028, F.lane);
        float gl[4];
#pragma unroll
        for (int j = 0; j < 4; ++j) gl[j] = __shfl(r4, 16 * j) + b_grp[j];
        int gt = 0; float gm = gl[0];
#pragma unroll
        for (int j = 1; j < 4; ++j) if (gl[j] > gm) { gm = gl[j]; gt = j; }
        float se = 0.f;
#pragma unroll
        for (int j = 0; j < 4; ++j) se += expf(gl[j] - gm);
        const float pg = 1.f / se;
        float wv[8];
#pragma unroll
        for (int i = 0; i < 8; ++i) wv[i] = __shfl(gt < 2 ? r16a : r16b, 4 * ((gt & 1) * 8 + i)) + b_rt[gt * 8 + i];
        int i0 = 0; float v0 = wv[0];
#pragma unroll
        for (int i = 1; i < 8; ++i) if (wv[i] > v0) { v0 = wv[i]; i0 = i; }
        int i1 = -1; float v1 = -3.0e38f;
#pragma unroll
        for (int i = 0; i < 8; ++i) if (i != i0 && wv[i] > v1) { v1 = wv[i]; i1 = i; }
        const float e1 = expf(v1 - v0), w0 = 1.f / (1.f + e1), w1 = e1 * w0;
        if (F.lane == 0) { const int ea = gt * 8 + i0, eb = gt * 8 + i1; EID[tok * 2] = ea; EID[tok * 2 + 1] = eb; EW[tok * 2] = pg * w0; EW[tok * 2 + 1] = pg * w1;
            __hip_atomic_fetch_add(&hist[ea], 1, __ATOMIC_RELAXED, __HIP_MEMORY_SCOPE_WORKGROUP); __hip_atomic_fetch_add(&hist[eb], 1, __ATOMIC_RELAXED, __HIP_MEMORY_SCOPE_WORKGROUP); }
    }
    __syncthreads();
    if (F.tid < 32 && hist[F.tid]) atomicAdd((unsigned*)(F.ctl + CW_CNT + 64 * L + F.tid), (unsigned)hist[F.tid]);
}

DI void moe_tables(Frame& F, int L, LAS int* pst, LAS int* cnt) {
    if (F.tid < 32) cnt[F.tid] = (int)__hip_atomic_load(F.ctl + CW_CNT + 64 * L + F.tid, __ATOMIC_RELAXED, __HIP_MEMORY_SCOPE_AGENT);
    __syncthreads();
    if (F.tid == 0) { int s = 0; for (int e = 0; e < 32; ++e) { pst[e] = s; s += ((cnt[e] + 255) >> 8) << 8; } pst[32] = s; }
    __syncthreads();
}
template <int L> DI void phase_d1(Frame& F) {
    LAS int* pst = (LAS int*)F.lds; LAS int* cnt = pst + 40; LAS int* lh = cnt + 32; LAS int* lbase = lh + 32; LAS int* aslot = lbase + 32; LAS int* arow = aslot + 512;
    if (F.tid < 32) lh[F.tid] = 0;
    moe_tables(F, L, pst, cnt);
    const int* EID = (const int*)(F.ws + WS_EID); int* SLOT = (int*)(F.ws + WS_SLOT);
    const bf16* HB = (const bf16*)(F.ws + WS_HB); bf16* XB = (bf16*)(F.ws + WS_XB);
    const int TPB = (NTOK + F.G - 1) / F.G;
    const int t0 = blockIdx.x * TPB; int nt = NTOK - t0; nt = nt < 0 ? 0 : (nt > TPB ? TPB : nt);
    const int i = F.tid; const bool valid = i < 2 * nt; const int tok = t0 + (i >> 1);
    int e = 0, rank = 0;
    if (valid) { e = EID[tok * 2 + (i & 1)]; rank = __hip_atomic_fetch_add(&lh[e], 1, __ATOMIC_RELAXED, __HIP_MEMORY_SCOPE_WORKGROUP); }
    __syncthreads();
    if (F.tid < 32) lbase[F.tid] = lh[F.tid] ? (int)atomicAdd((unsigned*)(F.ctl + CW_CUR + 64 * L + F.tid), (unsigned)lh[F.tid]) : 0;
    __syncthreads();
    if (valid) { const int slot = pst[e] + lbase[e] + rank; SLOT[tok * 2 + (i & 1)] = slot; aslot[i] = slot; arow[i] = tok_row(tok); }
    __syncthreads();
    for (int a = F.wave; a < 2 * nt; a += NWAVES) { const v4u* src = (const v4u*)(HB + (size_t)arow[a] * D); v4u* dst = (v4u*)(XB + (size_t)aslot[a] * D);
        const v4u x0 = src[F.lane], x1 = src[64 + F.lane]; dst[F.lane] = x0; dst[64 + F.lane] = x1; }
    for (int j = blockIdx.x; j < 256; j += F.G) { const int ee = j & 31, part = j >> 5, npad = (((cnt[ee] + 255) >> 8) << 8) - cnt[ee];
        for (int q = part * 8 + F.wave; q < npad; q += 64) { v4u* dst = (v4u*)(XB + (size_t)(pst[ee] + cnt[ee] + q) * D); dst[F.lane] = (v4u){0u, 0u, 0u, 0u}; dst[64 + F.lane] = (v4u){0u, 0u, 0u, 0u}; } }
}

template <int L> DI void phase_t2(Frame& F) {
    LAS float* wl = (LAS float*)F.lds;
#ifndef T2_NOCONV
    if (L == 0) { convert_weights<1>(F); __syncthreads(); }
#endif
    if (L == 0) { stage_cols<16, 1028>(F.in[17], 3088, 3072, wl, F.tid); __syncthreads(); }
    const float* lg = F.in[L ? 31 : 15]; const float* lb = F.in[L ? 32 : 16];
    const bf16* Y2 = (const bf16*)(F.ws + WS_XB); bf16* HB = (bf16*)(F.ws + WS_HB); float* METAF = (float*)(F.ws + WS_METAF); float* GLR = (float*)(F.ws + WS_GLR);
    const int* SLOT = (const int*)(F.ws + WS_SLOT); const float* EW = (const float*)(F.ws + WS_EW);
    const int gw = F.vcu * NWAVES + F.wave, NGW = F.G * NWAVES;
    const int ntok = L ? NMAIN : NTOK;
#pragma unroll 1
    for (int tok = gw; tok < ntok; tok += NGW) {
        const int row = tok_row(tok);
        float* hf = tok < NMAIN ? F.out + (size_t)tok * D : METAF + (size_t)(tok - NMAIN) * D;
        const int s0 = SLOT[tok * 2], s1 = SLOT[tok * 2 + 1]; const float w0 = EW[tok * 2], w1 = EW[tok * 2 + 1];
        f32x4 v[4];
#pragma unroll
        for (int j = 0; j < 4; ++j) { const f32x4 hv = *(const f32x4*)(hf + 256 * j + 4 * F.lane);
            const v2u ya = *(const v2u*)(Y2 + (size_t)s0 * D + 256 * j + 4 * F.lane), yb = *(const v2u*)(Y2 + (size_t)s1 * D + 256 * j + 4 * F.lane);
            v[j].x = ALPHA * hv.x + (w0 * bflo(ya.x) + w1 * bflo(yb.x)); v[j].y = ALPHA * hv.y + (w0 * bfhi(ya.x) + w1 * bfhi(yb.x));
            v[j].z = ALPHA * hv.z + (w0 * bflo(ya.y) + w1 * bflo(yb.y)); v[j].w = ALPHA * hv.w + (w0 * bfhi(ya.y) + w1 * bfhi(yb.y)); }
        ln_row(v, lg, lb, F.lane);
#pragma unroll
        for (int j = 0; j < 4; ++j) *(f32x4*)(hf + 256 * j + 4 * F.lane) = v[j];
        if (L == 0) {
            store_row_bf16(HB + (size_t)row * D, v, F.lane);
            const float r = row_dots<16, 1028>(v, wl, F.lane);
            if ((F.lane & 3) == 0) GLR[(size_t)row * 16 + (F.lane >> 2)] = r;
        }
    }
}

DI void unit_decode(int u, int& b, int& c, int& h, int& row0) { h = u & 3; const int bc = u >> 2; b = bc / NCHUNK; c = bc - b * NCHUNK; row0 = c == 0 ? CH0ROW : b * SEQ + (c - 1) * 64; }
DI int prev_last_row(int c, int row0) { return c == 1 ? METAROW + NMETA - 1 : row0 - 1; }
constexpr int LD_QS = 136, LD_VT = 72, LD_BC = 132;
constexpr int L_QS = 0, L_KS = 17408, L_VT = 34816, L_PS = 71680, L_BC = 80896, L_SC = 114688, L_KT = 0;
static_assert(L_BC + 64 * LD_BC * 4 <= L_SC && L_SC + 8192 <= TAB_OFF, "chunk lds map");

DI void compute_bc(Frame& F, int row0, int h, bool ch0, LAS float* bc, LAS float* sc) {
    LAS float* gl = sc + 1024;
    LAS float* tot = sc + 512;
    const float* GLR = (const float*)(F.ws + WS_GLR); const float* wgu = F.in[18]; const float* bgate = F.in[19];
    if (F.tid < 256) *(LAS f32x4*)(gl + F.tid * 4) = *(const f32x4*)(GLR + (size_t)(row0 + (F.tid >> 2)) * 16 + (F.tid & 3) * 4);
    const int d = F.tid & 127, tq = F.tid >> 7;
    float w[16];
#pragma unroll
    for (int r = 0; r < 16; ++r) w[r] = wgu[r * 512 + h * 128 + d];
    const float bias = bgate[h * 128 + d];
    __syncthreads();
    float run = 0.f;
#pragma unroll 4
    for (int j = 0; j < 16; ++j) { const int t = 16 * tq + j; float z = bias;
#pragma unroll
        for (int r = 0; r < 16; ++r) z += gl[t * 16 + r] * w[r];
        const float la = (ch0 && t < 48) ? 0.f : logsig(z) * (1.f / 16.f); run += la; bc[t * LD_BC + d] = run; }
    tot[tq * 128 + d] = run;
    __syncthreads();
    float off = 0.f;
#pragma unroll
    for (int q = 0; q < 3; ++q) if (q < tq) off += tot[q * 128 + d];
#pragma unroll 4
    for (int j = 0; j < 16; ++j) bc[(16 * tq + j) * LD_BC + d] += off;
    __syncthreads();
}
template <bool SCALED> DI void stage_vt(Frame& F, const bf16* V, int row0, int h, LAS bf16* VT, float ws) {
    const v4u* src = (const v4u*)(V + (size_t)(row0 + F.lane) * 1024 + h * 256 + 32 * F.wave);
    v4u x[4];
#pragma unroll
    for (int j = 0; j < 4; ++j) x[j] = src[j];
#pragma unroll
    for (int j = 0; j < 4; ++j) { const unsigned wv[4] = {x[j].x, x[j].y, x[j].z, x[j].w};
#pragma unroll
        for (int q = 0; q < 4; ++q) { const int dv = 32 * F.wave + 8 * j + 2 * q;
            if (SCALED) { VT[dv * LD_VT + F.lane] = (bf16)f2bf(bflo(wv[q]) * ws); VT[(dv + 1) * LD_VT + F.lane] = (bf16)f2bf(bfhi(wv[q]) * ws); }
            else { VT[dv * LD_VT + F.lane] = (bf16)(wv[q] & 0xffffu); VT[(dv + 1) * LD_VT + F.lane] = (bf16)(wv[q] >> 16); } } }
}

template <int MIX> DI void phase_aprime(Frame& F) {
    LAS bf16* KT = (LAS bf16*)(F.lds + L_KT); LAS bf16* VT = (LAS bf16*)(F.lds + L_VT); LAS float* BC = (LAS float*)(F.lds + L_BC); LAS float* SC = (LAS float*)(F.lds + L_SC);
    const bf16* Kp = (const bf16*)(F.ws + WS_K); const bf16* Vp = (const bf16*)(F.ws + WS_V); bf16* ST = (bf16*)(F.ws + WS_ST);
    const float* A = (const float*)(F.ws + WS_A); const float* MX = (const float*)(F.ws + WS_MX);
    float* GDEC = (float*)(F.ws + WS_GDEC); float* DN = (float*)(F.ws + WS_DN);
    const int r = F.lane & 15, g = F.lane >> 4;
    for (int u = blockIdx.x; u < NUNIT; u += F.G) {
        int b, c, h, row0; unit_decode(u, b, c, h, row0);
        __syncthreads();
        float ws = 1.f, gdec = 1.f;
        if (MIX == 0) { const float Mend = MX[(size_t)(row0 + 63) * 4 + h], Mprev = c == 0 ? 0.f : MX[(size_t)prev_last_row(c, row0) * 4 + h];
            ws = expf(A[(size_t)(row0 + F.lane) * 4 + h] - Mend); gdec = expf(Mprev - Mend); if (F.wave == 0) SC[F.lane] = ws; }
        else compute_bc(F, row0, h, c == 0, BC, SC);
        { const v4u* src = (const v4u*)(Kp + (size_t)(row0 + F.lane) * 512 + h * 128 + 16 * F.wave); const v4u x0 = src[0], x1 = src[1];
          const unsigned wv[8] = {x0.x, x0.y, x0.z, x0.w, x1.x, x1.y, x1.z, x1.w};
#pragma unroll
          for (int q = 0; q < 8; ++q) { const int d = 16 * F.wave + 2 * q; float k0 = bflo(wv[q]), k1 = bfhi(wv[q]);
              if (MIX == 1) { k0 *= expf(BC[63 * LD_BC + d] - BC[F.lane * LD_BC + d]); k1 *= expf(BC[63 * LD_BC + d + 1] - BC[F.lane * LD_BC + d + 1]); }
              KT[d * LD_VT + F.lane] = (bf16)f2bf(k0); KT[(d + 1) * LD_VT + F.lane] = (bf16)f2bf(k1); } }
        stage_vt<MIX == 0>(F, Vp, row0, h, VT, ws);
        __syncthreads();
        f32x4 acc[8][2];
#pragma unroll
        for (int dt = 0; dt < 8; ++dt)
#pragma unroll
            for (int nt = 0; nt < 2; ++nt) acc[dt][nt] = (f32x4){0.f, 0.f, 0.f, 0.f};
#pragma unroll
        for (int ks = 0; ks < 2; ++ks) {
            bf16x8 y[2];
#pragma unroll
            for (int nt = 0; nt < 2; ++nt) y[nt] = *(const LAS bf16x8*)(VT + (32 * F.wave + 16 * nt + r) * LD_VT + 32 * ks + 8 * g);
#pragma unroll
            for (int dt = 0; dt < 8; ++dt) { const bf16x8 x = *(const LAS bf16x8*)(KT + (16 * dt + r) * LD_VT + 32 * ks + 8 * g);
#pragma unroll
                for (int nt = 0; nt < 2; ++nt) acc[dt][nt] = mma16(x, y[nt], acc[dt][nt]); }
        }
        bf16* stu = ST + (size_t)u * 32768;
#pragma unroll
        for (int nt = 0; nt < 2; ++nt) { const int dv = 32 * F.wave + 16 * nt + r;
#pragma unroll
            for (int dt = 0; dt < 8; ++dt) { v2u o; o.x = pk2(acc[dt][nt].x, acc[dt][nt].y); o.y = pk2(acc[dt][nt].z, acc[dt][nt].w); *(v2u*)(stu + dv * 128 + 16 * dt + 4 * g) = o; } }
        if (F.tid < 128) { const int d = F.tid;
            if (MIX == 0) { float s = 0.f;
                for (int j = 0; j < 64; ++j) s += bf2f(KT[d * LD_VT + j]) * SC[j];
                DN[(size_t)u * 128 + d] = s; GDEC[(size_t)u * 128 + d] = gdec; }
            else GDEC[(size_t)u * 128 + d] = expf(BC[63 * LD_BC + d]); }
    }
}

template <int MIX> DI void phase_scan(Frame& F) {
    unsigned* ST = (unsigned*)(F.ws + WS_ST); const float* GDEC = (const float*)(F.ws + WS_GDEC); float* DN = (float*)(F.ws + WS_DN);
    for (int gid = blockIdx.x * NTHR + F.tid; gid < 8 * 16384; gid += F.G * NTHR) {
        const int bh = gid >> 14, e2 = gid & 16383, b = bh >> 2, h = bh & 3, d = (2 * e2) & 127;
        float s0 = 0.f, s1 = 0.f;
        size_t ub = (size_t)(b * NCHUNK) * 4 + h;
        int c = 0;
#pragma unroll 1
        for (; c + 8 <= NCHUNK; c += 8) {
            unsigned x[8]; float g0[8], g1[8];
#pragma unroll
            for (int j = 0; j < 8; ++j) { const size_t u = ub + (size_t)(c + j) * 4; x[j] = ST[u * 16384 + e2]; const float2 gg = *(const float2*)(GDEC + u * 128 + d); g0[j] = gg.x; g1[j] = gg.y; }
#pragma unroll
            for (int j = 0; j < 8; ++j) { const size_t u = ub + (size_t)(c + j) * 4; ST[u * 16384 + e2] = pk2(s0, s1); s0 = g0[j] * s0 + bflo(x[j]); s1 = g1[j] * s1 + bfhi(x[j]); }
        }
        for (; c < NCHUNK; ++c) { const size_t u = ub + (size_t)c * 4; const unsigned x = ST[u * 16384 + e2]; const float2 gg = *(const float2*)(GDEC + u * 128 + d);
            ST[u * 16384 + e2] = pk2(s0, s1); s0 = gg.x * s0 + bflo(x); s1 = gg.y * s1 + bfhi(x); }
    }
    if (MIX == 0) {
        const int gid = blockIdx.x * NTHR + F.tid;
        if (gid < 1024) { const int bh = gid >> 7, d = gid & 127, b = bh >> 2, h = bh & 3; float s = 0.f;
            for (int c = 0; c < NCHUNK; ++c) { const size_t u = (size_t)(b * NCHUNK + c) * 4 + h; const float x = DN[u * 128 + d], gg = GDEC[u * 128 + d]; DN[u * 128 + d] = s; s = gg * s + x; } }
    }
}

template <int MIX> DI void phase_cprime(Frame& F) {
    LAS bf16* QS = (LAS bf16*)(F.lds + L_QS); LAS bf16* KS = (LAS bf16*)(F.lds + L_KS); LAS bf16* VT = (LAS bf16*)(F.lds + L_VT); LAS bf16* PS = (LAS bf16*)(F.lds + L_PS);
    LAS float* BC = (LAS float*)(F.lds + L_BC); LAS float* SC = (LAS float*)(F.lds + L_SC);
    LAS float* sa = SC, *sM = SC + 64, *smt = SC + 128, *sf = SC + 192, *srd = SC + 256, *snh = SC + 320, *red = SC + 448, *stat = SC + 1472;
    const bf16* Qp = (const bf16*)(F.ws + WS_Q); const bf16* Kp = (const bf16*)(F.ws + WS_K); const bf16* Vp = (const bf16*)(F.ws + WS_V); bf16* Op = (bf16*)(F.ws + WS_O);
    const bf16* ST = (const bf16*)(F.ws + WS_ST);
    const float* A = (const float*)(F.ws + WS_A); const float* MX = (const float*)(F.ws + WS_MX); const float* MT = (const float*)(F.ws + WS_MT); const float* NH = (const float*)(F.ws + WS_DN);
    const float* hnw = F.in[MIX ? 20 : 4];
    const int r = F.lane & 15, g = F.lane >> 4, w = F.wave;
    for (int u = blockIdx.x; u < NUNIT; u += F.G) {
        int b, c, h, row0; unit_decode(u, b, c, h, row0);
        if (b == 1 && c == 0) continue;
        __syncthreads();
        if (MIX == 0) {
            if (F.tid < 64) { const size_t row = row0 + F.tid; const float Mprev = c == 0 ? 0.f : MX[(size_t)prev_last_row(c, row0) * 4 + h]; const float Mt = MX[row * 4 + h];
                sa[F.tid] = A[row * 4 + h]; sM[F.tid] = Mt; smt[F.tid] = MT[row * 4 + h]; sf[F.tid] = expf(Mprev - Mt); }
            else if (F.tid >= 128 && F.tid < 256) snh[F.tid - 128] = NH[(size_t)u * 128 + F.tid - 128];
        } else compute_bc(F, row0, h, c == 0, BC, SC);
        { const int rr = F.tid >> 3, ch = F.tid & 7;
          const v4u* qsrc = (const v4u*)(Qp + (size_t)(row0 + rr) * 512 + h * 128 + 16 * ch); const v4u* ksrc = (const v4u*)(Kp + (size_t)(row0 + rr) * 512 + h * 128 + 16 * ch);
          v4u q0 = qsrc[0], q1 = qsrc[1], k0 = ksrc[0], k1 = ksrc[1];
          if (MIX == 1) {
              unsigned qw[8] = {q0.x, q0.y, q0.z, q0.w, q1.x, q1.y, q1.z, q1.w}, kw[8] = {k0.x, k0.y, k0.z, k0.w, k1.x, k1.y, k1.z, k1.w};
#pragma unroll
              for (int j = 0; j < 8; ++j) { const float b0 = BC[rr * LD_BC + 16 * ch + 2 * j], b1 = BC[rr * LD_BC + 16 * ch + 2 * j + 1]; const float e0 = expf(b0), e1 = expf(b1);
                  qw[j] = pk2(bflo(qw[j]) * e0, bfhi(qw[j]) * e1); kw[j] = pk2(bflo(kw[j]) / e0, bfhi(kw[j]) / e1); }
              q0 = (v4u){qw[0], qw[1], qw[2], qw[3]}; q1 = (v4u){qw[4], qw[5], qw[6], qw[7]}; k0 = (v4u){kw[0], kw[1], kw[2], kw[3]}; k1 = (v4u){kw[4], kw[5], kw[6], kw[7]};
          }
          *(LAS v4u*)(QS + rr * LD_QS + 16 * ch) = q0; *(LAS v4u*)(QS + rr * LD_QS + 16 * ch + 8) = q1;
          *(LAS v4u*)(KS + rr * LD_QS + 16 * ch) = k0; *(LAS v4u*)(KS + rr * LD_QS + 16 * ch + 8) = k1; }
        stage_vt<false>(F, Vp, row0, h, VT, 1.f);
        __syncthreads();
        { const int st = w >> 1;
#pragma unroll
          for (int tti = 0; tti < 2; ++tti) { const int tt = 2 * (w & 1) + tti; f32x4 acc = (f32x4){0.f, 0.f, 0.f, 0.f};
              if (st <= tt) {
#pragma unroll
                  for (int ks = 0; ks < 4; ++ks) { const bf16x8 x = *(const LAS bf16x8*)(KS + (16 * st + r) * LD_QS + 32 * ks + 8 * g), y = *(const LAS bf16x8*)(QS + (16 * tt + r) * LD_QS + 32 * ks + 8 * g); acc = mma16(x, y, acc); } }
              const int t = 16 * tt + r, s0 = 16 * st + 4 * g; float p[4];
#pragma unroll
              for (int i = 0; i < 4; ++i) { float v = acc[i]; if (MIX == 0) v *= expf(sa[s0 + i] - sM[t]); p[i] = (s0 + i <= t) ? v : 0.f; }
              v2u o; o.x = pk2(p[0], p[1]); o.y = pk2(p[2], p[3]); *(LAS v2u*)(PS + t * LD_VT + s0) = o; } }
        __syncthreads();
        if (MIX == 0 && F.tid < 64) { const int t = F.tid; float di = 0.f, dq = 0.f;
            for (int s = 0; s < 64; ++s) di += bf2f(PS[t * LD_VT + s]);
            for (int d = 0; d < 128; ++d) dq += bf2f(QS[t * LD_QS + d]) * snh[d];
            const float den = di + sf[t] * dq; srd[t] = 1.f / fmaxf(fabsf(den), expf(-smt[t])); }
        f32x4 acc1[2][4], acc2[2][4];
#pragma unroll
        for (int nt = 0; nt < 2; ++nt)
#pragma unroll
            for (int mt = 0; mt < 4; ++mt) { acc1[nt][mt] = (f32x4){0.f, 0.f, 0.f, 0.f}; acc2[nt][mt] = (f32x4){0.f, 0.f, 0.f, 0.f}; }
        const bf16* stu = ST + (size_t)u * 32768;
#pragma unroll
        for (int ks = 0; ks < 4; ++ks) {
            bf16x8 x[2], y[4];
#pragma unroll
            for (int nt = 0; nt < 2; ++nt) x[nt] = *(const bf16x8*)(stu + (32 * w + 16 * nt + r) * 128 + 32 * ks + 8 * g);
#pragma unroll
            for (int mt = 0; mt < 4; ++mt) y[mt] = *(const LAS bf16x8*)(QS + (16 * mt + r) * LD_QS + 32 * ks + 8 * g);
#pragma unroll
            for (int nt = 0; nt < 2; ++nt)
#pragma unroll
                for (int mt = 0; mt < 4; ++mt) acc2[nt][mt] = mma16(x[nt], y[mt], acc2[nt][mt]);
        }
#pragma unroll
        for (int ks = 0; ks < 2; ++ks) {
            bf16x8 x[2], y[4];
#pragma unroll
            for (int nt = 0; nt < 2; ++nt) x[nt] = *(const LAS bf16x8*)(VT + (32 * w + 16 * nt + r) * LD_VT + 32 * ks + 8 * g);
#pragma unroll
            for (int mt = 0; mt < 4; ++mt) y[mt] = *(const LAS bf16x8*)(PS + (16 * mt + r) * LD_VT + 32 * ks + 8 * g);
#pragma unroll
            for (int nt = 0; nt < 2; ++nt)
#pragma unroll
                for (int mt = 0; mt < 4; ++mt) acc1[nt][mt] = mma16(x[nt], y[mt], acc1[nt][mt]);
        }
        __syncthreads();
#pragma unroll
        for (int mt = 0; mt < 4; ++mt) { const int t = 16 * mt + r; float s1 = 0.f, s2 = 0.f;
            const float ft = MIX == 0 ? sf[t] : 1.f, rd = MIX == 0 ? srd[t] : 1.f;
#pragma unroll
            for (int nt = 0; nt < 2; ++nt) { f32x4 hv = (acc1[nt][mt] + acc2[nt][mt] * ft) * rd; acc1[nt][mt] = hv; s1 += (hv.x + hv.y) + (hv.z + hv.w); s2 += (hv.x * hv.x + hv.y * hv.y) + (hv.z * hv.z + hv.w * hv.w); }
            s1 += __shfl_xor(s1, 16); s1 += __shfl_xor(s1, 32); s2 += __shfl_xor(s2, 16); s2 += __shfl_xor(s2, 32);
            if (g == 0) { red[(w * 64 + t) * 2] = s1; red[(w * 64 + t) * 2 + 1] = s2; } }
        __syncthreads();
        if (F.tid < 64) { float s1 = 0.f, s2 = 0.f;
#pragma unroll
            for (int ww = 0; ww < 8; ++ww) { s1 += red[(ww * 64 + F.tid) * 2]; s2 += red[(ww * 64 + F.tid) * 2 + 1]; }
            if (MIX == 0) { const float mean = s1 * (1.f / 256.f), var = fmaxf(s2 * (1.f / 256.f) - mean * mean, 0.f); stat[F.tid * 2] = mean; stat[F.tid * 2 + 1] = 1.f / sqrtf(var + LN_EPS); }
            else { stat[F.tid * 2] = 0.f; stat[F.tid * 2 + 1] = 1.f / sqrtf(s2 * (1.f / 256.f) + LN_EPS); } }
        __syncthreads();
#pragma unroll
        for (int mt = 0; mt < 4; ++mt) { const int t = 16 * mt + r; const float mean = stat[t * 2], rstd = stat[t * 2 + 1];
#pragma unroll
            for (int nt = 0; nt < 2; ++nt) { const int dv = 32 * w + 16 * nt + 4 * g; bf16* op = Op + (size_t)(row0 + t) * 1024 + h * 256 + dv;
                const v2u gw = *(const v2u*)op; const f32x4 hn = *(const f32x4*)(hnw + h * 256 + dv); const f32x4 hv = acc1[nt][mt];
                const float gi[4] = {bflo(gw.x), bfhi(gw.x), bflo(gw.y), bfhi(gw.y)}; float o[4];
#pragma unroll
                for (int i = 0; i < 4; ++i) { const float sg = 1.f / (1.f + expf(-gi[i])); o[i] = (hv[i] - mean) * rstd * hn[i] * (MIX == 0 ? sg : gi[i] * sg); }
                v2u ow; ow.x = pk2(o[0], o[1]); ow.y = pk2(o[2], o[3]); *(v2u*)op = ow; } }
    }
}

struct EpiProj {
    static constexpr bool PERM = true, AFTER_DRAIN = false;
    bf16 *Q, *K, *V, *O;
    DI void operator()(const f32x4 (&acc)[2][2][4][2], const pg8::Unit& u, int wr, int wc, int fr, int fq) const {
        bf16* base; int ld, colt; float sc = 1.f; const int pn = u.pn;
        if (pn < 2) { base = Q; ld = 512; colt = pn * 256; sc = QSCALE; } else if (pn < 4) { base = K; ld = 512; colt = (pn - 2) * 256; }
        else if (pn < 8) { base = V; ld = 1024; colt = (pn - 4) * 256; } else { base = O; ld = 1024; colt = (pn - 8) * 256; }
        const int row0 = u.pm * 256 + wr * 64 + fr, col0 = colt + wc * 32 + 8 * fq;
#pragma unroll
        for (int ai = 0; ai < 2; ++ai)
#pragma unroll
            for (int m = 0; m < 4; ++m) { bf16* rowp = base + (size_t)(row0 + ai * 128 + m * 16) * ld + col0;
#pragma unroll
                for (int bj = 0; bj < 2; ++bj) { const f32x4 v0 = acc[ai][bj][m][0] * sc, v1 = acc[ai][bj][m][1] * sc;
                    v4u w; w.x = pg8::cvt_pk_bf16(v0[0], v0[1]); w.y = pg8::cvt_pk_bf16(v0[2], v0[3]); w.z = pg8::cvt_pk_bf16(v1[0], v1[1]); w.w = pg8::cvt_pk_bf16(v1[2], v1[3]);
                    *(v4u*)(rowp + bj * 128) = w; } }
    }
};
struct EpiPlain {
    static constexpr bool PERM = true, AFTER_DRAIN = false;
    bf16* O;
    DI void operator()(const f32x4 (&acc)[2][2][4][2], const pg8::Unit& u, int wr, int wc, int fr, int fq) const {
        const int row0 = u.pm * 256 + wr * 64 + fr, col0 = (u.pn & 3) * 256 + wc * 32 + 8 * fq;
#pragma unroll
        for (int ai = 0; ai < 2; ++ai)
#pragma unroll
            for (int m = 0; m < 4; ++m) { bf16* rowp = O + (size_t)(row0 + ai * 128 + m * 16) * 1024 + col0;
#pragma unroll
                for (int bj = 0; bj < 2; ++bj) { const f32x4 v0 = acc[ai][bj][m][0], v1 = acc[ai][bj][m][1];
                    v4u w; w.x = pg8::cvt_pk_bf16(v0[0], v0[1]); w.y = pg8::cvt_pk_bf16(v0[2], v0[3]); w.z = pg8::cvt_pk_bf16(v1[0], v1[1]); w.w = pg8::cvt_pk_bf16(v1[2], v1[3]);
                    *(v4u*)(rowp + bj * 128) = w; } }
    }
};
struct EpiGU {
    static constexpr bool PERM = true, AFTER_DRAIN = false;
    bf16* Hd;
    DI void operator()(const f32x4 (&acc)[2][2][4][2], const pg8::Unit& u, int wr, int wc, int fr, int fq) const {
        const int row0 = u.pm * 256 + wr * 64 + fr, col0 = (u.pn & 3) * 128 + wc * 32 + 8 * fq;
#pragma unroll
        for (int ai = 0; ai < 2; ++ai)
#pragma unroll
            for (int m = 0; m < 4; ++m) { float o[8];
#pragma unroll
                for (int n = 0; n < 2; ++n)
#pragma unroll
                    for (int i = 0; i < 4; ++i) { const float gte = acc[ai][0][m][n][i], up = acc[ai][1][m][n][i]; o[4 * n + i] = gte * __builtin_amdgcn_rcpf(1.f + __expf(-gte)) * up; }
                v4u w; w.x = pg8::cvt_pk_bf16(o[0], o[1]); w.y = pg8::cvt_pk_bf16(o[2], o[3]); w.z = pg8::cvt_pk_bf16(o[4], o[5]); w.w = pg8::cvt_pk_bf16(o[6], o[7]);
                *(v4u*)(Hd + (size_t)(row0 + ai * 128 + m * 16) * 512 + col0) = w; }
    }
};
struct MoeOrder {
    const LAS int* tile_e; int nunits, G, c;
    DI bool next(int i, pg8::Unit& u) const { const int L = i * G + c; if (L >= nunits) return false; const int t = L >> 2; const int e = __builtin_amdgcn_readfirstlane(tile_e[t]); u.pm = t; u.pn = e * 4 + (L & 3); return true; }
    DI void a_ready(const pg8::Unit&) const {}
    DI void done(const pg8::Unit&) const {}
};
DI int moe_order_setup(Frame& F, int L) {
    LAS int* pst = (LAS int*)(F.lds + TAB_OFF); LAS int* cnt = pst + 40; LAS int* tile_e = pst + 128;
    moe_tables(F, L, pst, cnt);
    const int ntiles = pst[32] >> 8;
    for (int t = F.tid; t < ntiles; t += NTHR) { int e = 0;
        for (int q = 1; q < 32; ++q) if (pst[q] <= t * 256) e = q;
        tile_e[t] = e; }
    __syncthreads();
    return ntiles;
}

constexpr int NPHASE = 23;
#ifndef PH_MASK
#define PH_MASK 0xFFFu
#endif
#define EN(i) (((PH_MASK) >> (i)) & 1u)
template <int L> DI void layer_phases(Frame& F, const XcdBarrier& bar, int lo, int hi) {
    constexpr int P = 1 + 11 * L;
#define IN(k) (lo <= (k) && (k) < hi)
#define SEAM(k) do { if (IN(k) && IN((k) + 1)) xcd_barrier(bar); } while (0)
    if (EN(0) && IN(P + 0)) { pg8::Gemm gm{(const bf16*)(F.ws + WS_HB), (const bf16*)(F.ws + WS_WIN), MR, NPROJ, D}; pg8::StaticOrder S; S.init(MR, NPROJ, F.G, (int)blockIdx.x);
        EpiProj E{(bf16*)(F.ws + WS_Q), (bf16*)(F.ws + WS_K), (bf16*)(F.ws + WS_V), (bf16*)(F.ws + WS_O)};
        pg8::gemm_phase<EpiProj, pg8::StaticOrder, true, true>(F.lds, gm, S, E); }
    SEAM(P + 0);
    if (EN(1) && IN(P + 1)) { if (L == 0) phase_s1(F); }
    if (L == 0) SEAM(P + 1);
    if (EN(2) && IN(P + 2)) phase_aprime<L>(F);
    SEAM(P + 2);
    if (EN(3) && IN(P + 3)) phase_scan<L>(F);
    SEAM(P + 3);
    if (EN(4) && IN(P + 4)) phase_cprime<L>(F);
    SEAM(P + 4);
    if (EN(5) && IN(P + 5)) { pg8::Gemm gm{(const bf16*)(F.ws + WS_O), (const bf16*)(F.ws + WS_WOUT), MR, D, D}; pg8::StaticOrder S; S.init(MR, D, F.G, (int)blockIdx.x);
        EpiPlain E{(bf16*)(F.ws + WS_YB)};
        pg8::gemm_phase<EpiPlain, pg8::StaticOrder, true, true>(F.lds, gm, S, E); }
    SEAM(P + 5);
    if (EN(6) && IN(P + 6)) phase_t1<L>(F);
    SEAM(P + 6);
    if (EN(7) && IN(P + 7)) phase_d1<L>(F);
    SEAM(P + 7);
    if (EN(8) && IN(P + 8)) { const int ntiles = moe_order_setup(F, L);
        pg8::Gemm gm{(const bf16*)(F.ws + WS_XB), (const bf16*)(F.ws + WS_WGU), 0, 0, D}; MoeOrder S{(const LAS int*)(F.lds + TAB_OFF) + 128, ntiles * 4, F.G, F.vcu};
        EpiGU E{(bf16*)(F.ws + WS_HDN)};
        pg8::gemm_phase<EpiGU, MoeOrder, true, true>(F.lds, gm, S, E); }
    SEAM(P + 8);
    if (EN(9) && IN(P + 9)) { const int ntiles = moe_order_setup(F, L);
        pg8::Gemm gm{(const bf16*)(F.ws + WS_HDN), (const bf16*)(F.ws + WS_WD), 0, 0, FF}; MoeOrder S{(const LAS int*)(F.lds + TAB_OFF) + 128, ntiles * 4, F.G, F.vcu};
        EpiPlain E{(bf16*)(F.ws + WS_XB)};
        pg8::gemm_phase<EpiPlain, MoeOrder, true, true>(F.lds, gm, S, E); }
    SEAM(P + 9);
    if (EN(10) && IN(P + 10)) phase_t2<L>(F);
    if (L == 0) SEAM(P + 10);
#undef IN
#undef SEAM
}

__global__ void __launch_bounds__(NTHR, 2) hybrid_fwd(Args args) {
    extern __shared__ __attribute__((aligned(16))) unsigned char lds[];
    Frame F;
    F.lds = (LAS unsigned char*)lds;
    F.tid = threadIdx.x; F.lane = F.tid & 63; F.wave = __builtin_amdgcn_readfirstlane(F.tid >> 6);
    F.G = gridDim.x; { const int bx = blockIdx.x; F.vcu = (F.G % 8 == 0) ? (bx % 8) * (F.G / 8) + bx / 8 : bx; }
    F.in = args.in; F.out = args.out; F.ws = args.ws;
    F.ctl = (gu32*)(args.ws + WS_CTL);
    volatile LAS unsigned* MISC = (volatile LAS unsigned*)(F.lds + TOP_OFF);
    if (F.tid < 64) MISC[F.tid] = 0u;
    __syncthreads();
    const int lo = args.ph_lo, hi = args.ph_hi;
    XcdBarrier bar; bar.bar = (unsigned*)(F.ctl + CW_BAR); bar.x = 0; bar.st = nullptr;
    if (hi - lo > 1) bar = xcd_barrier_post((unsigned*)(F.ctl + CW_BAR), MISC + 8);
    if (lo <= 0 && 0 < hi) { if (EN(11)) phase_p0(F); if (hi > 1) xcd_barrier(bar); }
    layer_phases<0>(F, bar, lo, hi);
    layer_phases<1>(F, bar, lo, hi);
}

#ifndef MK_PER_PHASE
#define MK_PER_PHASE 0
#endif
extern "C" void kernel_launch(void* const* d_in, const int* in_sizes, int n_in, void* d_out, int out_size, void* d_ws, size_t ws_size, hipStream_t stream) {
    static int grid = 0;
    if (grid == 0) {
        if (n_in != 33 || in_sizes[0] != NMAIN * D || out_size != NMAIN * D || ws_size < WS_END) { fprintf(stderr, "kernel_launch: unexpected shapes (n_in %d, in0 %d, out %d, ws %zu)\n", n_in, n_in > 0 ? in_sizes[0] : -1, out_size, ws_size); grid = -1; return; }
        if (hipFuncSetAttribute((const void*)hybrid_fwd, hipFuncAttributeMaxDynamicSharedMemorySize, LDS_BYTES) != hipSuccess) { fprintf(stderr, "kernel_launch: hipFuncSetAttribute failed\n"); grid = -1; return; }
        int dev = 0, cus = 0, per_cu = 0;
        (void)hipGetDevice(&dev); (void)hipDeviceGetAttribute(&cus, hipDeviceAttributeMultiprocessorCount, dev);
        if (hipOccupancyMaxActiveBlocksPerMultiprocessor(&per_cu, (const void*)hybrid_fwd, NTHR, LDS_BYTES) != hipSuccess || per_cu < 1) fprintf(stderr, "kernel_launch: occupancy query reports %d blocks per CU\n", per_cu);
        (void)hipGetLastError();
        grid = 256;
        if (cus < 256) { fprintf(stderr, "kernel_launch: device has %d CUs, need 256\n", cus); grid = -1; return; }
    }
    if (grid < 0) return;
    (void)hipMemsetAsync((char*)d_ws + WS_CTL, 0, CTL_ZERO_BYTES, stream);
    Args a{};
    for (int i = 0; i < 33; ++i) a.in[i] = (const float*)d_in[i];
    a.out = (float*)d_out; a.ws = (unsigned char*)d_ws;
#if MK_PER_PHASE
    for (int p = 0; p < NPHASE; ++p) { a.ph_lo = p; a.ph_hi = p + 1; hipLaunchKernelGGL(hybrid_fwd, dim3(grid), dim3(NTHR), LDS_BYTES, stream, a); }
#else
    a.ph_lo = 0; a.ph_hi = NPHASE;
    hipLaunchKernelGGL(hybrid_fwd, dim3(grid), dim3(NTHR), LDS_BYTES, stream, a);
#endif
}
```

```cpp
#include <hip/hip_runtime.h>
#include <cstdio>
#include <cstdint>
namespace pg8 {
#define PG8_LAS __attribute__((address_space(3)))
typedef unsigned short bf16_t;
typedef short bf16x8 __attribute__((ext_vector_type(8)));
typedef float f32x4 __attribute__((ext_vector_type(4)));
typedef unsigned u32x4 __attribute__((ext_vector_type(4)));
constexpr int BM = 256, BK = 64, HALF = 128, HTB = HALF * BK * 2  , STAGE_BYTES = 8 * HTB, NXCD = 8, WGM = 8;

__host__ __device__ __forceinline__ int lds_byte(int r, int c) { const int st = (r >> 4) * 2 + (c >> 5), rr = r & 15, cc = c & 31, ob = rr * 64 + cc * 2; return st * 1024 + (ob ^ (((ob >> 9) & 1) << 5)); }
__host__ __device__ __forceinline__ void stage_rc(int b, int& R, int& C) { const int st = b / 1024, sb = b % 1024, swz = sb ^ (((sb >> 9) & 1) << 5); R = (st >> 1) * 16 + swz / 64; C = (st & 1) * 32 + (swz % 64) / 2; }
__host__ __device__ __forceinline__ int perm32(int rho) { const int n = rho >> 4, i = rho & 15; return 8 * (i >> 2) + 4 * n + (i & 3); }

struct Unit { int pm, pn; };
struct Gemm { const bf16_t* A; const bf16_t* Bt; int M, N, K; };

struct StaticOrder {
    int nM, nN, nwg, G, c;
    __host__ __device__ void init(int M, int N, int G_, int c_) { nM = M / BM; nN = N / BM; nwg = nM * nN; G = G_; c = c_; }
    __host__ __device__ bool next(int i, Unit& u) const {
        const long L = (long)i * G + c; if (L >= nwg) return false;
        int wgid = (int)L; { const int q = nwg / NXCD, r = nwg % NXCD, xcd = wgid % NXCD, off = wgid / NXCD; wgid = (xcd < r ? xcd * (q + 1) : r * (q + 1) + (xcd - r) * q) + off; }
        const int nig = WGM * nN, gid = wgid / nig, fm = gid * WGM, gsz = (nM - fm) < WGM ? (nM - fm) : WGM;
        u.pm = fm + ((wgid % nig) % gsz); u.pn = (wgid % nig) / gsz; return true;
    }
    __device__ __forceinline__ void a_ready(const Unit&) const {}
    __device__ __forceinline__ void done(const Unit&) const {}
};

__device__ __forceinline__ unsigned cvt_pk_bf16(float lo, float hi) { unsigned r; asm volatile("v_cvt_pk_bf16_f32 %0, %1, %2" : "=v"(r) : "v"(lo), "v"(hi)); return r; }
template <class Epi, class Sched, bool ALIGN_EPI = false, bool SP2 = false>
__device__ __forceinline__ void gemm_phase(PG8_LAS unsigned char* lds, const Gemm g, const Sched& S, const Epi& E) {
    const int tid = threadIdx.x, wid = __builtin_amdgcn_readfirstlane(tid >> 6), lane = tid & 63, wr = wid >> 2, wc = wid & 3, fr = lane & 15, fq = lane >> 4;
    const int K = g.K, nt = K / BK;
    unsigned voffA[2], voffB[2];
#pragma unroll
    for (int i = 0; i < 2; ++i) { int R, C; stage_rc(tid * 16 + i * 8192, R, C); const int Rb = Epi::PERM ? ((R & ~31) + perm32(R & 31)) : R;
        voffA[i] = (unsigned)(R * K + C) * 2u; voffB[i] = (unsigned)(Rb * K + C) * 2u; }
    const size_t kstep = (size_t)(BK * 2);
    const size_t hstep = (size_t)HALF * K * 2;
    const size_t tstep = 2 * hstep;
    const unsigned ldsw = (unsigned)wid * 1024u;
    const int aoff = lds_byte(wr * 64 + fr, fq * 8), boff = lds_byte(wc * 32 + fr, fq * 8);
#define PG8_SA(b, h) (((b) * 2 + (h)) * HTB)
#define PG8_SB(b, h) ((4 + (b) * 2 + (h)) * HTB)
#define PG8_STAGE(bufoff, gbase, voff) do { _Pragma("unroll") for (int _i = 0; _i < 2; ++_i) \
        __builtin_amdgcn_global_load_lds((const unsigned*)((const char*)(gbase) + (voff)[_i]), (PG8_LAS unsigned*)(lds + (bufoff) + ldsw + _i * 8192), 16, 0, 0); } while (0)
#define PG8_LDA(dst, b, h) do { _Pragma("unroll") for (int m = 0; m < 4; ++m) _Pragma("unroll") for (int k = 0; k < 2; ++k) dst[m][k] = *(const PG8_LAS bf16x8*)(lds + PG8_SA(b, h) + aoff + m * 2048 + k * 1024); } while (0)
#define PG8_LDB(dst, b, h) do { _Pragma("unroll") for (int n = 0; n < 2; ++n) _Pragma("unroll") for (int k = 0; k < 2; ++k) dst[n][k] = *(const PG8_LAS bf16x8*)(lds + PG8_SB(b, h) + boff + n * 2048 + k * 1024); } while (0)
#define PG8_MMA(ai, bj, At, Bt) do { __builtin_amdgcn_s_setprio(1); _Pragma("unroll") for (int m = 0; m < 4; ++m) _Pragma("unroll") for (int n = 0; n < 2; ++n) _Pragma("unroll") for (int k = 0; k < 2; ++k) \
        acc[ai][bj][m][n] = __builtin_amdgcn_mfma_f32_16x16x32_bf16(Bt[n][k], At[m][k], acc[ai][bj][m][n], 0, 0, 0); __builtin_amdgcn_s_setprio(0); } while (0)
#define PG8_WAIT_V(n) asm volatile("s_waitcnt vmcnt(" #n ")" ::: "memory")
#define PG8_WAIT_L(n) asm volatile("s_waitcnt lgkmcnt(" #n ")" ::: "memory")
#define PG8_BAR __builtin_amdgcn_s_barrier()
#define PG8_SCHED __builtin_amdgcn_sched_barrier(0)
    Unit cur, nxt; int ui = 0;
    if (!S.next(0, cur)) return;
    f32x4 acc[2][2][4][2];
#pragma unroll
    for (int a = 0; a < 2; ++a)
#pragma unroll
        for (int b = 0; b < 2; ++b)
#pragma unroll
            for (int m = 0; m < 4; ++m)
#pragma unroll
                for (int n = 0; n < 2; ++n) acc[a][b][m][n] = (f32x4){0.f, 0.f, 0.f, 0.f};
    bf16x8 At[4][2], B0[2][2], B1[2][2];
    const char* cA = (const char*)g.A + (size_t)cur.pm * tstep; const char* cB = (const char*)g.Bt + (size_t)cur.pn * tstep;
    S.a_ready(cur);
    if constexpr (SP2) {
        PG8_STAGE(PG8_SB(0, 0), cB, voffB); PG8_STAGE(PG8_SB(0, 1), cB + hstep, voffB); PG8_STAGE(PG8_SA(0, 0), cA, voffA); PG8_STAGE(PG8_SA(0, 1), cA + hstep, voffA);
        if (wr == 1) PG8_BAR;
        PG8_WAIT_V(2); PG8_BAR;
        PG8_STAGE(PG8_SB(1, 0), cB + kstep, voffB); PG8_STAGE(PG8_SA(1, 0), cA + kstep, voffA); PG8_STAGE(PG8_SB(1, 1), cB + hstep + kstep, voffB);
        PG8_WAIT_V(6); PG8_BAR;
    } else {
        PG8_STAGE(PG8_SB(0, 0), cB, voffB); PG8_STAGE(PG8_SA(0, 0), cA, voffA); PG8_STAGE(PG8_SB(0, 1), cB + hstep, voffB); PG8_STAGE(PG8_SA(0, 1), cA + hstep, voffA);
        if (wr == 1) PG8_BAR;
        PG8_WAIT_V(4); PG8_BAR;
        PG8_STAGE(PG8_SB(1, 0), cB + kstep, voffB); PG8_STAGE(PG8_SA(1, 0), cA + kstep, voffA); PG8_STAGE(PG8_SB(1, 1), cB + hstep + kstep, voffB);
        PG8_WAIT_V(6); PG8_BAR;
    }
    for (;;) {
        const bool has_next = S.next(ui + 1, nxt);
        const char* nA = has_next ? (const char*)g.A + (size_t)nxt.pm * tstep : cA; const char* nB = has_next ? (const char*)g.Bt + (size_t)nxt.pn * tstep : cB;
        for (int t = 0; t < nt; t += 2) {
            const bool last = (t == nt - 2);
            const char* a1 = cA + (size_t)(t + 1) * kstep;
            const char* a2 = last ? nA : cA + (size_t)(t + 2) * kstep; const char* b2 = last ? nB : cB + (size_t)(t + 2) * kstep;
            const char* a3 = a2 + kstep; const char* b3 = b2 + kstep;
            if (last && has_next) S.a_ready(nxt);
            if constexpr (SP2) {
            PG8_LDB(B0, 0, 0); PG8_LDB(B1, 0, 1); PG8_SCHED; PG8_LDA(At, 0, 0); PG8_STAGE(PG8_SA(1, 1), a1 + hstep, voffA);
            PG8_WAIT_V(8); PG8_WAIT_L(0); PG8_BAR; PG8_MMA(0, 0, At, B0); PG8_MMA(0, 1, At, B1); PG8_BAR; PG8_SCHED;
            PG8_LDA(At, 0, 1); PG8_STAGE(PG8_SB(0, 0), b2, voffB); PG8_STAGE(PG8_SB(0, 1), b2 + hstep, voffB); PG8_STAGE(PG8_SA(0, 0), a2, voffA);
            PG8_WAIT_V(8); PG8_WAIT_L(0); PG8_BAR; PG8_MMA(1, 0, At, B0); PG8_MMA(1, 1, At, B1); PG8_BAR; PG8_SCHED;
            PG8_LDB(B0, 1, 0); PG8_LDB(B1, 1, 1); PG8_SCHED; PG8_LDA(At, 1, 0); PG8_STAGE(PG8_SA(0, 1), a2 + hstep, voffA);
            PG8_WAIT_V(8); PG8_WAIT_L(0); PG8_BAR; PG8_MMA(0, 0, At, B0); PG8_MMA(0, 1, At, B1); PG8_BAR; PG8_SCHED;
            PG8_LDA(At, 1, 1); PG8_STAGE(PG8_SB(1, 0), b3, voffB); PG8_STAGE(PG8_SB(1, 1), b3 + hstep, voffB); PG8_STAGE(PG8_SA(1, 0), a3, voffA);
            PG8_WAIT_V(8); PG8_WAIT_L(0); PG8_BAR; PG8_MMA(1, 0, At, B0); PG8_MMA(1, 1, At, B1); PG8_BAR; PG8_SCHED;
            } else {
            PG8_LDB(B0, 0, 0); PG8_SCHED; PG8_LDA(At, 0, 0); PG8_STAGE(PG8_SA(1, 1), a1 + hstep, voffA);
            PG8_WAIT_L(8); PG8_BAR; PG8_WAIT_L(0); PG8_MMA(0, 0, At, B0); PG8_BAR; PG8_SCHED;
            PG8_LDB(B1, 0, 1); PG8_STAGE(PG8_SB(0, 0), b2, voffB);
            PG8_BAR; PG8_WAIT_L(0); PG8_MMA(0, 1, At, B1); PG8_BAR;
            PG8_LDA(At, 0, 1); PG8_STAGE(PG8_SA(0, 0), a2, voffA);
            PG8_BAR; PG8_WAIT_L(0); PG8_MMA(1, 0, At, B0); PG8_BAR; PG8_SCHED;
            PG8_STAGE(PG8_SB(0, 1), b2 + hstep, voffB);
            PG8_WAIT_V(6); PG8_BAR; PG8_MMA(1, 1, At, B1); PG8_BAR;
            PG8_LDB(B0, 1, 0); PG8_SCHED; PG8_LDA(At, 1, 0); PG8_STAGE(PG8_SA(0, 1), a2 + hstep, voffA);
            PG8_WAIT_L(8); PG8_BAR; PG8_WAIT_L(0); PG8_MMA(0, 0, At, B0); PG8_BAR; PG8_SCHED;
            PG8_LDB(B1, 1, 1); PG8_STAGE(PG8_SB(1, 0), b3, voffB);
            PG8_BAR; PG8_WAIT_L(0); PG8_MMA(0, 1, At, B1); PG8_BAR;
            PG8_LDA(At, 1, 1); PG8_STAGE(PG8_SA(1, 0), a3, voffA);
            PG8_BAR; PG8_WAIT_L(0); PG8_MMA(1, 0, At, B0); PG8_BAR; PG8_SCHED;
            PG8_STAGE(PG8_SB(1, 1), b3 + hstep, voffB);
            PG8_WAIT_V(6); PG8_BAR; PG8_MMA(1, 1, At, B1); PG8_BAR;
            }
        }
        if constexpr (ALIGN_EPI) { if (wr == 0) PG8_BAR; }
        if constexpr (!Epi::AFTER_DRAIN) { E(acc, cur, wr, wc, fr, fq); S.done(cur); }
        if (!has_next) break;
#pragma unroll
        for (int a = 0; a < 2; ++a)
#pragma unroll
            for (int b = 0; b < 2; ++b)
#pragma unroll
                for (int m = 0; m < 4; ++m)
#pragma unroll
                    for (int n = 0; n < 2; ++n) acc[a][b][m][n] = (f32x4){0.f, 0.f, 0.f, 0.f};
        cur = nxt; cA = nA; cB = nB; ++ui;
        if constexpr (ALIGN_EPI) { if (wr == 1) PG8_BAR; }
    }
    PG8_WAIT_V(0);
    if constexpr (!ALIGN_EPI) { if (wr == 0) PG8_BAR; }
    PG8_BAR;
    if constexpr (Epi::AFTER_DRAIN) { E.fused(acc, cur, wr, wc, fr, fq, lds, wid, lane); S.done(cur); }
#undef PG8_SA
#undef PG8_SB
#undef PG8_STAGE
#undef PG8_LDA
#undef PG8_LDB
#undef PG8_MMA
#undef PG8_WAIT_V
#undef PG8_WAIT_L
#undef PG8_BAR
#undef PG8_SCHED
}
}

#define DI __device__ __forceinline__
#define GAS __attribute__((address_space(1)))
#define LAS __attribute__((address_space(3)))
typedef unsigned short bf16;
typedef unsigned v4u __attribute__((ext_vector_type(4)));
typedef unsigned v2u __attribute__((ext_vector_type(2)));
typedef float f32x4 __attribute__((ext_vector_type(4)));
typedef short bf16x8 __attribute__((ext_vector_type(8)));
typedef GAS unsigned gu32;

constexpr int D = 1024, NMAIN = 32768, SEQ = 16384, MR = 33024, CH0ROW = 32768, METAROW = 32816, NMETA = 16, NTOK = NMAIN + NMETA;
constexpr int NCHUNK = 257, NUNIT = 2 * NCHUNK * 4;
constexpr int NPROJ = 3072, NE = 32, FF = 512, PMAXT = 289;
constexpr float ALPHA = 1.41421356237f, LN_EPS = 1e-5f, QSCALE = 0.08838834764831845f, NEGBIG = -1e30f;
constexpr int NWAVES = 8, NTHR = 512;

constexpr size_t MiB = 1u << 20;
constexpr size_t WS_CTL = 0, CTL_ZERO_BYTES = 1 * MiB;
constexpr size_t WS_GATES = 1 * MiB;
constexpr size_t WS_A = WS_GATES + (size_t)MR * 32;
constexpr size_t WS_MX = WS_A + (size_t)MR * 16;
constexpr size_t WS_MT = WS_MX + (size_t)MR * 16;
constexpr size_t WS_GLR = WS_MT + (size_t)MR * 16;
constexpr size_t WS_EID = WS_GLR + (size_t)MR * 64;
constexpr size_t WS_EW = WS_EID + (size_t)NTOK * 8;
constexpr size_t WS_SLOT = WS_EW + (size_t)NTOK * 8;
constexpr size_t WS_GDEC = WS_SLOT + (size_t)NTOK * 8;
constexpr size_t WS_DN = WS_GDEC + (size_t)NUNIT * 512;
constexpr size_t WS_METAF = WS_DN + (size_t)NUNIT * 512;
static_assert(WS_METAF + 65536 <= 10 * MiB, "small buffers");
constexpr size_t WS_WIN = 10 * MiB, WS_WOUT = 16 * MiB, WS_WGU = 18 * MiB, WS_WD = 82 * MiB;
constexpr size_t WS_HB = 114 * MiB;
constexpr size_t WS_ARENA = 179 * MiB;
constexpr size_t WS_Q = WS_ARENA, WS_K = WS_Q + (size_t)MR * 1024, WS_V = WS_K + (size_t)MR * 1024, WS_O = WS_V + (size_t)MR * 2048, WS_ST = WS_O + (size_t)MR * 2048;
constexpr size_t WS_YB = WS_Q;
constexpr size_t WS_XB = WS_V;
constexpr size_t WS_HDN = WS_XB + (size_t)PMAXT * 256 * 2048;
constexpr size_t WS_END = WS_ST + (size_t)NUNIT * 65536;
static_assert(WS_HDN + (size_t)PMAXT * 256 * 1024 <= WS_END, "moe overlay");
static_assert(WS_END == 501 * MiB, "ws map");
constexpr int CW_BAR = 4096;
constexpr int CW_CNT = 16384;
constexpr int CW_CUR = 16384 + 256;
constexpr int LDS_BYTES = 155648, TAB_OFF = 131072, TOP_OFF = 154624;

typedef __bf16 bf16x2_t __attribute__((ext_vector_type(2)));
typedef float f32x2_t __attribute__((ext_vector_type(2)));
DI unsigned pk2(float lo, float hi) { const f32x2_t v = {lo, hi}; return __builtin_bit_cast(unsigned, __builtin_convertvector(v, bf16x2_t)); }
DI unsigned f2bf(float f) { return pk2(f, 0.f) & 0xffffu; }
DI float bflo(unsigned w) { return __builtin_bit_cast(float, w << 16); }
DI float bfhi(unsigned w) { return __builtin_bit_cast(float, w & 0xffff0000u); }
DI float bf2f(bf16 b) { return __builtin_bit_cast(float, (unsigned)b << 16); }
#define LDS_WAIT() asm volatile("s_waitcnt lgkmcnt(0)" ::: "memory")
DI float wave_sum(float v) {
#pragma unroll
    for (int o = 1; o < 64; o <<= 1) v += __shfl_xor(v, o);
    return v;
}
template <int N, int OFF> struct FoldStep {
    template <int NP> static DI float run(float (&p)[NP], int lane) {
        constexpr int half = N / 2; const bool hi = (lane & OFF) != 0;
#pragma unroll
        for (int i = 0; i < half; ++i) { const float keep = hi ? p[half + i] : p[i], send = hi ? p[i] : p[half + i]; p[i] = keep + __shfl_xor(send, OFF); }
        return FoldStep<half, OFF / 2>::run(p, lane);
    }
};
template <int OFF> struct FoldStep<1, OFF> {
    template <int NP> static DI float run(float (&p)[NP], int lane) { float r = p[0];
#pragma unroll
        for (int off = OFF; off >= 1; off >>= 1) r += __shfl_xor(r, off);
        return r; }
};
template <int N> DI float fold_reduce(float (&p)[N], int lane) { return FoldStep<N, 32>::run(p, lane); }
DI float logsig(float z) { return fminf(z, 0.f) - log1pf(expf(-fabsf(z))); }
DI f32x4 mma16(bf16x8 x, bf16x8 y, f32x4 c) { return __builtin_amdgcn_mfma_f32_16x16x32_bf16(x, y, c, 0, 0, 0); }
#define XB_TMO      128
#define XB_XCNT(j)  (256  + 64 * (j))
#define XB_XSUB(j)  (1280 + 64 * (j))
#define XB_XGEN(j)  (2304 + 64 * (j))
#define XB_TOP      3328
#define XB_TOPGEN   3392
#define XCD_BAR_WORDS 3456
#define XB_SPIN_CAP (1u << 18)

__device__ __forceinline__ unsigned xb_ld(unsigned* p)              { return __hip_atomic_load(p, __ATOMIC_RELAXED, __HIP_MEMORY_SCOPE_AGENT); }
__device__ __forceinline__ unsigned xb_add(unsigned* p, unsigned v) { return __hip_atomic_fetch_add(p, v, __ATOMIC_RELAXED, __HIP_MEMORY_SCOPE_AGENT); }
__device__ __forceinline__ unsigned xb_xcc_id() { return (unsigned)__builtin_amdgcn_s_getreg((3 << 11) | 20) & 0xFu; }
#define XB_SPIN(cond, bar) do { unsigned _sp = 0; while (cond) { __builtin_amdgcn_s_sleep(1); \
    if ((++_sp & 255u) == 0u) { if (xb_ld(&(bar)[XB_TMO])) break; if (_sp > XB_SPIN_CAP) { atomicAdd(&(bar)[XB_TMO], 1u); break; } } } } while (0)

struct XcdBarrier {
    unsigned* bar; unsigned x;
    volatile LAS unsigned* st;
};

__device__ __forceinline__ XcdBarrier xcd_barrier_post(unsigned* bar, volatile LAS unsigned* st) {
    XcdBarrier b; b.bar = bar; b.x = xb_xcc_id(); b.st = st;
    if (threadIdx.x == 0) (void)xb_add(&bar[XB_XCNT(b.x)], 1u);
    return b;
}
__device__ __forceinline__ void xcd_barrier_complete(unsigned* bar, unsigned x, unsigned& nloc, unsigned& nx) {
    const unsigned G = gridDim.x * gridDim.y * gridDim.z;
    unsigned sum, cnt, mine, sp = 0u;
    for (;;) {
        sum = 0u; cnt = 0u; mine = 0u;
#pragma unroll
        for (unsigned j = 0; j < 16; ++j) { const unsigned c = xb_ld(&bar[XB_XCNT(j)]); sum += c; cnt += (c > 0u) ? 1u : 0u; mine = (j == x) ? c : mine; }
        if (sum == G) break;
        __builtin_amdgcn_s_sleep(1);
        if ((++sp & 255u) == 0u) { if (xb_ld(&bar[XB_TMO])) break; if (sp > XB_SPIN_CAP) { atomicAdd(&bar[XB_TMO], 1u); break; } }
    }
    nloc = mine > 0u ? mine : 1u; nx = cnt > 0u ? cnt : 1u;
}

__device__ __forceinline__ void xcd_barrier(const XcdBarrier& b) {
    asm volatile("s_waitcnt vmcnt(0)" ::: "memory");
    __syncthreads();
    if (threadIdx.x == 0) {
        unsigned* bar = b.bar;
        __builtin_amdgcn_s_waitcnt(0);
        unsigned nloc = b.st[0], nx = b.st[1];
        if (nloc == 0u) { xcd_barrier_complete(bar, b.x, nloc, nx); b.st[0] = nloc; b.st[1] = nx; }
        const unsigned old = xb_add(&bar[XB_XSUB(b.x)], 1u);
        const unsigned gen = old / nloc;
        if (old + 1u == (gen + 1u) * nloc) {
            __builtin_amdgcn_fence(__ATOMIC_RELEASE, "agent");
            asm volatile("s_waitcnt vmcnt(0)" ::: "memory");
            const unsigned og = xb_add(&bar[XB_TOP], 1u);
            const unsigned tg = og / nx;
            if (og + 1u == (tg + 1u) * nx) xb_add(&bar[XB_TOPGEN], 1u);
            else XB_SPIN(xb_ld(&bar[XB_TOPGEN]) == tg, bar);
            __builtin_amdgcn_fence(__ATOMIC_ACQUIRE, "agent");
            xb_add(&bar[XB_XGEN(b.x)], 1u);
            asm volatile("s_waitcnt vmcnt(0)" ::: "memory");
        } else {
            XB_SPIN(xb_ld(&bar[XB_XGEN(b.x)]) == gen, bar);
            __builtin_amdgcn_fence(__ATOMIC_ACQUIRE, "agent");
            asm volatile("s_waitcnt vmcnt(0)" ::: "memory");
        }
    }
    __syncthreads();
}

struct Args { const float* in[33]; float* out; unsigned char* ws; int ph_lo, ph_hi; };
struct Frame {
    LAS unsigned char* lds;
    gu32* ctl;
    int tid, lane, wave, G, vcu;
    const float* const* in;
    float* out; unsigned char* ws;
};
DI int tok_row(int tok) { return tok < NMAIN ? tok : tok + (METAROW - NMAIN); }

DI void transpose_item(const float* W, int ldw, int k0, int n0, bf16* WT, int Kd, int drow0, LAS float* scr, int lane) {
#pragma unroll 8
    for (int i = 0; i < 32; ++i) { const int kk = 2 * i + (lane >> 5); scr[kk * 33 + (lane & 31)] = W[(size_t)(k0 + kk) * ldw + n0 + (lane & 31)]; }
    LDS_WAIT(); asm volatile("" ::: "memory");
    const int c = lane & 7;
#pragma unroll
    for (int j = 0; j < 4; ++j) { const int n = (lane >> 3) + 8 * j; const LAS float* s = scr + (8 * c) * 33 + n;
        v4u o; o.x = pk2(s[0 * 33], s[1 * 33]); o.y = pk2(s[2 * 33], s[3 * 33]); o.z = pk2(s[4 * 33], s[5 * 33]); o.w = pk2(s[6 * 33], s[7 * 33]);
        *(v4u*)(WT + (size_t)(drow0 + n) * Kd + k0 + 8 * c) = o; }
    LDS_WAIT(); asm volatile("" ::: "memory");
}
template <int L> DI void convert_weights(Frame& F) {
    constexpr int IB = L ? 17 : 2;
    const float* w_in = F.in[IB]; const int ld_in = L ? 3088 : 3080;
    const float* w_out = F.in[L ? 21 : 5];
    const float* w_g = F.in[L ? 28 : 12]; const float* w_u = F.in[L ? 29 : 13]; const float* w_d = F.in[L ? 30 : 14];
    bf16* WIN = (bf16*)(F.ws + WS_WIN); bf16* WOUT = (bf16*)(F.ws + WS_WOUT); bf16* WGU = (bf16*)(F.ws + WS_WGU); bf16* WD = (bf16*)(F.ws + WS_WD);
    LAS float* scr = (LAS float*)(F.lds + F.wave * 16384);
    const int gw = F.vcu * NWAVES + F.wave, NGW = F.G * NWAVES;
    constexpr int I_IN = 16 * 96, I_OUT = 16 * 32, I_G = 32 * 256, I_D = 32 * 256, NITEMS = I_IN + I_OUT + 2 * I_G + I_D;
    for (int it = gw; it < NITEMS; it += NGW) {
        int r = it;
        if (r < I_IN) { const int kb = r / 96, nb = r % 96; transpose_item(w_in, ld_in, 64 * kb, 32 * nb, WIN, 1024, 32 * nb, scr, F.lane); continue; } r -= I_IN;
        if (r < I_OUT) { const int kb = r / 32, nb = r % 32; transpose_item(w_out, 1024, 64 * kb, 32 * nb, WOUT, 1024, 32 * nb, scr, F.lane); continue; } r -= I_OUT;
        if (r < 2 * I_G) { const int up = r >= I_G; if (up) r -= I_G; const int e = r >> 8, rr = r & 255, kb = rr >> 4, nb = rr & 15, n0 = 32 * nb;
            transpose_item((up ? w_u : w_g) + (size_t)e * 1024 * 512, 512, 64 * kb, n0, WGU, 1024, e * 1024 + (n0 >> 7) * 256 + up * 128 + (n0 & 127), scr, F.lane); continue; } r -= 2 * I_G;
        { const int e = r >> 8, rr = r & 255, kb = rr >> 5, nb = rr & 31; transpose_item(w_d + (size_t)e * 512 * 1024, 1024, 64 * kb, 32 * nb, WD, 512, e * 1024 + 32 * nb, scr, F.lane); }
    }
}
template <int NC, int STR> DI void stage_cols(const float* W, int ldw, int col0, LAS float* dst, int tid) {
#pragma unroll 4
    for (int idx = tid; idx < NC * 1024; idx += NTHR) { const int e = idx % NC, k = idx / NC; dst[e * STR + k] = W[(size_t)k * ldw + col0 + e]; }
}
DI void ln_row(f32x4 (&v)[4], const float* lg, const float* lb, int lane) {
    float s = 0.f;
#pragma unroll
    for (int j = 0; j < 4; ++j) s += (v[j].x + v[j].y) + (v[j].z + v[j].w);
    const float mean = wave_sum(s) * (1.f / D); float s2 = 0.f;
#pragma unroll
    for (int j = 0; j < 4; ++j) { v[j] = v[j] - mean; s2 += (v[j].x * v[j].x + v[j].y * v[j].y) + (v[j].z * v[j].z + v[j].w * v[j].w); }
    const float rstd = 1.f / sqrtf(wave_sum(s2) * (1.f / D) + LN_EPS);
#pragma unroll
    for (int j = 0; j < 4; ++j) { const f32x4 g = *(const f32x4*)(lg + 256 * j + 4 * lane), b = *(const f32x4*)(lb + 256 * j + 4 * lane); v[j] = v[j] * rstd * g + b; }
}
DI void store_row_bf16(bf16* orow, const f32x4 (&v)[4], int lane) {
    unsigned long long* o8 = (unsigned long long*)orow + lane;
#pragma unroll
    for (int j = 0; j < 4; ++j) o8[64 * j] = (unsigned long long)pk2(v[j].x, v[j].y) | ((unsigned long long)pk2(v[j].z, v[j].w) << 32);
}
template <int NC, int STR> DI float row_dots(const f32x4 (&v)[4], const LAS float* wl, int lane) {
    float p[NC];
#pragma unroll
    for (int e = 0; e < NC; ++e) { float a = 0.f;
#pragma unroll
        for (int j = 0; j < 4; ++j) { const f32x4 w = *(const LAS f32x4*)(wl + e * STR + 256 * j + 4 * lane); a += (v[j].x * w.x + v[j].y * w.y) + (v[j].z * w.z + v[j].w * w.w); }
        p[e] = a; if ((e & 3) == 3) asm volatile("" : "+v"(p[e - 3]), "+v"(p[e - 2]), "+v"(p[e - 1]), "+v"(p[e]) :: "memory"); }
    return fold_reduce<NC>(p, lane);
}

DI void phase_p0(Frame& F) {
    bf16* HB = (bf16*)(F.ws + WS_HB);
    for (int i = blockIdx.x * NTHR + F.tid; i < 240 * 128; i += F.G * NTHR) { const int ri = i >> 7, r = ri < 48 ? CH0ROW + ri : 32832 + (ri - 48);
        *(v4u*)(HB + (size_t)r * D + (i & 127) * 8) = (v4u){0u, 0u, 0u, 0u}; }
    convert_weights<0>(F);
    __syncthreads();
    LAS float* wg = (LAS float*)F.lds;
    stage_cols<8, 1028>(F.in[2], 3080, 3072, wg, F.tid);
    __syncthreads();
    const float* x = F.in[0]; const float* meta = F.in[1]; const float* bg = F.in[3];
    float* GATES = (float*)(F.ws + WS_GATES);
    const int gw = F.vcu * NWAVES + F.wave, NGW = F.G * NWAVES;
#pragma unroll 1
    for (int tok = gw; tok < NTOK; tok += NGW) {
        const float* src = tok < NMAIN ? x + (size_t)tok * D : meta + (size_t)(tok - NMAIN) * D; const int row = tok_row(tok);
        f32x4 v[4];
#pragma unroll
        for (int j = 0; j < 4; ++j) v[j] = *(const f32x4*)(src + 256 * j + 4 * F.lane);
        store_row_bf16(HB + (size_t)row * D, v, F.lane);
        const float r = row_dots<8, 1028>(v, wg, F.lane);
        if ((F.lane & 7) == 0) GATES[(size_t)row * 8 + (F.lane >> 3)] = r + bg[F.lane >> 3];
    }
}

template <bool MAXOP> DI float block_scan_excl(float val, LAS float* sb, int tid) {
    sb[tid] = val; __syncthreads();
#pragma unroll 1
    for (int off = 1; off < NTHR; off <<= 1) { float t = MAXOP ? -3.0e38f : 0.f; if (tid >= off) t = sb[tid - off]; __syncthreads(); sb[tid] = MAXOP ? fmaxf(sb[tid], t) : sb[tid] + t; __syncthreads(); }
    const float r = tid ? sb[tid - 1] : (MAXOP ? -3.0e38f : 0.f); __syncthreads();
    return r;
}
DI void phase_s1(Frame& F) {
    if (blockIdx.x >= 8) return;
    const int b = blockIdx.x >> 2, h = blockIdx.x & 3, tid = F.tid;
    const float* GATES = (const float*)(F.ws + WS_GATES);
    float* A = (float*)(F.ws + WS_A); float* MX = (float*)(F.ws + WS_MX); float* MT = (float*)(F.ws + WS_MT);
    LAS float* sb = (LAS float*)F.lds; LAS float* bc = sb + 512;
    if (tid == 0) { float B = 0.f, M = 0.f;
        for (int j = 0; j < NMETA; ++j) { const int row = METAROW + j; const float li = GATES[row * 8 + h], lf = logsig(GATES[row * 8 + 4 + h]); B += lf; const float a = li - B; M = fmaxf(M, a);
            if (b == 0) { A[row * 4 + h] = a; MX[row * 4 + h] = M; MT[row * 4 + h] = B + M; } }
        bc[0] = B; bc[1] = M; }
    if (b == 0 && tid < 48) { const int row = CH0ROW + tid; A[row * 4 + h] = NEGBIG; MX[row * 4 + h] = 0.f; MT[row * 4 + h] = 0.f; }
    __syncthreads();
    const float Bm = bc[0], Mm = bc[1];
    const int r0 = b * SEQ + 32 * tid;
    float run = 0.f;
#pragma unroll 4
    for (int j = 0; j < 32; ++j) run += logsig(GATES[(size_t)(r0 + j) * 8 + 4 + h]);
    const float off = block_scan_excl<false>(run, sb, tid) + Bm;
    float Bc = off, mx = -3.0e38f;
#pragma unroll 4
    for (int j = 0; j < 32; ++j) { const size_t row = r0 + j; Bc += logsig(GATES[row * 8 + 4 + h]); const float a = GATES[row * 8 + h] - Bc; mx = fmaxf(mx, a); A[row * 4 + h] = a; MT[row * 4 + h] = Bc; }
    const float pre = fmaxf(block_scan_excl<true>(mx, sb, tid), Mm);
    float M = pre;
#pragma unroll 4
    for (int j = 0; j < 32; ++j) { const size_t row = r0 + j; M = fmaxf(M, A[row * 4 + h]); MX[row * 4 + h] = M; MT[row * 4 + h] += M; }
}

template <int L> DI void phase_t1(Frame& F) {
    LAS float* wr = (LAS float*)F.lds;
    LAS int* hist = (LAS int*)(F.lds + 148032);
    stage_cols<32, 1028>(F.in[L ? 26 : 10], 32, 0, wr, F.tid);
    stage_cols<4, 1028>(F.in[L ? 24 : 8], 4, 0, wr + 32 * 1028, F.tid);
    if (F.tid < 32) hist[F.tid] = 0;
    __syncthreads();
    const float* lg = F.in[L ? 22 : 6]; const float* lb = F.in[L ? 23 : 7]; const float* b_grp = F.in[L ? 25 : 9]; const float* b_rt = F.in[L ? 27 : 11];
    const bf16* YB = (const bf16*)(F.ws + WS_YB); bf16* HB = (bf16*)(F.ws + WS_HB); float* METAF = (float*)(F.ws + WS_METAF);
    int* EID = (int*)(F.ws + WS_EID); float* EW = (float*)(F.ws + WS_EW);
    const int gw = F.vcu * NWAVES + F.wave, NGW = F.G * NWAVES;
#pragma unroll 1
    for (int tok = gw; tok < NTOK; tok += NGW) {
        const int row = tok_row(tok);
        const float* hp = (L == 0) ? (tok < NMAIN ? F.in[0] + (size_t)tok * D : F.in[1] + (size_t)(tok - NMAIN) * D)
                                   : (tok < NMAIN ? F.out + (size_t)tok * D : METAF + (size_t)(tok - NMAIN) * D);
        float* hf = tok < NMAIN ? F.out + (size_t)tok * D : METAF + (size_t)(tok - NMAIN) * D;
        f32x4 v[4];
#pragma unroll
        for (int j = 0; j < 4; ++j) { const f32x4 hv = *(const f32x4*)(hp + 256 * j + 4 * F.lane); const v2u yw = *(const v2u*)(YB + (size_t)row * D + 256 * j + 4 * F.lane);
            v[j].x = ALPHA * hv.x + bflo(yw.x); v[j].y = ALPHA * hv.y + bfhi(yw.x); v[j].z = ALPHA * hv.z + bflo(yw.y); v[j].w = ALPHA * hv.w + bfhi(yw.y); }
        ln_row(v, lg, lb, F.lane);
#pragma unroll
        for (int j = 0; j < 4; ++j) *(f32x4*)(hf + 256 * j + 4 * F.lane) = v[j];
        store_row_bf16(HB + (size_t)row * D, v, F.lane);
        const float r16a = row_dots<16, 1028>(v, wr, F.lane);
        const float r16b = row_dots<16, 1028>(v, wr + 16 * 1028, F.lane);
        const float r4 = row_dots<4, 1028>(v, wr + 32 * 1028, F.lane);
        float gl[4];
#pragma unroll
        for (int j = 0; j < 4; ++j) gl[j] = __shfl(r4, 16 * j) + b_grp[j];
        int gt = 0; float gm = gl[0];
#pragma unroll
        for (int j = 1; j < 4; ++j) if (gl[j] > gm) { gm = gl[j]; gt = j; }
        float se = 0.f;
#pragma unroll
        for (int j = 0; j < 4; ++j) se += expf(gl[j] - gm);
        const float pg = 1.f / se;
        float wv[8];
#pragma unroll
        for (int i = 0; i < 8; ++i) wv[i] = __shfl(gt < 2 ? r16a : r16b, 4 * ((gt & 1) * 8 + i)) + b_rt[gt * 8 + i];
        int i0 = 0; float v0 = wv[0];
#pragma unroll
        for (int i = 1; i < 8; ++i) if (wv[i] > v0) { v0 = wv[i]; i0 = i; }
        int i1 = -1; float v1 = -3.0e38f;
#pragma unroll
        for (int i = 0; i < 8; ++i) if (i != i0 && wv[i] > v1) { v1 = wv[i]; i1 = i; }
        const float e1 = expf(v1 - v0), w0 = 1.f / (1.f + e1), w1 = e1 * w0;
        if (F.lane == 0) { const int ea = gt * 8 + i0, eb = gt * 8 + i1; EID[tok * 2] = ea; EID[tok * 2 + 1] = eb; EW[tok * 2] = pg * w0; EW[tok * 2 + 1] = pg * w1;
            __hip_atomic_fetch_add(&hist[ea], 1, __ATOMIC_RELAXED, __HIP_MEMORY_SCOPE_WORKGROUP); __hip_atomic_fetch_add(&hist[eb], 1, __ATOMIC_RELAXED, __HIP_MEMORY_SCOPE_WORKGROUP); }
    }
    __syncthreads();
    if (F.tid < 32 && hist[F.tid]) atomicAdd((unsigned*)(F.ctl + CW_CNT + 64 * L + F.tid), (unsigned)hist[F.tid]);
}

DI void moe_tables(Frame& F, int L, LAS int* pst, LAS int* cnt) {
    if (F.tid < 32) cnt[F.tid] = (int)__hip_atomic_load(F.ctl + CW_CNT + 64 * L + F.tid, __ATOMIC_RELAXED, __HIP_MEMORY_SCOPE_AGENT);
    __syncthreads();
    if (F.tid == 0) { int s = 0; for (int e = 0; e < 32; ++e) { pst[e] = s; s += ((cnt[e] + 255) >> 8) << 8; } pst[32] = s; }
    __syncthreads();
}
template <int L> DI void phase_d1(Frame& F) {
    LAS int* pst = (LAS int*)F.lds; LAS int* cnt = pst + 40; LAS int* lh = cnt + 32; LAS int* lbase = lh + 32; LAS int* aslot = lbase + 32; LAS int* arow = aslot + 512;
    if (F.tid < 32) lh[F.tid] = 0;
    moe_tables(F, L, pst, cnt);
    const int* EID = (const int*)(F.ws + WS_EID); int* SLOT = (int*)(F.ws + WS_SLOT);
    const bf16* HB = (const bf16*)(F.ws + WS_HB); bf16* XB = (bf16*)(F.ws + WS_XB);
    const int TPB = (NTOK + F.G - 1) / F.G;
    const int t0 = blockIdx.x * TPB; int nt = NTOK - t0; nt = nt < 0 ? 0 : (nt > TPB ? TPB : nt);
    const int i = F.tid; const bool valid = i < 2 * nt; const int tok = t0 + (i >> 1);
    int e = 0, rank = 0;
    if (valid) { e = EID[tok * 2 + (i & 1)]; rank = __hip_atomic_fetch_add(&lh[e], 1, __ATOMIC_RELAXED, __HIP_MEMORY_SCOPE_WORKGROUP); }
    __syncthreads();
    if (F.tid < 32) lbase[F.tid] = lh[F.tid] ? (int)atomicAdd((unsigned*)(F.ctl + CW_CUR + 64 * L + F.tid), (unsigned)lh[F.tid]) : 0;
    __syncthreads();
    if (valid) { const int slot = pst[e] + lbase[e] + rank; SLOT[tok * 2 + (i & 1)] = slot; aslot[i] = slot; arow[i] = tok_row(tok); }
    __syncthreads();
    for (int a = F.wave; a < 2 * nt; a += NWAVES) { const v4u* src = (const v4u*)(HB + (size_t)arow[a] * D); v4u* dst = (v4u*)(XB + (size_t)aslot[a] * D);
        const v4u x0 = src[F.lane], x1 = src[64 + F.lane]; dst[F.lane] = x0; dst[64 + F.lane] = x1; }
    for (int j = blockIdx.x; j < 256; j += F.G) { const int ee = j & 31, part = j >> 5, npad = (((cnt[ee] + 255) >> 8) << 8) - cnt[ee];
        for (int q = part * 8 + F.wave; q < npad; q += 64) { v4u* dst = (v4u*)(XB + (size_t)(pst[ee] + cnt[ee] + q) * D); dst[F.lane] = (v4u){0u, 0u, 0u, 0u}; dst[64 + F.lane] = (v4u){0u, 0u, 0u, 0u}; } }
}

template <int L> DI void phase_t2(Frame& F) {
    LAS float* wl = (LAS float*)F.lds;
#ifndef T2_NOCONV
    if (L == 0) { convert_weights<1>(F); __syncthreads(); }
#endif
    if (L == 0) { stage_cols<16, 1028>(F.in[17], 3088, 3072, wl, F.tid); __syncthreads(); }
    const float* lg = F.in[L ? 31 : 15]; const float* lb = F.in[L ? 32 : 16];
    const bf16* Y2 = (const bf16*)(F.ws + WS_XB); bf16* HB = (bf16*)(F.ws + WS_HB); float* METAF = (float*)(F.ws + WS_METAF); float* GLR = (float*)(F.ws + WS_GLR);
    const int* SLOT = (const int*)(F.ws + WS_SLOT); const float* EW = (const float*)(F.ws + WS_EW);
    const int gw = F.vcu * NWAVES + F.wave, NGW = F.G * NWAVES;
    const int ntok = L ? NMAIN : NTOK;
#pragma unroll 1
    for (int tok = gw; tok < ntok; tok += NGW) {
        const int row = tok_row(tok);
        float* hf = tok < NMAIN ? F.out + (size_t)tok * D : METAF + (size_t)(tok - NMAIN) * D;
        const int s0 = SLOT[tok * 2], s1 = SLOT[tok * 2 + 1]; const float w0 = EW[tok * 2], w1 = EW[tok * 2 + 1];
        f32x4 v[4];
#pragma unroll
        for (int j = 0; j < 4; ++j) { const f32x4 hv = *(const f32x4*)(hf + 256 * j + 4 * F.lane);
            const v2u ya = *(const v2u*)(Y2 + (size_t)s0 * D + 256 * j + 4 * F.lane), yb = *(const v2u*)(Y2 + (size_t)s1 * D + 256 * j + 4 * F.lane);
            v[j].x = ALPHA * hv.x + (w0 * bflo(ya.x) + w1 * bflo(yb.x)); v[j].y = ALPHA * hv.y + (w0 * bfhi(ya.x) + w1 * bfhi(yb.x));
            v[j].z = ALPHA * hv.z + (w0 * bflo(ya.y) + w1 * bflo(yb.y)); v[j].w = ALPHA * hv.w + (w0 * bfhi(ya.y) + w1 * bfhi(yb.y)); }
        ln_row(v, lg, lb, F.lane);
#pragma unroll
        for (int j = 0; j < 4; ++j) *(f32x4*)(hf + 256 * j + 4 * F.lane) = v[j];
        if (L == 0) {
            store_row_bf16(HB + (size_t)row * D, v, F.lane);
            const float r = row_dots<16, 1028>(v, wl, F.lane);
            if ((F.lane & 3) == 0) GLR[(size_t)row * 16 + (F.lane >> 2)] = r;
        }
    }
}

DI void unit_decode(int u, int& b, int& c, int& h, int& row0) { h = u & 3; const int bc = u >> 2; b = bc / NCHUNK; c = bc - b * NCHUNK; row0 = c == 0 ? CH0ROW : b * SEQ + (c - 1) * 64; }
DI int prev_last_row(int c, int row0) { return c == 1 ? METAROW + NMETA - 1 : row0 - 1; }
DI float fexp(float x) { return __builtin_amdgcn_exp2f(x * 1.44269504089f); }
DI float flogsig(float z) { return fminf(z, 0.f) - __builtin_amdgcn_logf(1.f + fexp(-fabsf(z))) * 0.69314718056f; }
DI float frcp(float x) { return __builtin_amdgcn_rcpf(x); }
constexpr int LD_QS = 136, LD_VT = 72, LD_BC = 132;
constexpr int L_QS = 0, L_KS = 17408, L_VT = 34816, L_PS = 71680, L_BC = 80896, L_SC = 114688, L_KT = 0;
static_assert(L_BC + 64 * LD_BC * 4 <= L_SC && L_SC + 8192 <= TAB_OFF, "chunk lds map");

DI void compute_bc(Frame& F, int row0, int h, bool ch0, LAS float* bc, LAS float* sc) {
    LAS float* gl = sc + 1024;
    LAS float* tot = sc + 512;
    const float* GLR = (const float*)(F.ws + WS_GLR); const float* wgu = F.in[18]; const float* bgate = F.in[19];
    if (F.tid < 256) *(LAS f32x4*)(gl + F.tid * 4) = *(const f32x4*)(GLR + (size_t)(row0 + (F.tid >> 2)) * 16 + (F.tid & 3) * 4);
    const int d = F.tid & 127, tq = F.tid >> 7;
    float w[16];
#pragma unroll
    for (int r = 0; r < 16; ++r) w[r] = wgu[r * 512 + h * 128 + d];
    const float bias = bgate[h * 128 + d];
    __syncthreads();
    float run = 0.f;
#pragma unroll 4
    for (int j = 0; j < 16; ++j) { const int t = 16 * tq + j; float z = bias;
#pragma unroll
        for (int r = 0; r < 16; ++r) z += gl[t * 16 + r] * w[r];
        const float la = (ch0 && t < 48) ? 0.f : flogsig(z) * (1.f / 16.f); run += la; bc[t * LD_BC + d] = run; }
    tot[tq * 128 + d] = run;
    __syncthreads();
    float off = 0.f;
#pragma unroll
    for (int q = 0; q < 3; ++q) if (q < tq) off += tot[q * 128 + d];
#pragma unroll 4
    for (int j = 0; j < 16; ++j) bc[(16 * tq + j) * LD_BC + d] += off;
    __syncthreads();
}
template <bool SCALED> DI void stage_vt(Frame& F, const bf16* V, int row0, int h, LAS bf16* VT, float ws) {
    const v4u* src = (const v4u*)(V + (size_t)(row0 + F.lane) * 1024 + h * 256 + 32 * F.wave);
    v4u x[4];
#pragma unroll
    for (int j = 0; j < 4; ++j) x[j] = src[j];
#pragma unroll
    for (int j = 0; j < 4; ++j) { const unsigned wv[4] = {x[j].x, x[j].y, x[j].z, x[j].w};
#pragma unroll
        for (int q = 0; q < 4; ++q) { const int dv = 32 * F.wave + 8 * j + 2 * q;
            if (SCALED) { VT[dv * LD_VT + F.lane] = (bf16)f2bf(bflo(wv[q]) * ws); VT[(dv + 1) * LD_VT + F.lane] = (bf16)f2bf(bfhi(wv[q]) * ws); }
            else { VT[dv * LD_VT + F.lane] = (bf16)(wv[q] & 0xffffu); VT[(dv + 1) * LD_VT + F.lane] = (bf16)(wv[q] >> 16); } } }
}

template <int MIX> DI void phase_aprime(Frame& F) {
    LAS bf16* KT = (LAS bf16*)(F.lds + L_KT); LAS bf16* VT = (LAS bf16*)(F.lds + L_VT); LAS float* BC = (LAS float*)(F.lds + L_BC); LAS float* SC = (LAS float*)(F.lds + L_SC);
    const bf16* Kp = (const bf16*)(F.ws + WS_K); const bf16* Vp = (const bf16*)(F.ws + WS_V); bf16* ST = (bf16*)(F.ws + WS_ST);
    const float* A = (const float*)(F.ws + WS_A); const float* MX = (const float*)(F.ws + WS_MX);
    float* GDEC = (float*)(F.ws + WS_GDEC); float* DN = (float*)(F.ws + WS_DN);
    const int r = F.lane & 15, g = F.lane >> 4;
    for (int u = blockIdx.x; u < NUNIT; u += F.G) {
        int b, c, h, row0; unit_decode(u, b, c, h, row0);
        const v4u* ksrc = (const v4u*)(Kp + (size_t)(row0 + F.lane) * 512 + h * 128 + 16 * F.wave); const v4u kx0 = ksrc[0], kx1 = ksrc[1];
        const v4u* vsrc = (const v4u*)(Vp + (size_t)(row0 + F.lane) * 1024 + h * 256 + 32 * F.wave);
        v4u vx[4];
#pragma unroll
        for (int j = 0; j < 4; ++j) vx[j] = vsrc[j];
        float ws = 1.f, gdec = 1.f;
        if (MIX == 0) { const float Mend = MX[(size_t)(row0 + 63) * 4 + h], Mprev = c == 0 ? 0.f : MX[(size_t)prev_last_row(c, row0) * 4 + h];
            ws = fexp(A[(size_t)(row0 + F.lane) * 4 + h] - Mend); gdec = fexp(Mprev - Mend); }
        __syncthreads();
        if (MIX == 0) { if (F.wave == 0) SC[F.lane] = ws; }
        else compute_bc(F, row0, h, c == 0, BC, SC);
        { const unsigned wv[8] = {kx0.x, kx0.y, kx0.z, kx0.w, kx1.x, kx1.y, kx1.z, kx1.w};
#pragma unroll
          for (int q = 0; q < 8; ++q) { const int d = 16 * F.wave + 2 * q; float k0 = bflo(wv[q]), k1 = bfhi(wv[q]);
              if (MIX == 1) { k0 *= fexp(BC[63 * LD_BC + d] - BC[F.lane * LD_BC + d]); k1 *= fexp(BC[63 * LD_BC + d + 1] - BC[F.lane * LD_BC + d + 1]); }
              KT[d * LD_VT + F.lane] = (bf16)f2bf(k0); KT[(d + 1) * LD_VT + F.lane] = (bf16)f2bf(k1); } }
#pragma unroll
        for (int j = 0; j < 4; ++j) { const unsigned wv[4] = {vx[j].x, vx[j].y, vx[j].z, vx[j].w};
#pragma unroll
            for (int q = 0; q < 4; ++q) { const int dv = 32 * F.wave + 8 * j + 2 * q;
                if (MIX == 0) { VT[dv * LD_VT + F.lane] = (bf16)f2bf(bflo(wv[q]) * ws); VT[(dv + 1) * LD_VT + F.lane] = (bf16)f2bf(bfhi(wv[q]) * ws); }
                else { VT[dv * LD_VT + F.lane] = (bf16)(wv[q] & 0xffffu); VT[(dv + 1) * LD_VT + F.lane] = (bf16)(wv[q] >> 16); } } }
        __syncthreads();
        f32x4 acc[8][2];
#pragma unroll
        for (int dt = 0; dt < 8; ++dt)
#pragma unroll
            for (int nt = 0; nt < 2; ++nt) acc[dt][nt] = (f32x4){0.f, 0.f, 0.f, 0.f};
#pragma unroll
        for (int ks = 0; ks < 2; ++ks) {
            bf16x8 y[2];
#pragma unroll
            for (int nt = 0; nt < 2; ++nt) y[nt] = *(const LAS bf16x8*)(VT + (32 * F.wave + 16 * nt + r) * LD_VT + 32 * ks + 8 * g);
#pragma unroll
            for (int dt = 0; dt < 8; ++dt) { const bf16x8 x = *(const LAS bf16x8*)(KT + (16 * dt + r) * LD_VT + 32 * ks + 8 * g);
#pragma unroll
                for (int nt = 0; nt < 2; ++nt) acc[dt][nt] = mma16(x, y[nt], acc[dt][nt]); }
        }
        bf16* stu = ST + (size_t)u * 32768;
#pragma unroll
        for (int nt = 0; nt < 2; ++nt) { const int dv = 32 * F.wave + 16 * nt + r;
#pragma unroll
            for (int dt = 0; dt < 8; ++dt) { v2u o; o.x = pk2(acc[dt][nt].x, acc[dt][nt].y); o.y = pk2(acc[dt][nt].z, acc[dt][nt].w); *(v2u*)(stu + dv * 128 + 16 * dt + 4 * g) = o; } }
        if (F.tid < 128) { const int d = F.tid;
            if (MIX == 0) { float s = 0.f;
                for (int j = 0; j < 64; ++j) s += bf2f(KT[d * LD_VT + j]) * SC[j];
                DN[(size_t)u * 128 + d] = s; GDEC[(size_t)u * 128 + d] = gdec; }
            else GDEC[(size_t)u * 128 + d] = fexp(BC[63 * LD_BC + d]); }
    }
}

template <int MIX> DI void phase_scan(Frame& F) {
    unsigned* ST = (unsigned*)(F.ws + WS_ST); const float* GDEC = (const float*)(F.ws + WS_GDEC); float* DN = (float*)(F.ws + WS_DN);
    for (int gid = blockIdx.x * NTHR + F.tid; gid < 8 * 16384; gid += F.G * NTHR) {
        const int bh = gid >> 14, e2 = gid & 16383, b = bh >> 2, h = bh & 3, d = (2 * e2) & 127;
        float s0 = 0.f, s1 = 0.f;
        size_t ub = (size_t)(b * NCHUNK) * 4 + h;
        int c = 0;
#pragma unroll 1
        for (; c + 8 <= NCHUNK; c += 8) {
            unsigned x[8]; float g0[8], g1[8];
#pragma unroll
            for (int j = 0; j < 8; ++j) { const size_t u = ub + (size_t)(c + j) * 4; x[j] = ST[u * 16384 + e2]; const float2 gg = *(const float2*)(GDEC + u * 128 + d); g0[j] = gg.x; g1[j] = gg.y; }
#pragma unroll
            for (int j = 0; j < 8; ++j) { const size_t u = ub + (size_t)(c + j) * 4; ST[u * 16384 + e2] = pk2(s0, s1); s0 = g0[j] * s0 + bflo(x[j]); s1 = g1[j] * s1 + bfhi(x[j]); }
        }
        for (; c < NCHUNK; ++c) { const size_t u = ub + (size_t)c * 4; const unsigned x = ST[u * 16384 + e2]; const float2 gg = *(const float2*)(GDEC + u * 128 + d);
            ST[u * 16384 + e2] = pk2(s0, s1); s0 = gg.x * s0 + bflo(x); s1 = gg.y * s1 + bfhi(x); }
    }
    if (MIX == 0) {
        const int gid = blockIdx.x * NTHR + F.tid;
        if (gid < 1024) { const int bh = gid >> 7, d = gid & 127, b = bh >> 2, h = bh & 3; float s = 0.f;
            for (int c = 0; c < NCHUNK; ++c) { const size_t u = (size_t)(b * NCHUNK + c) * 4 + h; const float x = DN[u * 128 + d], gg = GDEC[u * 128 + d]; DN[u * 128 + d] = s; s = gg * s + x; } }
    }
}

template <int MIX> DI void phase_cprime(Frame& F) {
    LAS bf16* QS = (LAS bf16*)(F.lds + L_QS); LAS bf16* KS = (LAS bf16*)(F.lds + L_KS); LAS bf16* VT = (LAS bf16*)(F.lds + L_VT); LAS bf16* PS = (LAS bf16*)(F.lds + L_PS);
    LAS float* BC = (LAS float*)(F.lds + L_BC); LAS float* SC = (LAS float*)(F.lds + L_SC);
    LAS float* sa = SC, *sM = SC + 64, *smt = SC + 128, *sf = SC + 192, *srd = SC + 256, *snh = SC + 320, *red = SC + 448, *stat = SC + 1472;
    const bf16* Qp = (const bf16*)(F.ws + WS_Q); const bf16* Kp = (const bf16*)(F.ws + WS_K); const bf16* Vp = (const bf16*)(F.ws + WS_V); const bf16* Op = (const bf16*)(F.ws + WS_O); bf16* Mo = (bf16*)(F.ws + WS_HB);
    const bf16* ST = (const bf16*)(F.ws + WS_ST);
    const float* A = (const float*)(F.ws + WS_A); const float* MX = (const float*)(F.ws + WS_MX); const float* MT = (const float*)(F.ws + WS_MT); const float* NH = (const float*)(F.ws + WS_DN);
    const float* hnw = F.in[MIX ? 20 : 4];
    const int r = F.lane & 15, g = F.lane >> 4, w = F.wave;
    for (int u = blockIdx.x; u < NUNIT; u += F.G) {
        int b, c, h, row0; unit_decode(u, b, c, h, row0);
        if (b == 1 && c == 0) continue;
        const int rr = F.tid >> 3, ch = F.tid & 7;
        const v4u* qsrc = (const v4u*)(Qp + (size_t)(row0 + rr) * 512 + h * 128 + 16 * ch); const v4u* ksrc = (const v4u*)(Kp + (size_t)(row0 + rr) * 512 + h * 128 + 16 * ch);
        v4u q0 = qsrc[0], q1 = qsrc[1], k0 = ksrc[0], k1 = ksrc[1];
        const v4u* vsrc = (const v4u*)(Vp + (size_t)(row0 + F.lane) * 1024 + h * 256 + 32 * w);
        v4u vx[4];
#pragma unroll
        for (int j = 0; j < 4; ++j) vx[j] = vsrc[j];
        const bf16* stu = ST + (size_t)u * 32768;
        bf16x8 sx[4][2];
#pragma unroll
        for (int ks = 0; ks < 4; ++ks)
#pragma unroll
            for (int nt = 0; nt < 2; ++nt) sx[ks][nt] = *(const bf16x8*)(stu + (32 * w + 16 * nt + r) * 128 + 32 * ks + 8 * g);
        v2u gwv[4][2];
#pragma unroll
        for (int mt = 0; mt < 4; ++mt)
#pragma unroll
            for (int nt = 0; nt < 2; ++nt) gwv[mt][nt] = *(const v2u*)(Op + (size_t)(row0 + 16 * mt + r) * 1024 + h * 256 + 32 * w + 16 * nt + 4 * g);
        __syncthreads();
        if (MIX == 0) {
            if (F.tid < 64) { const size_t row = row0 + F.tid; const float Mprev = c == 0 ? 0.f : MX[(size_t)prev_last_row(c, row0) * 4 + h]; const float Mt = MX[row * 4 + h];
                sa[F.tid] = A[row * 4 + h]; sM[F.tid] = Mt; smt[F.tid] = MT[row * 4 + h]; sf[F.tid] = fexp(Mprev - Mt); }
            else if (F.tid >= 128 && F.tid < 256) snh[F.tid - 128] = NH[(size_t)u * 128 + F.tid - 128];
        } else compute_bc(F, row0, h, c == 0, BC, SC);
        { if (MIX == 1) {
              unsigned qw[8] = {q0.x, q0.y, q0.z, q0.w, q1.x, q1.y, q1.z, q1.w}, kw[8] = {k0.x, k0.y, k0.z, k0.w, k1.x, k1.y, k1.z, k1.w};
#pragma unroll
              for (int j4 = 0; j4 < 4; ++j4) { const f32x4 bv = *(const LAS f32x4*)(BC + rr * LD_BC + 16 * ch + 4 * j4);
#pragma unroll
                  for (int jj = 0; jj < 2; ++jj) { const int j = 2 * j4 + jj; const float b0 = bv[2 * jj], b1 = bv[2 * jj + 1];
                      qw[j] = pk2(bflo(qw[j]) * fexp(b0), bfhi(qw[j]) * fexp(b1)); kw[j] = pk2(bflo(kw[j]) * fexp(-b0), bfhi(kw[j]) * fexp(-b1)); } }
              q0 = (v4u){qw[0], qw[1], qw[2], qw[3]}; q1 = (v4u){qw[4], qw[5], qw[6], qw[7]}; k0 = (v4u){kw[0], kw[1], kw[2], kw[3]}; k1 = (v4u){kw[4], kw[5], kw[6], kw[7]};
          }
          *(LAS v4u*)(QS + rr * LD_QS + 16 * ch) = q0; *(LAS v4u*)(QS + rr * LD_QS + 16 * ch + 8) = q1;
          *(LAS v4u*)(KS + rr * LD_QS + 16 * ch) = k0; *(LAS v4u*)(KS + rr * LD_QS + 16 * ch + 8) = k1; }
#pragma unroll
        for (int j = 0; j < 4; ++j) { const unsigned wv[4] = {vx[j].x, vx[j].y, vx[j].z, vx[j].w};
#pragma unroll
            for (int q = 0; q < 4; ++q) { const int dv = 32 * w + 8 * j + 2 * q; VT[dv * LD_VT + F.lane] = (bf16)(wv[q] & 0xffffu); VT[(dv + 1) * LD_VT + F.lane] = (bf16)(wv[q] >> 16); } }
        __syncthreads();
        { const int st = w >> 1;
#pragma unroll
          for (int tti = 0; tti < 2; ++tti) { const int tt = 2 * (w & 1) + tti; f32x4 acc = (f32x4){0.f, 0.f, 0.f, 0.f};
              if (st <= tt) {
#pragma unroll
                  for (int ks = 0; ks < 4; ++ks) { const bf16x8 x = *(const LAS bf16x8*)(KS + (16 * st + r) * LD_QS + 32 * ks + 8 * g), y = *(const LAS bf16x8*)(QS + (16 * tt + r) * LD_QS + 32 * ks + 8 * g); acc = mma16(x, y, acc); } }
              const int t = 16 * tt + r, s0 = 16 * st + 4 * g; float p[4];
#pragma unroll
              for (int i = 0; i < 4; ++i) { float v = acc[i]; if (MIX == 0) v *= fexp(sa[s0 + i] - sM[t]); p[i] = (s0 + i <= t) ? v : 0.f; }
              v2u o; o.x = pk2(p[0], p[1]); o.y = pk2(p[2], p[3]); *(LAS v2u*)(PS + t * LD_VT + s0) = o; } }
        __syncthreads();
        if (MIX == 0) {
            const int t = F.tid >> 3, part = F.tid & 7;
            const v4u pw = *(const LAS v4u*)(PS + t * LD_VT + 8 * part), qa = *(const LAS v4u*)(QS + t * LD_QS + 16 * part), qb = *(const LAS v4u*)(QS + t * LD_QS + 16 * part + 8);
            float di = (bflo(pw.x) + bfhi(pw.x)) + (bflo(pw.y) + bfhi(pw.y)) + (bflo(pw.z) + bfhi(pw.z)) + (bflo(pw.w) + bfhi(pw.w));
            const unsigned qq[8] = {qa.x, qa.y, qa.z, qa.w, qb.x, qb.y, qb.z, qb.w}; float dq = 0.f;
#pragma unroll
            for (int j = 0; j < 8; ++j) dq += bflo(qq[j]) * snh[16 * part + 2 * j] + bfhi(qq[j]) * snh[16 * part + 2 * j + 1];
            float den = di + sf[t] * dq;
            den += __shfl_xor(den, 1); den += __shfl_xor(den, 2); den += __shfl_xor(den, 4);
            if (part == 0) srd[t] = frcp(fmaxf(fabsf(den), fexp(-smt[t]))); }
        f32x4 acc1[2][4], acc2[2][4];
#pragma unroll
        for (int nt = 0; nt < 2; ++nt)
#pragma unroll
            for (int mt = 0; mt < 4; ++mt) { acc1[nt][mt] = (f32x4){0.f, 0.f, 0.f, 0.f}; acc2[nt][mt] = (f32x4){0.f, 0.f, 0.f, 0.f}; }
#pragma unroll
        for (int ks = 0; ks < 4; ++ks) {
            bf16x8 y[4];
#pragma unroll
            for (int mt = 0; mt < 4; ++mt) y[mt] = *(const LAS bf16x8*)(QS + (16 * mt + r) * LD_QS + 32 * ks + 8 * g);
#pragma unroll
            for (int nt = 0; nt < 2; ++nt)
#pragma unroll
                for (int mt = 0; mt < 4; ++mt) acc2[nt][mt] = mma16(sx[ks][nt], y[mt], acc2[nt][mt]);
        }
#pragma unroll
        for (int ks = 0; ks < 2; ++ks) {
            bf16x8 x[2], y[4];
#pragma unroll
            for (int nt = 0; nt < 2; ++nt) x[nt] = *(const LAS bf16x8*)(VT + (32 * w + 16 * nt + r) * LD_VT + 32 * ks + 8 * g);
#pragma unroll
            for (int mt = 0; mt < 4; ++mt) y[mt] = *(const LAS bf16x8*)(PS + (16 * mt + r) * LD_VT + 32 * ks + 8 * g);
#pragma unroll
            for (int nt = 0; nt < 2; ++nt)
#pragma unroll
                for (int mt = 0; mt < 4; ++mt) acc1[nt][mt] = mma16(x[nt], y[mt], acc1[nt][mt]);
        }
        if (MIX == 0) __syncthreads();
#pragma unroll
        for (int mt = 0; mt < 4; ++mt) { const int t = 16 * mt + r; float s1 = 0.f, s2 = 0.f;
            const float ft = MIX == 0 ? sf[t] : 1.f, rd = MIX == 0 ? srd[t] : 1.f;
#pragma unroll
            for (int nt = 0; nt < 2; ++nt) { f32x4 hv = (acc1[nt][mt] + acc2[nt][mt] * ft) * rd; acc1[nt][mt] = hv; s1 += (hv.x + hv.y) + (hv.z + hv.w); s2 += (hv.x * hv.x + hv.y * hv.y) + (hv.z * hv.z + hv.w * hv.w); }
            s1 += __shfl_xor(s1, 16); s1 += __shfl_xor(s1, 32); s2 += __shfl_xor(s2, 16); s2 += __shfl_xor(s2, 32);
            if (g == 0) { red[(w * 64 + t) * 2] = s1; red[(w * 64 + t) * 2 + 1] = s2; } }
        __syncthreads();
        if (F.tid < 64) { float s1 = 0.f, s2 = 0.f;
#pragma unroll
            for (int ww = 0; ww < 8; ++ww) { s1 += red[(ww * 64 + F.tid) * 2]; s2 += red[(ww * 64 + F.tid) * 2 + 1]; }
            if (MIX == 0) { const float mean = s1 * (1.f / 256.f), var = fmaxf(s2 * (1.f / 256.f) - mean * mean, 0.f); stat[F.tid * 2] = mean; stat[F.tid * 2 + 1] = 1.f / sqrtf(var + LN_EPS); }
            else { stat[F.tid * 2] = 0.f; stat[F.tid * 2 + 1] = 1.f / sqrtf(s2 * (1.f / 256.f) + LN_EPS); } }
        __syncthreads();
#pragma unroll
        for (int mt = 0; mt < 4; ++mt) { const int t = 16 * mt + r; const float mean = stat[t * 2], rstd = stat[t * 2 + 1];
#pragma unroll
            for (int nt = 0; nt < 2; ++nt) { const int dv = 32 * w + 16 * nt + 4 * g; const size_t oi = (size_t)(row0 + t) * 1024 + h * 256 + dv;
                const v2u gw = gwv[mt][nt]; const f32x4 hn = *(const f32x4*)(hnw + h * 256 + dv); const f32x4 hv = acc1[nt][mt];
                const float gi[4] = {bflo(gw.x), bfhi(gw.x), bflo(gw.y), bfhi(gw.y)}; float o[4];
#pragma unroll
                for (int i = 0; i < 4; ++i) { const float sg = frcp(1.f + fexp(-gi[i])); o[i] = (hv[i] - mean) * rstd * hn[i] * (MIX == 0 ? sg : gi[i] * sg); }
                v2u ow; ow.x = pk2(o[0], o[1]); ow.y = pk2(o[2], o[3]); *(v2u*)(Mo + oi) = ow; } }
    }
}

struct EpiProj {
    static constexpr bool PERM = true, AFTER_DRAIN = false;
    bf16 *Q, *K, *V, *O;
    DI void operator()(const f32x4 (&acc)[2][2][4][2], const pg8::Unit& u, int wr, int wc, int fr, int fq) const {
        bf16* base; int ld, colt; float sc = 1.f; const int pn = u.pn;
        if (pn < 2) { base = Q; ld = 512; colt = pn * 256; sc = QSCALE; } else if (pn < 4) { base = K; ld = 512; colt = (pn - 2) * 256; }
        else if (pn < 8) { base = V; ld = 1024; colt = (pn - 4) * 256; } else { base = O; ld = 1024; colt = (pn - 8) * 256; }
        const int row0 = u.pm * 256 + wr * 64 + fr, col0 = colt + wc * 32 + 8 * fq;
#pragma unroll
        for (int ai = 0; ai < 2; ++ai)
#pragma unroll
            for (int m = 0; m < 4; ++m) { bf16* rowp = base + (size_t)(row0 + ai * 128 + m * 16) * ld + col0;
#pragma unroll
                for (int bj = 0; bj < 2; ++bj) { const f32x4 v0 = acc[ai][bj][m][0] * sc, v1 = acc[ai][bj][m][1] * sc;
                    v4u w; w.x = pk2(v0[0], v0[1]); w.y = pk2(v0[2], v0[3]); w.z = pk2(v1[0], v1[1]); w.w = pk2(v1[2], v1[3]);
                    *(v4u*)(rowp + bj * 128) = w; } }
    }
};
struct EpiPlain {
    static constexpr bool PERM = true, AFTER_DRAIN = false;
    bf16* O;
    DI void operator()(const f32x4 (&acc)[2][2][4][2], const pg8::Unit& u, int wr, int wc, int fr, int fq) const {
        const int row0 = u.pm * 256 + wr * 64 + fr, col0 = (u.pn & 3) * 256 + wc * 32 + 8 * fq;
#pragma unroll
        for (int ai = 0; ai < 2; ++ai)
#pragma unroll
            for (int m = 0; m < 4; ++m) { bf16* rowp = O + (size_t)(row0 + ai * 128 + m * 16) * 1024 + col0;
#pragma unroll
                for (int bj = 0; bj < 2; ++bj) { const f32x4 v0 = acc[ai][bj][m][0], v1 = acc[ai][bj][m][1];
                    v4u w; w.x = pk2(v0[0], v0[1]); w.y = pk2(v0[2], v0[3]); w.z = pk2(v1[0], v1[1]); w.w = pk2(v1[2], v1[3]);
                    *(v4u*)(rowp + bj * 128) = w; } }
    }
};
struct EpiGU {
    static constexpr bool PERM = true, AFTER_DRAIN = false;
    bf16* Hd;
    DI void operator()(const f32x4 (&acc)[2][2][4][2], const pg8::Unit& u, int wr, int wc, int fr, int fq) const {
        const int row0 = u.pm * 256 + wr * 64 + fr, col0 = (u.pn & 3) * 128 + wc * 32 + 8 * fq;
#pragma unroll
        for (int ai = 0; ai < 2; ++ai)
#pragma unroll
            for (int m = 0; m < 4; ++m) { float o[8];
#pragma unroll
                for (int n = 0; n < 2; ++n)
#pragma unroll
                    for (int i = 0; i < 4; ++i) { const float gte = acc[ai][0][m][n][i], up = acc[ai][1][m][n][i]; o[4 * n + i] = gte * __builtin_amdgcn_rcpf(1.f + __expf(-gte)) * up; }
                v4u w; w.x = pk2(o[0], o[1]); w.y = pk2(o[2], o[3]); w.z = pk2(o[4], o[5]); w.w = pk2(o[6], o[7]);
                *(v4u*)(Hd + (size_t)(row0 + ai * 128 + m * 16) * 512 + col0) = w; }
    }
};
struct MoeOrder {
    const LAS int* tile_e; int nunits, G, c;
    DI bool next(int i, pg8::Unit& u) const { const int L = i * G + c; if (L >= nunits) return false; const int t = L >> 2; const int e = __builtin_amdgcn_readfirstlane(tile_e[t]); u.pm = t; u.pn = e * 4 + (L & 3); return true; }
    DI void a_ready(const pg8::Unit&) const {}
    DI void done(const pg8::Unit&) const {}
};
DI int moe_order_setup(Frame& F, int L) {
    LAS int* pst = (LAS int*)(F.lds + TAB_OFF); LAS int* cnt = pst + 40; LAS int* tile_e = pst + 128;
    moe_tables(F, L, pst, cnt);
    const int ntiles = pst[32] >> 8;
    for (int t = F.tid; t < ntiles; t += NTHR) { int e = 0;
        for (int q = 1; q < 32; ++q) if (pst[q] <= t * 256) e = q;
        tile_e[t] = e; }
    __syncthreads();
    return ntiles;
}

DI void gemm_g1(Frame& F) { pg8::Gemm gm{(const bf16*)(F.ws + WS_HB), (const bf16*)(F.ws + WS_WIN), MR, NPROJ, D}; pg8::StaticOrder S; S.init(MR, NPROJ, F.G, (int)blockIdx.x);
    EpiProj E{(bf16*)(F.ws + WS_Q), (bf16*)(F.ws + WS_K), (bf16*)(F.ws + WS_V), (bf16*)(F.ws + WS_O)};
    pg8::gemm_phase<EpiProj, pg8::StaticOrder, true, true>(F.lds, gm, S, E); }
DI void gemm_g2(Frame& F) { pg8::Gemm gm{(const bf16*)(F.ws + WS_HB), (const bf16*)(F.ws + WS_WOUT), MR, D, D}; pg8::StaticOrder S; S.init(MR, D, F.G, (int)blockIdx.x);
    EpiPlain E{(bf16*)(F.ws + WS_YB)};
    pg8::gemm_phase<EpiPlain, pg8::StaticOrder, true, true>(F.lds, gm, S, E); }
DI void gemm_g3(Frame& F, int L) { const int ntiles = moe_order_setup(F, L);
    pg8::Gemm gm{(const bf16*)(F.ws + WS_XB), (const bf16*)(F.ws + WS_WGU), 0, 0, D}; MoeOrder S{(const LAS int*)(F.lds + TAB_OFF) + 128, ntiles * 4, F.G, F.vcu};
    EpiGU E{(bf16*)(F.ws + WS_HDN)};
    pg8::gemm_phase<EpiGU, MoeOrder, true, true>(F.lds, gm, S, E); }
DI void gemm_g4(Frame& F, int L) { const int ntiles = moe_order_setup(F, L);
    pg8::Gemm gm{(const bf16*)(F.ws + WS_HDN), (const bf16*)(F.ws + WS_WD), 0, 0, FF}; MoeOrder S{(const LAS int*)(F.lds + TAB_OFF) + 128, ntiles * 4, F.G, F.vcu};
    EpiPlain E{(bf16*)(F.ws + WS_XB)};
    pg8::gemm_phase<EpiPlain, MoeOrder, true, true>(F.lds, gm, S, E); }

constexpr int NPHASE = 23;
#ifndef PH_MASK
#define PH_MASK 0xFFFu
#endif
#define EN(i) (((PH_MASK) >> (i)) & 1u)
#ifndef PH_REP
#define PH_REP 0u
#endif
#define REPS(i) ((((PH_REP) >> (i)) & 1u) ? 2 : 1)
template <int L> DI void layer_phases(Frame& F, const XcdBarrier& bar, int lo, int hi) {
    constexpr int P = 1 + 11 * L;
#define IN(k) (lo <= (k) && (k) < hi)
#define SEAM(k) do { if (IN(k) && IN((k) + 1)) xcd_barrier(bar); } while (0)
    if (EN(0) && IN(P + 0)) { gemm_g1(F); if (REPS(0) == 2) gemm_g1(F); }
    SEAM(P + 0);
    if (EN(1) && IN(P + 1)) { if (L == 0) { phase_s1(F); if (REPS(1) == 2) { __syncthreads(); phase_s1(F); } } }
    if (L == 0) SEAM(P + 1);
    if (EN(2) && IN(P + 2)) { phase_aprime<L>(F); if (REPS(2) == 2) phase_aprime<L>(F); }
    SEAM(P + 2);
    if (EN(3) && IN(P + 3)) phase_scan<L>(F);
    SEAM(P + 3);
    if (EN(4) && IN(P + 4)) { phase_cprime<L>(F); if (REPS(4) == 2) phase_cprime<L>(F); }
    SEAM(P + 4);
    if (EN(5) && IN(P + 5)) { gemm_g2(F); if (REPS(5) == 2) gemm_g2(F); }
    SEAM(P + 5);
    if (EN(6) && IN(P + 6)) phase_t1<L>(F);
    SEAM(P + 6);
    if (EN(7) && IN(P + 7)) phase_d1<L>(F);
    SEAM(P + 7);
    if (EN(8) && IN(P + 8)) { gemm_g3(F, L); if (REPS(8) == 2) gemm_g3(F, L); }
    SEAM(P + 8);
    if (EN(9) && IN(P + 9)) { gemm_g4(F, L); if (REPS(9) == 2) gemm_g4(F, L); }
    SEAM(P + 9);
    if (EN(10) && IN(P + 10)) phase_t2<L>(F);
    if (L == 0) SEAM(P + 10);
#undef IN
#undef SEAM
}

__global__ void __launch_bounds__(NTHR, 2) hybrid_fwd(Args args) {
    extern __shared__ __attribute__((aligned(16))) unsigned char lds[];
    Frame F;
    F.lds = (LAS unsigned char*)lds;
    F.tid = threadIdx.x; F.lane = F.tid & 63; F.wave = __builtin_amdgcn_readfirstlane(F.tid >> 6);
    F.G = gridDim.x; { const int bx = blockIdx.x; F.vcu = (F.G % 8 == 0) ? (bx % 8) * (F.G / 8) + bx / 8 : bx; }
    F.in = args.in; F.out = args.out; F.ws = args.ws;
    F.ctl = (gu32*)(args.ws + WS_CTL);
    volatile LAS unsigned* MISC = (volatile LAS unsigned*)(F.lds + TOP_OFF);
    if (F.tid < 64) MISC[F.tid] = 0u;
    __syncthreads();
    const int lo = args.ph_lo, hi = args.ph_hi;
    XcdBarrier bar; bar.bar = (unsigned*)(F.ctl + CW_BAR); bar.x = 0; bar.st = nullptr;
    if (hi - lo > 1) bar = xcd_barrier_post((unsigned*)(F.ctl + CW_BAR), MISC + 8);
    if (lo <= 0 && 0 < hi) { if (EN(11)) { phase_p0(F); if (REPS(11) == 2) { __syncthreads(); phase_p0(F); } } if (hi > 1) xcd_barrier(bar); }
    layer_phases<0>(F, bar, lo, hi);
    layer_phases<1>(F, bar, lo, hi);
}

#ifndef MK_PER_PHASE
#define MK_PER_PHASE 0
#endif
extern "C" void kernel_launch(void* const* d_in, const int* in_sizes, int n_in, void* d_out, int out_size, void* d_ws, size_t ws_size, hipStream_t stream) {
    static int grid = 0;
    if (grid == 0) {
        if (n_in != 33 || in_sizes[0] != NMAIN * D || out_size != NMAIN * D || ws_size < WS_END) { fprintf(stderr, "kernel_launch: unexpected shapes (n_in %d, in0 %d, out %d, ws %zu)\n", n_in, n_in > 0 ? in_sizes[0] : -1, out_size, ws_size); grid = -1; return; }
        if (hipFuncSetAttribute((const void*)hybrid_fwd, hipFuncAttributeMaxDynamicSharedMemorySize, LDS_BYTES) != hipSuccess) { fprintf(stderr, "kernel_launch: hipFuncSetAttribute failed\n"); grid = -1; return; }
        int dev = 0, cus = 0, per_cu = 0;
        (void)hipGetDevice(&dev); (void)hipDeviceGetAttribute(&cus, hipDeviceAttributeMultiprocessorCount, dev);
        if (hipOccupancyMaxActiveBlocksPerMultiprocessor(&per_cu, (const void*)hybrid_fwd, NTHR, LDS_BYTES) != hipSuccess || per_cu < 1) fprintf(stderr, "kernel_launch: occupancy query reports %d blocks per CU\n", per_cu);
        (void)hipGetLastError();
        grid = 256;
        if (cus < 256) { fprintf(stderr, "kernel_launch: device has %d CUs, need 256\n", cus); grid = -1; return; }
    }
    if (grid < 0) return;
    (void)hipMemsetAsync((char*)d_ws + WS_CTL, 0, CTL_ZERO_BYTES, stream);
    Args a{};
    for (int i = 0; i < 33; ++i) a.in[i] = (const float*)d_in[i];
    a.out = (float*)d_out; a.ws = (unsigned char*)d_ws;
#if MK_PER_PHASE
    for (int p = 0; p < NPHASE; ++p) { a.ph_lo = p; a.ph_hi = p + 1; hipLaunchKernelGGL(hybrid_fwd, dim3(grid), dim3(NTHR), LDS_BYTES, stream, a); }
#else
    a.ph_lo = 0; a.ph_hi = NPHASE;
    hipLaunchKernelGGL(hybrid_fwd, dim3(grid), dim3(NTHR), LDS_BYTES, stream, a);
#endif
}
```

```cpp
#include <hip/hip_runtime.h>
#include <cstdio>
#include <cstdint>
namespace pg8 {
#define PG8_LAS __attribute__((address_space(3)))
typedef unsigned short bf16_t;
typedef short bf16x8 __attribute__((ext_vector_type(8)));
typedef float f32x4 __attribute__((ext_vector_type(4)));
typedef unsigned u32x4 __attribute__((ext_vector_type(4)));
constexpr int BM = 256, BK = 64, HALF = 128, HTB = HALF * BK * 2  , STAGE_BYTES = 8 * HTB, NXCD = 8, WGM = 8;

__host__ __device__ __forceinline__ int lds_byte(int r, int c) { const int st = (r >> 4) * 2 + (c >> 5), rr = r & 15, cc = c & 31, ob = rr * 64 + cc * 2; return st * 1024 + (ob ^ (((ob >> 9) & 1) << 5)); }
__host__ __device__ __forceinline__ void stage_rc(int b, int& R, int& C) { const int st = b / 1024, sb = b % 1024, swz = sb ^ (((sb >> 9) & 1) << 5); R = (st >> 1) * 16 + swz / 64; C = (st & 1) * 32 + (swz % 64) / 2; }
__host__ __device__ __forceinline__ int perm32(int rho) { const int n = rho >> 4, i = rho & 15; return 8 * (i >> 2) + 4 * n + (i & 3); }

struct Unit { int pm, pn; };
struct Gemm { const bf16_t* A; const bf16_t* Bt; int M, N, K; };

struct StaticOrder {
    static constexpr bool GATHER = false;
    int nM, nN, nwg, G, c;
    __host__ __device__ void init(int M, int N, int G_, int c_) { nM = M / BM; nN = N / BM; nwg = nM * nN; G = G_; c = c_; }
    __host__ __device__ bool next(int i, Unit& u) const {
        const long L = (long)i * G + c; if (L >= nwg) return false;
        int wgid = (int)L; { const int q = nwg / NXCD, r = nwg % NXCD, xcd = wgid % NXCD, off = wgid / NXCD; wgid = (xcd < r ? xcd * (q + 1) : r * (q + 1) + (xcd - r) * q) + off; }
        const int nig = WGM * nN, gid = wgid / nig, fm = gid * WGM, gsz = (nM - fm) < WGM ? (nM - fm) : WGM;
        u.pm = fm + ((wgid % nig) % gsz); u.pn = (wgid % nig) / gsz; return true;
    }
    __device__ __forceinline__ void a_ready(const Unit&) const {}
    __device__ __forceinline__ void done(const Unit&) const {}
};

__device__ __forceinline__ unsigned cvt_pk_bf16(float lo, float hi) { unsigned r; asm volatile("v_cvt_pk_bf16_f32 %0, %1, %2" : "=v"(r) : "v"(lo), "v"(hi)); return r; }
template <class Epi, class Sched, bool ALIGN_EPI = false, bool SP2 = false>
__device__ __forceinline__ void gemm_phase(PG8_LAS unsigned char* lds, const Gemm g, const Sched& S, const Epi& E) {
    const int tid = threadIdx.x, wid = __builtin_amdgcn_readfirstlane(tid >> 6), lane = tid & 63, wr = wid >> 2, wc = wid & 3, fr = lane & 15, fq = lane >> 4;
    const int K = g.K, nt = K / BK;
    unsigned voffA[2], voffB[2];
#pragma unroll
    for (int i = 0; i < 2; ++i) { int R, C; stage_rc(tid * 16 + i * 8192, R, C); const int Rb = Epi::PERM ? ((R & ~31) + perm32(R & 31)) : R;
        voffA[i] = (unsigned)(R * K + C) * 2u; voffB[i] = (unsigned)(Rb * K + C) * 2u; }
    unsigned gc[2][2] = {{0u, 0u}, {0u, 0u}}, gn[2][2] = {{0u, 0u}, {0u, 0u}}; int gR[2] = {0, 0}; unsigned gC[2] = {0u, 0u};
    if constexpr (Sched::GATHER) { static_assert(SP2, "GATHER is written for the SP2 loop only");
#pragma unroll
        for (int i = 0; i < 2; ++i) { int R, C; stage_rc(tid * 16 + i * 8192, R, C); gR[i] = R; gC[i] = (unsigned)C * 2u; } }
    const char* gA0 = (const char*)g.A;
    const size_t kstep = (size_t)(BK * 2);
    const size_t hstep = (size_t)HALF * K * 2;
    const size_t tstep = 2 * hstep;
    const unsigned ldsw = (unsigned)wid * 1024u;
    const int aoff = lds_byte(wr * 64 + fr, fq * 8), boff = lds_byte(wc * 32 + fr, fq * 8);
#define PG8_SA(b, h) (((b) * 2 + (h)) * HTB)
#define PG8_SB(b, h) ((4 + (b) * 2 + (h)) * HTB)
#define PG8_STAGE(bufoff, gbase, voff) do { _Pragma("unroll") for (int _i = 0; _i < 2; ++_i) \
        __builtin_amdgcn_global_load_lds((const unsigned*)((const char*)(gbase) + (voff)[_i]), (PG8_LAS unsigned*)(lds + (bufoff) + ldsw + _i * 8192), 16, 0, 0); } while (0)
#define PG8_LDA(dst, b, h) do { _Pragma("unroll") for (int m = 0; m < 4; ++m) _Pragma("unroll") for (int k = 0; k < 2; ++k) dst[m][k] = *(const PG8_LAS bf16x8*)(lds + PG8_SA(b, h) + aoff + m * 2048 + k * 1024); } while (0)
#define PG8_LDB(dst, b, h) do { _Pragma("unroll") for (int n = 0; n < 2; ++n) _Pragma("unroll") for (int k = 0; k < 2; ++k) dst[n][k] = *(const PG8_LAS bf16x8*)(lds + PG8_SB(b, h) + boff + n * 2048 + k * 1024); } while (0)
#define PG8_MMA(ai, bj, At, Bt) do { __builtin_amdgcn_s_setprio(1); _Pragma("unroll") for (int m = 0; m < 4; ++m) _Pragma("unroll") for (int n = 0; n < 2; ++n) _Pragma("unroll") for (int k = 0; k < 2; ++k) \
        acc[ai][bj][m][n] = __builtin_amdgcn_mfma_f32_16x16x32_bf16(Bt[n][k], At[m][k], acc[ai][bj][m][n], 0, 0, 0); __builtin_amdgcn_s_setprio(0); } while (0)
#define PG8_WAIT_V(n) asm volatile("s_waitcnt vmcnt(" #n ")" ::: "memory")
#define PG8_WAIT_L(n) asm volatile("s_waitcnt lgkmcnt(" #n ")" ::: "memory")
#define PG8_BAR __builtin_amdgcn_s_barrier()
#define PG8_SCHED __builtin_amdgcn_sched_barrier(0)
    Unit cur, nxt; int ui = 0;
    if (!S.next(0, cur)) return;
    f32x4 acc[2][2][4][2];
#pragma unroll
    for (int a = 0; a < 2; ++a)
#pragma unroll
        for (int b = 0; b < 2; ++b)
#pragma unroll
            for (int m = 0; m < 4; ++m)
#pragma unroll
                for (int n = 0; n < 2; ++n) acc[a][b][m][n] = (f32x4){0.f, 0.f, 0.f, 0.f};
    bf16x8 At[4][2], B0[2][2], B1[2][2];
    const char* cA = (const char*)g.A + (size_t)cur.pm * tstep; const char* cB = (const char*)g.Bt + (size_t)cur.pn * tstep;
    S.a_ready(cur);
    if constexpr (Sched::GATHER) {
#pragma unroll
        for (int h = 0; h < 2; ++h)
#pragma unroll
            for (int i = 0; i < 2; ++i) gc[h][i] = S.rowoff(0, h * HALF + gR[i]) + gC[i]; }
    if constexpr (SP2) {
        PG8_STAGE(PG8_SB(0, 0), cB, voffB); PG8_STAGE(PG8_SB(0, 1), cB + hstep, voffB);
        if constexpr (Sched::GATHER) { PG8_STAGE(PG8_SA(0, 0), gA0, gc[0]); PG8_STAGE(PG8_SA(0, 1), gA0, gc[1]); } else { PG8_STAGE(PG8_SA(0, 0), cA, voffA); PG8_STAGE(PG8_SA(0, 1), cA + hstep, voffA); }
        if (wr == 1) PG8_BAR;
        PG8_WAIT_V(2); PG8_BAR;
        PG8_STAGE(PG8_SB(1, 0), cB + kstep, voffB); if constexpr (Sched::GATHER) { PG8_STAGE(PG8_SA(1, 0), gA0 + kstep, gc[0]); } else { PG8_STAGE(PG8_SA(1, 0), cA + kstep, voffA); } PG8_STAGE(PG8_SB(1, 1), cB + hstep + kstep, voffB);
        PG8_WAIT_V(6); PG8_BAR;
    } else {
        PG8_STAGE(PG8_SB(0, 0), cB, voffB); PG8_STAGE(PG8_SA(0, 0), cA, voffA); PG8_STAGE(PG8_SB(0, 1), cB + hstep, voffB); PG8_STAGE(PG8_SA(0, 1), cA + hstep, voffA);
        if (wr == 1) PG8_BAR;
        PG8_WAIT_V(4); PG8_BAR;
        PG8_STAGE(PG8_SB(1, 0), cB + kstep, voffB); PG8_STAGE(PG8_SA(1, 0), cA + kstep, voffA); PG8_STAGE(PG8_SB(1, 1), cB + hstep + kstep, voffB);
        PG8_WAIT_V(6); PG8_BAR;
    }
    for (;;) {
        const bool has_next = S.next(ui + 1, nxt);
        const char* nA = has_next ? (const char*)g.A + (size_t)nxt.pm * tstep : cA; const char* nB = has_next ? (const char*)g.Bt + (size_t)nxt.pn * tstep : cB;
        if constexpr (Sched::GATHER) {
#pragma unroll
            for (int h = 0; h < 2; ++h)
#pragma unroll
                for (int i = 0; i < 2; ++i) gn[h][i] = has_next ? S.rowoff(ui + 1, h * HALF + gR[i]) + gC[i] : gc[h][i]; }
        for (int t = 0; t < nt; t += 2) {
            const bool last = (t == nt - 2);
            const char* a1 = cA + (size_t)(t + 1) * kstep;
            const char* a2 = last ? nA : cA + (size_t)(t + 2) * kstep; const char* b2 = last ? nB : cB + (size_t)(t + 2) * kstep;
            const char* a3 = a2 + kstep; const char* b3 = b2 + kstep;
            if (last && has_next) S.a_ready(nxt);
            if constexpr (SP2) {
            const size_t gk2 = last ? (size_t)0 : (size_t)(t + 2) * kstep;
            unsigned g2[2][2];
            if constexpr (Sched::GATHER) {
#pragma unroll
                for (int h = 0; h < 2; ++h)
#pragma unroll
                    for (int i = 0; i < 2; ++i) g2[h][i] = last ? gn[h][i] : gc[h][i]; }
            PG8_LDB(B0, 0, 0); PG8_LDB(B1, 0, 1); PG8_SCHED; PG8_LDA(At, 0, 0); if constexpr (Sched::GATHER) { PG8_STAGE(PG8_SA(1, 1), gA0 + (size_t)(t + 1) * kstep, gc[1]); } else { PG8_STAGE(PG8_SA(1, 1), a1 + hstep, voffA); }
            PG8_WAIT_V(8); PG8_WAIT_L(0); PG8_BAR; PG8_MMA(0, 0, At, B0); PG8_MMA(0, 1, At, B1); PG8_BAR; PG8_SCHED;
            PG8_LDA(At, 0, 1); PG8_STAGE(PG8_SB(0, 0), b2, voffB); PG8_STAGE(PG8_SB(0, 1), b2 + hstep, voffB); if constexpr (Sched::GATHER) { PG8_STAGE(PG8_SA(0, 0), gA0 + gk2, g2[0]); } else { PG8_STAGE(PG8_SA(0, 0), a2, voffA); }
            PG8_WAIT_V(8); PG8_WAIT_L(0); PG8_BAR; PG8_MMA(1, 0, At, B0); PG8_MMA(1, 1, At, B1); PG8_BAR; PG8_SCHED;
            PG8_LDB(B0, 1, 0); PG8_LDB(B1, 1, 1); PG8_SCHED; PG8_LDA(At, 1, 0); if constexpr (Sched::GATHER) { PG8_STAGE(PG8_SA(0, 1), gA0 + gk2, g2[1]); } else { PG8_STAGE(PG8_SA(0, 1), a2 + hstep, voffA); }
            PG8_WAIT_V(8); PG8_WAIT_L(0); PG8_BAR; PG8_MMA(0, 0, At, B0); PG8_MMA(0, 1, At, B1); PG8_BAR; PG8_SCHED;
            PG8_LDA(At, 1, 1); PG8_STAGE(PG8_SB(1, 0), b3, voffB); PG8_STAGE(PG8_SB(1, 1), b3 + hstep, voffB); if constexpr (Sched::GATHER) { PG8_STAGE(PG8_SA(1, 0), gA0 + gk2 + kstep, g2[0]); } else { PG8_STAGE(PG8_SA(1, 0), a3, voffA); }
            PG8_WAIT_V(8); PG8_WAIT_L(0); PG8_BAR; PG8_MMA(1, 0, At, B0); PG8_MMA(1, 1, At, B1); PG8_BAR; PG8_SCHED;
            } else {
            PG8_LDB(B0, 0, 0); PG8_SCHED; PG8_LDA(At, 0, 0); PG8_STAGE(PG8_SA(1, 1), a1 + hstep, voffA);
            PG8_WAIT_L(8); PG8_BAR; PG8_WAIT_L(0); PG8_MMA(0, 0, At, B0); PG8_BAR; PG8_SCHED;
            PG8_LDB(B1, 0, 1); PG8_STAGE(PG8_SB(0, 0), b2, voffB);
            PG8_BAR; PG8_WAIT_L(0); PG8_MMA(0, 1, At, B1); PG8_BAR;
            PG8_LDA(At, 0, 1); PG8_STAGE(PG8_SA(0, 0), a2, voffA);
            PG8_BAR; PG8_WAIT_L(0); PG8_MMA(1, 0, At, B0); PG8_BAR; PG8_SCHED;
            PG8_STAGE(PG8_SB(0, 1), b2 + hstep, voffB);
            PG8_WAIT_V(6); PG8_BAR; PG8_MMA(1, 1, At, B1); PG8_BAR;
            PG8_LDB(B0, 1, 0); PG8_SCHED; PG8_LDA(At, 1, 0); PG8_STAGE(PG8_SA(0, 1), a2 + hstep, voffA);
            PG8_WAIT_L(8); PG8_BAR; PG8_WAIT_L(0); PG8_MMA(0, 0, At, B0); PG8_BAR; PG8_SCHED;
            PG8_LDB(B1, 1, 1); PG8_STAGE(PG8_SB(1, 0), b3, voffB);
            PG8_BAR; PG8_WAIT_L(0); PG8_MMA(0, 1, At, B1); PG8_BAR;
            PG8_LDA(At, 1, 1); PG8_STAGE(PG8_SA(1, 0), a3, voffA);
            PG8_BAR; PG8_WAIT_L(0); PG8_MMA(1, 0, At, B0); PG8_BAR; PG8_SCHED;
            PG8_STAGE(PG8_SB(1, 1), b3 + hstep, voffB);
            PG8_WAIT_V(6); PG8_BAR; PG8_MMA(1, 1, At, B1); PG8_BAR;
            }
        }
        if constexpr (ALIGN_EPI) { if (wr == 0) PG8_BAR; }
        if constexpr (!Epi::AFTER_DRAIN) { E(acc, cur, wr, wc, fr, fq); S.done(cur); }
        if (!has_next) break;
#pragma unroll
        for (int a = 0; a < 2; ++a)
#pragma unroll
            for (int b = 0; b < 2; ++b)
#pragma unroll
                for (int m = 0; m < 4; ++m)
#pragma unroll
                    for (int n = 0; n < 2; ++n) acc[a][b][m][n] = (f32x4){0.f, 0.f, 0.f, 0.f};
        cur = nxt; cA = nA; cB = nB; ++ui;
        if constexpr (Sched::GATHER) {
#pragma unroll
            for (int h = 0; h < 2; ++h)
#pragma unroll
                for (int i = 0; i < 2; ++i) gc[h][i] = gn[h][i]; }
        if constexpr (ALIGN_EPI) { if (wr == 1) PG8_BAR; }
    }
    PG8_WAIT_V(0);
    if constexpr (!ALIGN_EPI) { if (wr == 0) PG8_BAR; }
    PG8_BAR;
    if constexpr (Epi::AFTER_DRAIN) { E.fused(acc, cur, wr, wc, fr, fq, lds, wid, lane); S.done(cur); }
#undef PG8_SA
#undef PG8_SB
#undef PG8_STAGE
#undef PG8_LDA
#undef PG8_LDB
#undef PG8_MMA
#undef PG8_WAIT_V
#undef PG8_WAIT_L
#undef PG8_BAR
#undef PG8_SCHED
}
}

#define DI __device__ __forceinline__
#define GAS __attribute__((address_space(1)))
#define LAS __attribute__((address_space(3)))
typedef unsigned short bf16;
typedef unsigned v4u __attribute__((ext_vector_type(4)));
typedef unsigned v2u __attribute__((ext_vector_type(2)));
typedef float f32x4 __attribute__((ext_vector_type(4)));
typedef short bf16x8 __attribute__((ext_vector_type(8)));
typedef GAS unsigned gu32;

constexpr int D = 1024, NMAIN = 32768, SEQ = 16384, MR = 33024, CH0ROW = 32768, METAROW = 32816, NMETA = 16, NTOK = NMAIN + NMETA;
constexpr int NCHUNK = 257, NUNIT = 2 * NCHUNK * 4;
constexpr int NPROJ = 3072, NE = 32, FF = 512, PMAXT = 289;
constexpr float ALPHA = 1.41421356237f, LN_EPS = 1e-5f, QSCALE = 0.08838834764831845f, NEGBIG = -1e30f;
constexpr int NWAVES = 8, NTHR = 512;

constexpr size_t MiB = 1u << 20;
constexpr size_t WS_CTL = 0, CTL_ZERO_BYTES = 1 * MiB;
constexpr size_t WS_GATES = 1 * MiB;
constexpr size_t WS_A = WS_GATES + (size_t)MR * 32;
constexpr size_t WS_MX = WS_A + (size_t)MR * 16;
constexpr size_t WS_MT = WS_MX + (size_t)MR * 16;
constexpr size_t WS_GLR = WS_MT + (size_t)MR * 16;
constexpr size_t WS_EID = WS_GLR + (size_t)MR * 64;
constexpr size_t WS_EW = WS_EID + (size_t)NTOK * 8;
constexpr size_t WS_SLOT = WS_EW + (size_t)NTOK * 8;
constexpr size_t WS_GDEC = WS_SLOT + (size_t)NTOK * 8;
constexpr size_t WS_DN = WS_GDEC + (size_t)NUNIT * 512;
constexpr size_t WS_METAF = WS_DN + (size_t)NUNIT * 512;
constexpr size_t WS_ROWOF = WS_METAF + 65536;
static_assert(WS_ROWOF + (size_t)PMAXT * 1024 <= 10 * MiB, "small buffers");
constexpr size_t WS_WIN = 10 * MiB, WS_WOUT = 16 * MiB, WS_WGU = 18 * MiB, WS_WD = 82 * MiB;
constexpr size_t WS_HB = 114 * MiB;
constexpr size_t WS_ARENA = 179 * MiB;
constexpr size_t WS_Q = WS_ARENA, WS_K = WS_Q + (size_t)MR * 1024, WS_V = WS_K + (size_t)MR * 1024, WS_O = WS_V + (size_t)MR * 2048, WS_ST = WS_O + (size_t)MR * 2048;
constexpr size_t WS_YB = WS_Q;
constexpr size_t WS_XB = WS_V;
constexpr size_t WS_HDN = WS_XB + (size_t)PMAXT * 256 * 2048;
constexpr size_t WS_END = WS_ST + (size_t)NUNIT * 65536;
static_assert(WS_HDN + (size_t)PMAXT * 256 * 1024 <= WS_END, "moe overlay");
static_assert(WS_END == 501 * MiB, "ws map");
constexpr int CW_BAR = 4096;
constexpr int CW_CNT = 16384;
constexpr int CW_CUR = 16384 + 256;
constexpr int LDS_BYTES = 155648, TAB_OFF = 131072, TOP_OFF = 154624;

typedef __bf16 bf16x2_t __attribute__((ext_vector_type(2)));
typedef float f32x2_t __attribute__((ext_vector_type(2)));
DI unsigned pk2(float lo, float hi) { const f32x2_t v = {lo, hi}; return __builtin_bit_cast(unsigned, __builtin_convertvector(v, bf16x2_t)); }
DI unsigned f2bf(float f) { return pk2(f, 0.f) & 0xffffu; }
DI float bflo(unsigned w) { return __builtin_bit_cast(float, w << 16); }
DI float bfhi(unsigned w) { return __builtin_bit_cast(float, w & 0xffff0000u); }
DI float bf2f(bf16 b) { return __builtin_bit_cast(float, (unsigned)b << 16); }
#define LDS_WAIT() asm volatile("s_waitcnt lgkmcnt(0)" ::: "memory")
DI float wave_sum(float v) {
#pragma unroll
    for (int o = 1; o < 64; o <<= 1) v += __shfl_xor(v, o);
    return v;
}
template <int N, int OFF> struct FoldStep {
    template <int NP> static DI float run(float (&p)[NP], int lane) {
        constexpr int half = N / 2; const bool hi = (lane & OFF) != 0;
#pragma unroll
        for (int i = 0; i < half; ++i) { const float keep = hi ? p[half + i] : p[i], send = hi ? p[i] : p[half + i]; p[i] = keep + __shfl_xor(send, OFF); }
        return FoldStep<half, OFF / 2>::run(p, lane);
    }
};
template <int OFF> struct FoldStep<1, OFF> {
    template <int NP> static DI float run(float (&p)[NP], int lane) { float r = p[0];
#pragma unroll
        for (int off = OFF; off >= 1; off >>= 1) r += __shfl_xor(r, off);
        return r; }
};
template <int N> DI float fold_reduce(float (&p)[N], int lane) { return FoldStep<N, 32>::run(p, lane); }
DI float logsig(float z) { return fminf(z, 0.f) - log1pf(expf(-fabsf(z))); }
DI f32x4 mma16(bf16x8 x, bf16x8 y, f32x4 c) { return __builtin_amdgcn_mfma_f32_16x16x32_bf16(x, y, c, 0, 0, 0); }
#define XB_TMO      128
#define XB_XCNT(j)  (256  + 64 * (j))
#define XB_XSUB(j)  (1280 + 64 * (j))
#define XB_XGEN(j)  (2304 + 64 * (j))
#define XB_TOP      3328
#define XB_TOPGEN   3392
#define XCD_BAR_WORDS 3456
#define XB_SPIN_CAP (1u << 18)

__device__ __forceinline__ unsigned xb_ld(unsigned* p)              { return __hip_atomic_load(p, __ATOMIC_RELAXED, __HIP_MEMORY_SCOPE_AGENT); }
__device__ __forceinline__ unsigned xb_add(unsigned* p, unsigned v) { return __hip_atomic_fetch_add(p, v, __ATOMIC_RELAXED, __HIP_MEMORY_SCOPE_AGENT); }
__device__ __forceinline__ unsigned xb_xcc_id() { return (unsigned)__builtin_amdgcn_s_getreg((3 << 11) | 20) & 0xFu; }
#define XB_SPIN(cond, bar) do { unsigned _sp = 0; while (cond) { __builtin_amdgcn_s_sleep(1); \
    if ((++_sp & 255u) == 0u) { if (xb_ld(&(bar)[XB_TMO])) break; if (_sp > XB_SPIN_CAP) { atomicAdd(&(bar)[XB_TMO], 1u); break; } } } } while (0)

struct XcdBarrier {
    unsigned* bar; unsigned x;
    volatile LAS unsigned* st;
};

__device__ __forceinline__ XcdBarrier xcd_barrier_post(unsigned* bar, volatile LAS unsigned* st) {
    XcdBarrier b; b.bar = bar; b.x = xb_xcc_id(); b.st = st;
    if (threadIdx.x == 0) (void)xb_add(&bar[XB_XCNT(b.x)], 1u);
    return b;
}
__device__ __forceinline__ void xcd_barrier_complete(unsigned* bar, unsigned x, unsigned& nloc, unsigned& nx) {
    const unsigned G = gridDim.x * gridDim.y * gridDim.z;
    unsigned sum, cnt, mine, sp = 0u;
    for (;;) {
        sum = 0u; cnt = 0u; mine = 0u;
#pragma unroll
        for (unsigned j = 0; j < 16; ++j) { const unsigned c = xb_ld(&bar[XB_XCNT(j)]); sum += c; cnt += (c > 0u) ? 1u : 0u; mine = (j == x) ? c : mine; }
        if (sum == G) break;
        __builtin_amdgcn_s_sleep(1);
        if ((++sp & 255u) == 0u) { if (xb_ld(&bar[XB_TMO])) break; if (sp > XB_SPIN_CAP) { atomicAdd(&bar[XB_TMO], 1u); break; } }
    }
    nloc = mine > 0u ? mine : 1u; nx = cnt > 0u ? cnt : 1u;
}

__device__ __forceinline__ void xcd_barrier(const XcdBarrier& b) {
    asm volatile("s_waitcnt vmcnt(0)" ::: "memory");
    __syncthreads();
    if (threadIdx.x == 0) {
        unsigned* bar = b.bar;
        __builtin_amdgcn_s_waitcnt(0);
        unsigned nloc = b.st[0], nx = b.st[1];
        if (nloc == 0u) { xcd_barrier_complete(bar, b.x, nloc, nx); b.st[0] = nloc; b.st[1] = nx; }
        const unsigned old = xb_add(&bar[XB_XSUB(b.x)], 1u);
        const unsigned gen = old / nloc;
        if (old + 1u == (gen + 1u) * nloc) {
            __builtin_amdgcn_fence(__ATOMIC_RELEASE, "agent");
            asm volatile("s_waitcnt vmcnt(0)" ::: "memory");
            const unsigned og = xb_add(&bar[XB_TOP], 1u);
            const unsigned tg = og / nx;
            if (og + 1u == (tg + 1u) * nx) xb_add(&bar[XB_TOPGEN], 1u);
            else XB_SPIN(xb_ld(&bar[XB_TOPGEN]) == tg, bar);
            __builtin_amdgcn_fence(__ATOMIC_ACQUIRE, "agent");
            xb_add(&bar[XB_XGEN(b.x)], 1u);
            asm volatile("s_waitcnt vmcnt(0)" ::: "memory");
        } else {
            XB_SPIN(xb_ld(&bar[XB_XGEN(b.x)]) == gen, bar);
            __builtin_amdgcn_fence(__ATOMIC_ACQUIRE, "agent");
            asm volatile("s_waitcnt vmcnt(0)" ::: "memory");
        }
    }
    __syncthreads();
}

struct Args { const float* in[33]; float* out; unsigned char* ws; int ph_lo, ph_hi; };
struct Frame {
    LAS unsigned char* lds;
    gu32* ctl;
    int tid, lane, wave, G, vcu;
    const float* const* in;
    float* out; unsigned char* ws;
};
DI int tok_row(int tok) { return tok < NMAIN ? tok : tok + (METAROW - NMAIN); }

DI void transpose_item(const float* W, int ldw, int k0, int n0, bf16* WT, int Kd, int drow0, LAS float* scr, int lane) {
#pragma unroll 8
    for (int i = 0; i < 32; ++i) { const int kk = 2 * i + (lane >> 5); scr[kk * 33 + (lane & 31)] = W[(size_t)(k0 + kk) * ldw + n0 + (lane & 31)]; }
    LDS_WAIT(); asm volatile("" ::: "memory");
    const int c = lane & 7;
#pragma unroll
    for (int j = 0; j < 4; ++j) { const int n = (lane >> 3) + 8 * j; const LAS float* s = scr + (8 * c) * 33 + n;
        v4u o; o.x = pk2(s[0 * 33], s[1 * 33]); o.y = pk2(s[2 * 33], s[3 * 33]); o.z = pk2(s[4 * 33], s[5 * 33]); o.w = pk2(s[6 * 33], s[7 * 33]);
        *(v4u*)(WT + (size_t)(drow0 + n) * Kd + k0 + 8 * c) = o; }
    LDS_WAIT(); asm volatile("" ::: "memory");
}
template <int L> DI void convert_weights(Frame& F) {
    constexpr int IB = L ? 17 : 2;
    const float* w_in = F.in[IB]; const int ld_in = L ? 3088 : 3080;
    const float* w_out = F.in[L ? 21 : 5];
    const float* w_g = F.in[L ? 28 : 12]; const float* w_u = F.in[L ? 29 : 13]; const float* w_d = F.in[L ? 30 : 14];
    bf16* WIN = (bf16*)(F.ws + WS_WIN); bf16* WOUT = (bf16*)(F.ws + WS_WOUT); bf16* WGU = (bf16*)(F.ws + WS_WGU); bf16* WD = (bf16*)(F.ws + WS_WD);
    LAS float* scr = (LAS float*)(F.lds + F.wave * 16384);
    const int gw = F.vcu * NWAVES + F.wave, NGW = F.G * NWAVES;
    constexpr int I_IN = 16 * 96, I_OUT = 16 * 32, I_G = 32 * 256, I_D = 32 * 256, NITEMS = I_IN + I_OUT + 2 * I_G + I_D;
    for (int it = gw; it < NITEMS; it += NGW) {
        int r = it;
        if (r < I_IN) { const int kb = r / 96, nb = r % 96; transpose_item(w_in, ld_in, 64 * kb, 32 * nb, WIN, 1024, 32 * nb, scr, F.lane); continue; } r -= I_IN;
        if (r < I_OUT) { const int kb = r / 32, nb = r % 32; transpose_item(w_out, 1024, 64 * kb, 32 * nb, WOUT, 1024, 32 * nb, scr, F.lane); continue; } r -= I_OUT;
        if (r < 2 * I_G) { const int up = r >= I_G; if (up) r -= I_G; const int e = r >> 8, rr = r & 255, kb = rr >> 4, nb = rr & 15, n0 = 32 * nb;
            transpose_item((up ? w_u : w_g) + (size_t)e * 1024 * 512, 512, 64 * kb, n0, WGU, 1024, e * 1024 + (n0 >> 7) * 256 + up * 128 + (n0 & 127), scr, F.lane); continue; } r -= 2 * I_G;
        { const int e = r >> 8, rr = r & 255, kb = rr >> 5, nb = rr & 31; transpose_item(w_d + (size_t)e * 512 * 1024, 1024, 64 * kb, 32 * nb, WD, 512, e * 1024 + 32 * nb, scr, F.lane); }
    }
}
template <int NC, int STR> DI void stage_cols(const float* W, int ldw, int col0, LAS float* dst, int tid) {
#pragma unroll 4
    for (int idx = tid; idx < NC * 1024; idx += NTHR) { const int e = idx % NC, k = idx / NC; dst[e * STR + k] = W[(size_t)k * ldw + col0 + e]; }
}
DI void ln_row(f32x4 (&v)[4], const float* lg, const float* lb, int lane) {
    float s = 0.f;
#pragma unroll
    for (int j = 0; j < 4; ++j) s += (v[j].x + v[j].y) + (v[j].z + v[j].w);
    const float mean = wave_sum(s) * (1.f / D); float s2 = 0.f;
#pragma unroll
    for (int j = 0; j < 4; ++j) { v[j] = v[j] - mean; s2 += (v[j].x * v[j].x + v[j].y * v[j].y) + (v[j].z * v[j].z + v[j].w * v[j].w); }
    const float rstd = 1.f / sqrtf(wave_sum(s2) * (1.f / D) + LN_EPS);
#pragma unroll
    for (int j = 0; j < 4; ++j) { const f32x4 g = *(const f32x4*)(lg + 256 * j + 4 * lane), b = *(const f32x4*)(lb + 256 * j + 4 * lane); v[j] = v[j] * rstd * g + b; }
}
DI void store_row_bf16(bf16* orow, const f32x4 (&v)[4], int lane) {
    unsigned long long* o8 = (unsigned long long*)orow + lane;
#pragma unroll
    for (int j = 0; j < 4; ++j) o8[64 * j] = (unsigned long long)pk2(v[j].x, v[j].y) | ((unsigned long long)pk2(v[j].z, v[j].w) << 32);
}
template <int NC, int STR> DI float row_dots(const f32x4 (&v)[4], const LAS float* wl, int lane) {
    float p[NC];
#pragma unroll
    for (int e = 0; e < NC; ++e) { float a = 0.f;
#pragma unroll
        for (int j = 0; j < 4; ++j) { const f32x4 w = *(const LAS f32x4*)(wl + e * STR + 256 * j + 4 * lane); a += (v[j].x * w.x + v[j].y * w.y) + (v[j].z * w.z + v[j].w * w.w); }
        p[e] = a; if ((e & 3) == 3) asm volatile("" : "+v"(p[e - 3]), "+v"(p[e - 2]), "+v"(p[e - 1]), "+v"(p[e]) :: "memory"); }
    return fold_reduce<NC>(p, lane);
}

DI void phase_p0(Frame& F) {
    bf16* HB = (bf16*)(F.ws + WS_HB);
    for (int i = blockIdx.x * NTHR + F.tid; i < 240 * 128; i += F.G * NTHR) { const int ri = i >> 7, r = ri < 48 ? CH0ROW + ri : 32832 + (ri - 48);
        *(v4u*)(HB + (size_t)r * D + (i & 127) * 8) = (v4u){0u, 0u, 0u, 0u}; }
    convert_weights<0>(F);
    __syncthreads();
    LAS float* wg = (LAS float*)F.lds;
    stage_cols<8, 1028>(F.in[2], 3080, 3072, wg, F.tid);
    __syncthreads();
    const float* x = F.in[0]; const float* meta = F.in[1]; const float* bg = F.in[3];
    float* GATES = (float*)(F.ws + WS_GATES);
    const int gw = F.vcu * NWAVES + F.wave, NGW = F.G * NWAVES;
#pragma unroll 1
    for (int tok = gw; tok < NTOK; tok += NGW) {
        const float* src = tok < NMAIN ? x + (size_t)tok * D : meta + (size_t)(tok - NMAIN) * D; const int row = tok_row(tok);
        f32x4 v[4];
#pragma unroll
        for (int j = 0; j < 4; ++j) v[j] = *(const f32x4*)(src + 256 * j + 4 * F.lane);
        store_row_bf16(HB + (size_t)row * D, v, F.lane);
        const float r = row_dots<8, 1028>(v, wg, F.lane);
        if ((F.lane & 7) == 0) GATES[(size_t)row * 8 + (F.lane >> 3)] = r + bg[F.lane >> 3];
    }
}

template <bool MAXOP> DI float block_scan_excl(float val, LAS float* sb, int tid) {
    sb[tid] = val; __syncthreads();
#pragma unroll 1
    for (int off = 1; off < NTHR; off <<= 1) { float t = MAXOP ? -3.0e38f : 0.f; if (tid >= off) t = sb[tid - off]; __syncthreads(); sb[tid] = MAXOP ? fmaxf(sb[tid], t) : sb[tid] + t; __syncthreads(); }
    const float r = tid ? sb[tid - 1] : (MAXOP ? -3.0e38f : 0.f); __syncthreads();
    return r;
}
DI void phase_s1(Frame& F) {
    if (blockIdx.x >= 8) return;
    const int b = blockIdx.x >> 2, h = blockIdx.x & 3, tid = F.tid;
    const float* GATES = (const float*)(F.ws + WS_GATES);
    float* A = (float*)(F.ws + WS_A); float* MX = (float*)(F.ws + WS_MX); float* MT = (float*)(F.ws + WS_MT);
    LAS float* sb = (LAS float*)F.lds; LAS float* bc = sb + 512;
    if (tid == 0) { float B = 0.f, M = 0.f;
        for (int j = 0; j < NMETA; ++j) { const int row = METAROW + j; const float li = GATES[row * 8 + h], lf = logsig(GATES[row * 8 + 4 + h]); B += lf; const float a = li - B; M = fmaxf(M, a);
            if (b == 0) { A[row * 4 + h] = a; MX[row * 4 + h] = M; MT[row * 4 + h] = B + M; } }
        bc[0] = B; bc[1] = M; }
    if (b == 0 && tid < 48) { const int row = CH0ROW + tid; A[row * 4 + h] = NEGBIG; MX[row * 4 + h] = 0.f; MT[row * 4 + h] = 0.f; }
    __syncthreads();
    const float Bm = bc[0], Mm = bc[1];
    const int r0 = b * SEQ + 32 * tid;
    float run = 0.f;
#pragma unroll 4
    for (int j = 0; j < 32; ++j) run += logsig(GATES[(size_t)(r0 + j) * 8 + 4 + h]);
    const float off = block_scan_excl<false>(run, sb, tid) + Bm;
    float Bc = off, mx = -3.0e38f;
#pragma unroll 4
    for (int j = 0; j < 32; ++j) { const size_t row = r0 + j; Bc += logsig(GATES[row * 8 + 4 + h]); const float a = GATES[row * 8 + h] - Bc; mx = fmaxf(mx, a); A[row * 4 + h] = a; MT[row * 4 + h] = Bc; }
    const float pre = fmaxf(block_scan_excl<true>(mx, sb, tid), Mm);
    float M = pre;
#pragma unroll 4
    for (int j = 0; j < 32; ++j) { const size_t row = r0 + j; M = fmaxf(M, A[row * 4 + h]); MX[row * 4 + h] = M; MT[row * 4 + h] += M; }
}

template <int L> DI void phase_t1(Frame& F) {
    LAS float* wr = (LAS float*)F.lds;
    LAS int* hist = (LAS int*)(F.lds + 148032);
    stage_cols<32, 1028>(F.in[L ? 26 : 10], 32, 0, wr, F.tid);
    stage_cols<4, 1028>(F.in[L ? 24 : 8], 4, 0, wr + 32 * 1028, F.tid);
    if (F.tid < 32) hist[F.tid] = 0;
    __syncthreads();
    const float* lg = F.in[L ? 22 : 6]; const float* lb = F.in[L ? 23 : 7]; const float* b_grp = F.in[L ? 25 : 9]; const float* b_rt = F.in[L ? 27 : 11];
    const bf16* YB = (const bf16*)(F.ws + WS_YB); bf16* HB = (bf16*)(F.ws + WS_HB); float* METAF = (float*)(F.ws + WS_METAF);
    int* EID = (int*)(F.ws + WS_EID); float* EW = (float*)(F.ws + WS_EW);
    const int gw = F.vcu * NWAVES + F.wave, NGW = F.G * NWAVES;
#pragma unroll 1
    for (int tok = gw; tok < NTOK; tok += NGW) {
        const int row = tok_row(tok);
        const float* hp = (L == 0) ? (tok < NMAIN ? F.in[0] + (size_t)tok * D : F.in[1] + (size_t)(tok - NMAIN) * D)
                                   : (tok < NMAIN ? F.out + (size_t)tok * D : METAF + (size_t)(tok - NMAIN) * D);
        float* hf = tok < NMAIN ? F.out + (size_t)tok * D : METAF + (size_t)(tok - NMAIN) * D;
        f32x4 v[4];
#pragma unroll
        for (int j = 0; j < 4; ++j) { const f32x4 hv = *(const f32x4*)(hp + 256 * j + 4 * F.lane); const v2u yw = *(const v2u*)(YB + (size_t)row * D + 256 * j + 4 * F.lane);
            v[j].x = ALPHA * hv.x + bflo(yw.x); v[j].y = ALPHA * hv.y + bfhi(yw.x); v[j].z = ALPHA * hv.z + bflo(yw.y); v[j].w = ALPHA * hv.w + bfhi(yw.y); }
        ln_row(v, lg, lb, F.lane);
#pragma unroll
        for (int j = 0; j < 4; ++j) *(f32x4*)(hf + 256 * j + 4 * F.lane) = v[j];
        store_row_bf16(HB + (size_t)row * D, v, F.lane);
        const float r16a = row_dots<16, 1028>(v, wr, F.lane);
        const float r16b = row_dots<16, 1028>(v, wr + 16 * 1028, F.lane);
        const float r4 = row_dots<4, 1028>(v, wr + 32 * 1028, F.lane);
        float gl[4];
#pragma unroll
        for (int j = 0; j < 4; ++j) gl[j] = __shfl(r4, 16 * j) + b_grp[j];
        int gt = 0; float gm = gl[0];
#pragma unroll
        for (int j = 1; j < 4; ++j) if (gl[j] > gm) { gm = gl[j]; gt = j; }
        float se = 0.f;
#pragma unroll
        for (int j = 0; j < 4; ++j) se += expf(gl[j] - gm);
        const float pg = 1.f / se;
        float wv[8];
#pragma unroll
        for (int i = 0; i < 8; ++i) wv[i] = __shfl(gt < 2 ? r16a : r16b, 4 * ((gt & 1) * 8 + i)) + b_rt[gt * 8 + i];
        int i0 = 0; float v0 = wv[0];
#pragma unroll
        for (int i = 1; i < 8; ++i) if (wv[i] > v0) { v0 = wv[i]; i0 = i; }
        int i1 = -1; float v1 = -3.0e38f;
#pragma unroll
        for (int i = 0; i < 8; ++i) if (i != i0 && wv[i] > v1) { v1 = wv[i]; i1 = i; }
        const float e1 = expf(v1 - v0), w0 = 1.f / (1.f + e1), w1 = e1 * w0;
        if (F.lane == 0) { const int ea = gt * 8 + i0, eb = gt * 8 + i1; EID[tok * 2] = ea; EID[tok * 2 + 1] = eb; EW[tok * 2] = pg * w0; EW[tok * 2 + 1] = pg * w1;
            __hip_atomic_fetch_add(&hist[ea], 1, __ATOMIC_RELAXED, __HIP_MEMORY_SCOPE_WORKGROUP); __hip_atomic_fetch_add(&hist[eb], 1, __ATOMIC_RELAXED, __HIP_MEMORY_SCOPE_WORKGROUP); }
    }
    __syncthreads();
    if (F.tid < 32 && hist[F.tid]) atomicAdd((unsigned*)(F.ctl + CW_CNT + 64 * L + F.tid), (unsigned)hist[F.tid]);
}

DI void moe_tables(Frame& F, int L, LAS int* pst, LAS int* cnt) {
    if (F.tid < 32) cnt[F.tid] = (int)__hip_atomic_load(F.ctl + CW_CNT + 64 * L + F.tid, __ATOMIC_RELAXED, __HIP_MEMORY_SCOPE_AGENT);
    __syncthreads();
    if (F.tid == 0) { int s = 0; for (int e = 0; e < 32; ++e) { pst[e] = s; s += ((cnt[e] + 255) >> 8) << 8; } pst[32] = s; }
    __syncthreads();
}
template <int L> DI void phase_d1(Frame& F) {
    LAS int* pst = (LAS int*)F.lds; LAS int* cnt = pst + 40; LAS int* lh = cnt + 32; LAS int* lbase = lh + 32;
    if (F.tid < 32) lh[F.tid] = 0;
    moe_tables(F, L, pst, cnt);
    const int* EID = (const int*)(F.ws + WS_EID); int* SLOT = (int*)(F.ws + WS_SLOT); int* ROWOF = (int*)(F.ws + WS_ROWOF);
    const int TPB = (NTOK + F.G - 1) / F.G;
    const int t0 = blockIdx.x * TPB; int nt = NTOK - t0; nt = nt < 0 ? 0 : (nt > TPB ? TPB : nt);
    const int i = F.tid; const bool valid = i < 2 * nt; const int tok = t0 + (i >> 1);
    int e = 0, rank = 0;
    if (valid) { e = EID[tok * 2 + (i & 1)]; rank = __hip_atomic_fetch_add(&lh[e], 1, __ATOMIC_RELAXED, __HIP_MEMORY_SCOPE_WORKGROUP); }
    __syncthreads();
    if (F.tid < 32) lbase[F.tid] = lh[F.tid] ? (int)atomicAdd((unsigned*)(F.ctl + CW_CUR + 64 * L + F.tid), (unsigned)lh[F.tid]) : 0;
    __syncthreads();
    if (valid) { const int slot = pst[e] + lbase[e] + rank; SLOT[tok * 2 + (i & 1)] = slot; ROWOF[slot] = tok_row(tok); }
    for (int j = blockIdx.x; j < 32; j += F.G) { const int npad = (((cnt[j] + 255) >> 8) << 8) - cnt[j];
        for (int q = F.tid; q < npad; q += NTHR) ROWOF[pst[j] + cnt[j] + q] = 32832; }
}

template <int L> DI void phase_t2(Frame& F) {
    LAS float* wl = (LAS float*)F.lds;
#ifndef T2_NOCONV
    if (L == 0) { convert_weights<1>(F); __syncthreads(); }
#endif
    if (L == 0) { stage_cols<16, 1028>(F.in[17], 3088, 3072, wl, F.tid); __syncthreads(); }
    const float* lg = F.in[L ? 31 : 15]; const float* lb = F.in[L ? 32 : 16];
    const bf16* Y2 = (const bf16*)(F.ws + WS_XB); bf16* HB = (bf16*)(F.ws + WS_HB); float* METAF = (float*)(F.ws + WS_METAF); float* GLR = (float*)(F.ws + WS_GLR);
    const int* SLOT = (const int*)(F.ws + WS_SLOT); const float* EW = (const float*)(F.ws + WS_EW);
    const int gw = F.vcu * NWAVES + F.wave, NGW = F.G * NWAVES;
    const int ntok = L ? NMAIN : NTOK;
#pragma unroll 1
    for (int tok = gw; tok < ntok; tok += NGW) {
        const int row = tok_row(tok);
        float* hf = tok < NMAIN ? F.out + (size_t)tok * D : METAF + (size_t)(tok - NMAIN) * D;
        const int s0 = SLOT[tok * 2], s1 = SLOT[tok * 2 + 1]; const float w0 = EW[tok * 2], w1 = EW[tok * 2 + 1];
        f32x4 v[4];
#pragma unroll
        for (int j = 0; j < 4; ++j) { const f32x4 hv = *(const f32x4*)(hf + 256 * j + 4 * F.lane);
            const v2u ya = *(const v2u*)(Y2 + (size_t)s0 * D + 256 * j + 4 * F.lane), yb = *(const v2u*)(Y2 + (size_t)s1 * D + 256 * j + 4 * F.lane);
            v[j].x = ALPHA * hv.x + (w0 * bflo(ya.x) + w1 * bflo(yb.x)); v[j].y = ALPHA * hv.y + (w0 * bfhi(ya.x) + w1 * bfhi(yb.x));
            v[j].z = ALPHA * hv.z + (w0 * bflo(ya.y) + w1 * bflo(yb.y)); v[j].w = ALPHA * hv.w + (w0 * bfhi(ya.y) + w1 * bfhi(yb.y)); }
        ln_row(v, lg, lb, F.lane);
#pragma unroll
        for (int j = 0; j < 4; ++j) *(f32x4*)(hf + 256 * j + 4 * F.lane) = v[j];
        if (L == 0) {
            store_row_bf16(HB + (size_t)row * D, v, F.lane);
            const float r = row_dots<16, 1028>(v, wl, F.lane);
            if ((F.lane & 3) == 0) GLR[(size_t)row * 16 + (F.lane >> 2)] = r;
        }
    }
}

DI void unit_decode(int u, int& b, int& c, int& h, int& row0) { h = u & 3; const int bc = u >> 2; b = bc / NCHUNK; c = bc - b * NCHUNK; row0 = c == 0 ? CH0ROW : b * SEQ + (c - 1) * 64; }
DI int prev_last_row(int c, int row0) { return c == 1 ? METAROW + NMETA - 1 : row0 - 1; }
DI int main_unit(int i) { return i + 4 + (i >= 1024 ? 4 : 0); }
DI float fexp(float x) { return __builtin_amdgcn_exp2f(x * 1.44269504089f); }
DI float flogsig(float z) { return fminf(z, 0.f) - __builtin_amdgcn_logf(1.f + fexp(-fabsf(z))) * 0.69314718056f; }
DI float frcp(float x) { return __builtin_amdgcn_rcpf(x); }
DI float wscan_add(float x, int lane) {
#pragma unroll
    for (int off = 1; off < 64; off <<= 1) { const float y = __shfl_up(x, off); if (lane >= off) x += y; }
    return x;
}
DI float wscan_max(float x, int lane) {
#pragma unroll
    for (int off = 1; off < 64; off <<= 1) { const float y = __shfl_up(x, off); if (lane >= off) x = fmaxf(x, y); }
    return x;
}
constexpr int LD_QS = 136, LD_VT = 72;
constexpr int L_QS = 0, L_KS = 17408, L_VT = 34816, L_PS = 71680, L_WG = 80896, L_BG = 113664, L_SC = 116736, L_KT = 0;
static_assert(L_SC + 8192 <= TAB_OFF, "chunk lds map");

DI void mlstm_scalars(Frame& F, int c, int h, int row0, int lane, float& a, float& M, float& mt, float& Mprev) {
    if (c != 0) { const size_t row = row0 + lane; a = ((const float*)(F.ws + WS_A))[row * 4 + h]; M = ((const float*)(F.ws + WS_MX))[row * 4 + h]; mt = ((const float*)(F.ws + WS_MT))[row * 4 + h];
        Mprev = ((const float*)(F.ws + WS_MX))[(size_t)prev_last_row(c, row0) * 4 + h]; }
    else { const float* GATES = (const float*)(F.ws + WS_GATES); const bool real = lane >= 48; const size_t row = row0 + lane;
        const float li = real ? GATES[row * 8 + h] : NEGBIG, lf = real ? logsig(GATES[row * 8 + 4 + h]) : 0.f;
        const float B = wscan_add(lf, lane); a = real ? li - B : NEGBIG; M = fmaxf(wscan_max(a, lane), 0.f); mt = B + M; Mprev = 0.f; }
}
DI void gla_bc(float (&bc)[16], const f32x4 (&gl)[4], const LAS float* WG, const LAS float* BG, int h, int w, int lane, bool ch0) {
    f32x4 z[4];
#pragma unroll
    for (int q = 0; q < 4; ++q) z[q] = *(const LAS f32x4*)(BG + h * 128 + 16 * w + 4 * q);
#pragma unroll
    for (int r = 0; r < 16; ++r) { const float gv = gl[r >> 2][r & 3];
#pragma unroll
        for (int q = 0; q < 4; ++q) z[q] += gv * *(const LAS f32x4*)(WG + r * 512 + h * 128 + 16 * w + 4 * q);
        if (r & 1) asm volatile("" : "+v"(z[0]), "+v"(z[1]), "+v"(z[2]), "+v"(z[3]) :: "memory"); }
    const bool dead = ch0 && lane < 48;
#pragma unroll
    for (int j = 0; j < 16; ++j) { const float la = dead ? 0.f : flogsig(z[j >> 2][j & 3]) * (1.f / 16.f); bc[j] = wscan_add(la, lane); }
}
template <int MIX> DI void chunk_phase_setup(Frame& F) {
    if (MIX == 1) { LAS float* WG = (LAS float*)(F.lds + L_WG); LAS float* BG = (LAS float*)(F.lds + L_BG); const float* wgu = F.in[18]; const float* bgate = F.in[19];
#pragma unroll 4
        for (int i = F.tid; i < 16 * 512; i += NTHR) WG[i] = wgu[i];
        BG[F.tid] = bgate[F.tid]; }
}

template <int MIX> DI void aprime_unit(Frame& F, int u) {
    LAS bf16* KT = (LAS bf16*)(F.lds + L_KT); LAS bf16* VT = (LAS bf16*)(F.lds + L_VT); const LAS float* WG = (const LAS float*)(F.lds + L_WG); const LAS float* BG = (const LAS float*)(F.lds + L_BG);
    const bf16* Kp = (const bf16*)(F.ws + WS_K); const bf16* Vp = (const bf16*)(F.ws + WS_V); bf16* ST = (bf16*)(F.ws + WS_ST);
    float* GDEC = (float*)(F.ws + WS_GDEC); float* DN = (float*)(F.ws + WS_DN); const float* GLR = (const float*)(F.ws + WS_GLR);
    const int s = F.lane, w = F.wave, r = s & 15, g = s >> 4;
    int b, c, h, row0; unit_decode(u, b, c, h, row0);
    const v4u* ksrc = (const v4u*)(Kp + (size_t)(row0 + s) * 512 + h * 128 + 16 * w); const v4u kx0 = ksrc[0], kx1 = ksrc[1];
    const v4u* vsrc = (const v4u*)(Vp + (size_t)(row0 + s) * 1024 + h * 256 + 32 * w);
    v4u vx[4];
#pragma unroll
    for (int j = 0; j < 4; ++j) vx[j] = vsrc[j];
    float a = 0.f, M = 0.f, mt = 0.f, Mprev = 0.f; f32x4 gl[4];
    if (MIX == 0) mlstm_scalars(F, c, h, row0, s, a, M, mt, Mprev);
    else {
#pragma unroll
        for (int q = 0; q < 4; ++q) gl[q] = *(const f32x4*)(GLR + (size_t)(row0 + s) * 16 + 4 * q); }
    __syncthreads();
    float kv[16];
    { const unsigned wv[8] = {kx0.x, kx0.y, kx0.z, kx0.w, kx1.x, kx1.y, kx1.z, kx1.w};
#pragma unroll
      for (int q = 0; q < 8; ++q) { kv[2 * q] = bflo(wv[q]); kv[2 * q + 1] = bfhi(wv[q]); } }
    float vscale = 1.f;
    if (MIX == 0) {
        const float Mend = __shfl(M, 63), ws = fexp(a - Mend); vscale = ws;
        float p[16];
#pragma unroll
        for (int j = 0; j < 16; ++j) p[j] = ws * kv[j];
        const float dn = fold_reduce<16>(p, s);
        if ((s & 3) == 0) DN[(size_t)u * 128 + 16 * w + (s >> 2)] = dn;
        if (F.tid < 128) GDEC[(size_t)u * 128 + F.tid] = fexp(Mprev - Mend);
    } else {
        float bc[16]; gla_bc(bc, gl, WG, BG, h, w, s, c == 0);
#pragma unroll
        for (int j = 0; j < 16; ++j) { const float blast = __shfl(bc[j], 63); kv[j] *= fexp(blast - bc[j]); if (s == 63) GDEC[(size_t)u * 128 + 16 * w + j] = fexp(bc[j]); }
    }
#pragma unroll
    for (int j = 0; j < 16; ++j) KT[(16 * w + j) * LD_VT + s] = (bf16)f2bf(kv[j]);
#pragma unroll
    for (int j = 0; j < 4; ++j) { const unsigned wv[4] = {vx[j].x, vx[j].y, vx[j].z, vx[j].w};
#pragma unroll
        for (int q = 0; q < 4; ++q) { const int dv = 32 * w + 8 * j + 2 * q;
            if (MIX == 0) { VT[dv * LD_VT + s] = (bf16)f2bf(bflo(wv[q]) * vscale); VT[(dv + 1) * LD_VT + s] = (bf16)f2bf(bfhi(wv[q]) * vscale); }
            else { VT[dv * LD_VT + s] = (bf16)(wv[q] & 0xffffu); VT[(dv + 1) * LD_VT + s] = (bf16)(wv[q] >> 16); } } }
    __syncthreads();
    f32x4 acc[4][2][2];
#pragma unroll
    for (int p = 0; p < 4; ++p)
#pragma unroll
        for (int e = 0; e < 2; ++e)
#pragma unroll
            for (int nt = 0; nt < 2; ++nt) acc[p][e][nt] = (f32x4){0.f, 0.f, 0.f, 0.f};
#pragma unroll
    for (int ks = 0; ks < 2; ++ks) {
        bf16x8 y[2];
#pragma unroll
        for (int nt = 0; nt < 2; ++nt) y[nt] = *(const LAS bf16x8*)(VT + (32 * w + 16 * nt + r) * LD_VT + 32 * ks + 8 * g);
#pragma unroll
        for (int p = 0; p < 4; ++p)
#pragma unroll
            for (int e = 0; e < 2; ++e) { const bf16x8 x = *(const LAS bf16x8*)(KT + (32 * p + 8 * (r >> 2) + 4 * e + (r & 3)) * LD_VT + 32 * ks + 8 * g);
#pragma unroll
                for (int nt = 0; nt < 2; ++nt) acc[p][e][nt] = mma16(x, y[nt], acc[p][e][nt]); }
    }
    bf16* stu = ST + (size_t)u * 32768;
#pragma unroll
    for (int nt = 0; nt < 2; ++nt) { const int dv = 32 * w + 16 * nt + r;
#pragma unroll
        for (int p = 0; p < 4; ++p) { v4u o; o.x = pk2(acc[p][0][nt].x, acc[p][0][nt].y); o.y = pk2(acc[p][0][nt].z, acc[p][0][nt].w); o.z = pk2(acc[p][1][nt].x, acc[p][1][nt].y); o.w = pk2(acc[p][1][nt].z, acc[p][1][nt].w);
            *(v4u*)(stu + dv * 128 + 32 * p + 8 * g) = o; } }
}
template <int MIX> DI void phase_aprime(Frame& F) {
    chunk_phase_setup<MIX>(F);
    for (int i = blockIdx.x; i < 2048; i += F.G) aprime_unit<MIX>(F, main_unit(i));
}

template <int MIX> DI void phase_scan(Frame& F) {
    unsigned* ST = (unsigned*)(F.ws + WS_ST); const float* GDEC = (const float*)(F.ws + WS_GDEC); float* DN = (float*)(F.ws + WS_DN);
    for (int gid = blockIdx.x * NTHR + F.tid; gid < 8 * 16384; gid += F.G * NTHR) {
        const int bh = gid >> 14, e2 = gid & 16383, b = bh >> 2, h = bh & 3, d = (2 * e2) & 127;
        float s0 = 0.f, s1 = 0.f;
        size_t ub = (size_t)(b * NCHUNK) * 4 + h;
        int c = 0;
#pragma unroll 1
        for (; c + 8 <= NCHUNK; c += 8) {
            unsigned x[8]; float g0[8], g1[8];
#pragma unroll
            for (int j = 0; j < 8; ++j) { const size_t u = ub + (size_t)(c + j) * 4; x[j] = ST[u * 16384 + e2]; const float2 gg = *(const float2*)(GDEC + u * 128 + d); g0[j] = gg.x; g1[j] = gg.y; }
#pragma unroll
            for (int j = 0; j < 8; ++j) { const size_t u = ub + (size_t)(c + j) * 4; ST[u * 16384 + e2] = pk2(s0, s1); s0 = g0[j] * s0 + bflo(x[j]); s1 = g1[j] * s1 + bfhi(x[j]); }
        }
        for (; c < NCHUNK; ++c) { const size_t u = ub + (size_t)c * 4; const unsigned x = ST[u * 16384 + e2]; const float2 gg = *(const float2*)(GDEC + u * 128 + d);
            ST[u * 16384 + e2] = pk2(s0, s1); s0 = gg.x * s0 + bflo(x); s1 = gg.y * s1 + bfhi(x); }
    }
    if (MIX == 0) {
        const int gid = blockIdx.x * NTHR + F.tid;
        if (gid < 1024) { const int bh = gid >> 7, d = gid & 127, b = bh >> 2, h = bh & 3; float s = 0.f;
            for (int c = 0; c < NCHUNK; ++c) { const size_t u = (size_t)(b * NCHUNK + c) * 4 + h; const float x = DN[u * 128 + d], gg = GDEC[u * 128 + d]; DN[u * 128 + d] = s; s = gg * s + x; } }
    }
}

template <int MIX> DI void cprime_unit(Frame& F, int u) {
    LAS bf16* QS = (LAS bf16*)(F.lds + L_QS); LAS bf16* KS = (LAS bf16*)(F.lds + L_KS); LAS bf16* VT = (LAS bf16*)(F.lds + L_VT); LAS bf16* PS = (LAS bf16*)(F.lds + L_PS);
    const LAS float* WG = (const LAS float*)(F.lds + L_WG); const LAS float* BG = (const LAS float*)(F.lds + L_BG); LAS float* SC = (LAS float*)(F.lds + L_SC);
    LAS float* sa = SC, *sM = SC + 64, *smt = SC + 128, *sf = SC + 192, *red = SC + 256;
    const bf16* Qp = (const bf16*)(F.ws + WS_Q); const bf16* Kp = (const bf16*)(F.ws + WS_K); const bf16* Vp = (const bf16*)(F.ws + WS_V); const bf16* Op = (const bf16*)(F.ws + WS_O); bf16* Mo = (bf16*)(F.ws + WS_HB);
    const bf16* ST = (const bf16*)(F.ws + WS_ST); const float* NH = (const float*)(F.ws + WS_DN); const float* GLR = (const float*)(F.ws + WS_GLR);
    const float* hnw = F.in[MIX ? 20 : 4];
    const int t = F.lane, w = F.wave, r = t & 15, g = t >> 4;
    int b, c, h, row0; unit_decode(u, b, c, h, row0);
    const v4u* qsrc = (const v4u*)(Qp + (size_t)(row0 + t) * 512 + h * 128 + 16 * w); const v4u* ksrc = (const v4u*)(Kp + (size_t)(row0 + t) * 512 + h * 128 + 16 * w);
    v4u q0 = qsrc[0], q1 = qsrc[1], k0 = ksrc[0], k1 = ksrc[1];
    const v4u* vsrc = (const v4u*)(Vp + (size_t)(row0 + t) * 1024 + h * 256 + 32 * w);
    v4u vx[4];
#pragma unroll
    for (int j = 0; j < 4; ++j) vx[j] = vsrc[j];
    const bf16* stu = ST + (size_t)u * 32768;
    bf16x8 sx[4][2];
#pragma unroll
    for (int ks = 0; ks < 4; ++ks)
#pragma unroll
        for (int nt = 0; nt < 2; ++nt) { if (c != 0) sx[ks][nt] = *(const bf16x8*)(stu + (32 * w + 16 * nt + r) * 128 + 32 * ks + 8 * g); else sx[ks][nt] = (bf16x8){0, 0, 0, 0, 0, 0, 0, 0}; }
    v2u gwv[4][2];
#pragma unroll
    for (int mt = 0; mt < 4; ++mt)
#pragma unroll
        for (int nt = 0; nt < 2; ++nt) gwv[mt][nt] = *(const v2u*)(Op + (size_t)(row0 + 16 * mt + r) * 1024 + h * 256 + 32 * w + 16 * nt + 4 * g);
    float a = 0.f, M = 0.f, mtv = 0.f, Mprev = 0.f; f32x4 gl[4]; bf16x8 nx[4];
    if (MIX == 0) {
        mlstm_scalars(F, c, h, row0, t, a, M, mtv, Mprev);
#pragma unroll
        for (int ks = 0; ks < 4; ++ks) { nx[ks] = (bf16x8){0, 0, 0, 0, 0, 0, 0, 0};
            if (r == 0 && c != 0) { const f32x4 n0 = *(const f32x4*)(NH + (size_t)u * 128 + 32 * ks + 8 * g), n1 = *(const f32x4*)(NH + (size_t)u * 128 + 32 * ks + 8 * g + 4);
                v4u pw; pw.x = pk2(n0.x, n0.y); pw.y = pk2(n0.z, n0.w); pw.z = pk2(n1.x, n1.y); pw.w = pk2(n1.z, n1.w); nx[ks] = __builtin_bit_cast(bf16x8, pw); } }
    } else {
#pragma unroll
        for (int q = 0; q < 4; ++q) gl[q] = *(const f32x4*)(GLR + (size_t)(row0 + t) * 16 + 4 * q); }
    __syncthreads();
    if (MIX == 0) { if (w == 0) { sa[t] = a; sM[t] = M; smt[t] = mtv; sf[t] = fexp(Mprev - M); } }
    else {
        float bc[16]; gla_bc(bc, gl, WG, BG, h, w, t, c == 0);
        unsigned qw[8] = {q0.x, q0.y, q0.z, q0.w, q1.x, q1.y, q1.z, q1.w}, kw[8] = {k0.x, k0.y, k0.z, k0.w, k1.x, k1.y, k1.z, k1.w};
#pragma unroll
        for (int j = 0; j < 8; ++j) { const float b0 = bc[2 * j], b1 = bc[2 * j + 1];
            qw[j] = pk2(bflo(qw[j]) * fexp(b0), bfhi(qw[j]) * fexp(b1)); kw[j] = pk2(bflo(kw[j]) * fexp(-b0), bfhi(kw[j]) * fexp(-b1)); }
        q0 = (v4u){qw[0], qw[1], qw[2], qw[3]}; q1 = (v4u){qw[4], qw[5], qw[6], qw[7]}; k0 = (v4u){kw[0], kw[1], kw[2], kw[3]}; k1 = (v4u){kw[4], kw[5], kw[6], kw[7]};
    }
    *(LAS v4u*)(QS + t * LD_QS + 16 * w) = q0; *(LAS v4u*)(QS + t * LD_QS + 16 * w + 8) = q1;
    *(LAS v4u*)(KS + t * LD_QS + 16 * w) = k0; *(LAS v4u*)(KS + t * LD_QS + 16 * w + 8) = k1;
#pragma unroll
    for (int j = 0; j < 4; ++j) { const unsigned wv[4] = {vx[j].x, vx[j].y, vx[j].z, vx[j].w};
#pragma unroll
        for (int q = 0; q < 4; ++q) { const int dv = 32 * w + 8 * j + 2 * q; VT[dv * LD_VT + t] = (bf16)(wv[q] & 0xffffu); VT[(dv + 1) * LD_VT + t] = (bf16)(wv[q] >> 16); } }
    __syncthreads();
    { const int st = w >> 1;
#pragma unroll
      for (int tti = 0; tti < 2; ++tti) { const int tt = 2 * (w & 1) + tti; f32x4 acc = (f32x4){0.f, 0.f, 0.f, 0.f};
          if (st <= tt) {
#pragma unroll
              for (int ks = 0; ks < 4; ++ks) { const bf16x8 x = *(const LAS bf16x8*)(KS + (16 * st + r) * LD_QS + 32 * ks + 8 * g), y = *(const LAS bf16x8*)(QS + (16 * tt + r) * LD_QS + 32 * ks + 8 * g); acc = mma16(x, y, acc); } }
          const int tq = 16 * tt + r, s0 = 16 * st + 4 * g; float p[4];
#pragma unroll
          for (int i = 0; i < 4; ++i) { float v = acc[i]; if (MIX == 0) v *= fexp(sa[s0 + i] - sM[tq]); p[i] = (s0 + i <= tq) ? v : 0.f; }
          v2u o; o.x = pk2(p[0], p[1]); o.y = pk2(p[2], p[3]); *(LAS v2u*)(PS + tq * LD_VT + s0) = o; } }
    __syncthreads();
    f32x4 hnv[2];
#pragma unroll
    for (int nt = 0; nt < 2; ++nt) hnv[nt] = *(const f32x4*)(hnw + h * 256 + 32 * w + 16 * nt + 4 * g);
    f32x4 acc1[2][4], acc2[2][4], accd1[4], accd2[4];
#pragma unroll
    for (int mt = 0; mt < 4; ++mt) { accd1[mt] = (f32x4){0.f, 0.f, 0.f, 0.f}; accd2[mt] = (f32x4){0.f, 0.f, 0.f, 0.f};
#pragma unroll
        for (int nt = 0; nt < 2; ++nt) { acc1[nt][mt] = (f32x4){0.f, 0.f, 0.f, 0.f}; acc2[nt][mt] = (f32x4){0.f, 0.f, 0.f, 0.f}; } }
    const short one = r == 0 ? (short)0x3F80 : (short)0;
    const bf16x8 ones = (bf16x8){one, one, one, one, one, one, one, one};
#pragma unroll
    for (int ks = 0; ks < 4; ++ks) {
        bf16x8 y[4];
#pragma unroll
        for (int mt = 0; mt < 4; ++mt) y[mt] = *(const LAS bf16x8*)(QS + (16 * mt + r) * LD_QS + 32 * ks + 8 * g);
#pragma unroll
        for (int mt = 0; mt < 4; ++mt) {
#pragma unroll
            for (int nt = 0; nt < 2; ++nt) acc2[nt][mt] = mma16(sx[ks][nt], y[mt], acc2[nt][mt]);
            if (MIX == 0) accd2[mt] = mma16(nx[ks], y[mt], accd2[mt]); }
    }
#pragma unroll
    for (int ks = 0; ks < 2; ++ks) {
        bf16x8 x[2], y[4];
#pragma unroll
        for (int nt = 0; nt < 2; ++nt) x[nt] = *(const LAS bf16x8*)(VT + (32 * w + 16 * nt + r) * LD_VT + 32 * ks + 8 * g);
#pragma unroll
        for (int mt = 0; mt < 4; ++mt) y[mt] = *(const LAS bf16x8*)(PS + (16 * mt + r) * LD_VT + 32 * ks + 8 * g);
#pragma unroll
        for (int mt = 0; mt < 4; ++mt) {
#pragma unroll
            for (int nt = 0; nt < 2; ++nt) acc1[nt][mt] = mma16(x[nt], y[mt], acc1[nt][mt]);
            if (MIX == 0) accd1[mt] = mma16(ones, y[mt], accd1[mt]); }
    }
#pragma unroll
    for (int mt = 0; mt < 4; ++mt) { const int tq = 16 * mt + r; float s1 = 0.f, s2 = 0.f, ft = 1.f, rd = 1.f;
        if (MIX == 0) { ft = sf[tq]; const float dl = accd1[mt].x + ft * accd2[mt].x; const float den = __shfl(dl, r); rd = frcp(fmaxf(fabsf(den), fexp(-smt[tq]))); }
#pragma unroll
        for (int nt = 0; nt < 2; ++nt) { f32x4 hv = (acc1[nt][mt] + acc2[nt][mt] * ft) * rd; acc1[nt][mt] = hv; s1 += (hv.x + hv.y) + (hv.z + hv.w); s2 += (hv.x * hv.x + hv.y * hv.y) + (hv.z * hv.z + hv.w * hv.w); }
        s1 += __shfl_xor(s1, 16); s1 += __shfl_xor(s1, 32); s2 += __shfl_xor(s2, 16); s2 += __shfl_xor(s2, 32);
        if (g == 0) *(LAS f32x2_t*)(red + (w * 64 + tq) * 2) = (f32x2_t){s1, s2}; }
    __syncthreads();
#pragma unroll
    for (int mt = 0; mt < 4; ++mt) { const int tq = 16 * mt + r; float s1 = 0.f, s2 = 0.f;
#pragma unroll
        for (int ww = 0; ww < 8; ++ww) { const f32x2_t pr = *(const LAS f32x2_t*)(red + (ww * 64 + tq) * 2); s1 += pr.x; s2 += pr.y; }
        float mean = 0.f, rstd;
        if (MIX == 0) { mean = s1 * (1.f / 256.f); rstd = __builtin_amdgcn_rsqf(fmaxf(s2 * (1.f / 256.f) - mean * mean, 0.f) + LN_EPS); }
        else rstd = __builtin_amdgcn_rsqf(s2 * (1.f / 256.f) + LN_EPS);
#pragma unroll
        for (int nt = 0; nt < 2; ++nt) { const int dv = 32 * w + 16 * nt + 4 * g; const size_t oi = (size_t)(row0 + tq) * 1024 + h * 256 + dv;
            const v2u gw = gwv[mt][nt]; const f32x4 hn = hnv[nt]; const f32x4 hv = acc1[nt][mt];
            const float gi[4] = {bflo(gw.x), bfhi(gw.x), bflo(gw.y), bfhi(gw.y)}; float o[4];
#pragma unroll
            for (int i = 0; i < 4; ++i) { const float sg = frcp(1.f + fexp(-gi[i])); o[i] = (hv[i] - mean) * rstd * hn[i] * (MIX == 0 ? sg : gi[i] * sg); }
            v2u ow; ow.x = pk2(o[0], o[1]); ow.y = pk2(o[2], o[3]); *(v2u*)(Mo + oi) = ow; } }
}
template <int MIX> DI void phase_cprime(Frame& F) {
    chunk_phase_setup<MIX>(F);
    for (int i = blockIdx.x; i < 2048; i += F.G) cprime_unit<MIX>(F, main_unit(i));
}
template <int MIX> DI void phase_chunk0(Frame& F) {
    const int bid = blockIdx.x;
    if (bid >= 8 && bid < 20) { chunk_phase_setup<MIX>(F);
        if (bid < 16) { const int k = bid - 8; aprime_unit<MIX>(F, k < 4 ? k : 1028 + (k - 4)); }
        else cprime_unit<MIX>(F, bid - 16); }
}

struct EpiProj {
    static constexpr bool PERM = true, AFTER_DRAIN = false;
    bf16 *Q, *K, *V, *O;
    DI void operator()(const f32x4 (&acc)[2][2][4][2], const pg8::Unit& u, int wr, int wc, int fr, int fq) const {
        bf16* base; int ld, colt; float sc = 1.f; const int pn = u.pn;
        if (pn < 2) { base = Q; ld = 512; colt = pn * 256; sc = QSCALE; } else if (pn < 4) { base = K; ld = 512; colt = (pn - 2) * 256; }
        else if (pn < 8) { base = V; ld = 1024; colt = (pn - 4) * 256; } else { base = O; ld = 1024; colt = (pn - 8) * 256; }
        const int row0 = u.pm * 256 + wr * 64 + fr, col0 = colt + wc * 32 + 8 * fq;
#pragma unroll
        for (int ai = 0; ai < 2; ++ai)
#pragma unroll
            for (int m = 0; m < 4; ++m) { bf16* rowp = base + (size_t)(row0 + ai * 128 + m * 16) * ld + col0;
#pragma unroll
                for (int bj = 0; bj < 2; ++bj) { const f32x4 v0 = acc[ai][bj][m][0] * sc, v1 = acc[ai][bj][m][1] * sc;
                    v4u w; w.x = pk2(v0[0], v0[1]); w.y = pk2(v0[2], v0[3]); w.z = pk2(v1[0], v1[1]); w.w = pk2(v1[2], v1[3]);
                    *(v4u*)(rowp + bj * 128) = w; } }
    }
};
struct EpiPlain {
    static constexpr bool PERM = true, AFTER_DRAIN = false;
    bf16* O;
    DI void operator()(const f32x4 (&acc)[2][2][4][2], const pg8::Unit& u, int wr, int wc, int fr, int fq) const {
        const int row0 = u.pm * 256 + wr * 64 + fr, col0 = (u.pn & 3) * 256 + wc * 32 + 8 * fq;
#pragma unroll
        for (int ai = 0; ai < 2; ++ai)
#pragma unroll
            for (int m = 0; m < 4; ++m) { bf16* rowp = O + (size_t)(row0 + ai * 128 + m * 16) * 1024 + col0;
#pragma unroll
                for (int bj = 0; bj < 2; ++bj) { const f32x4 v0 = acc[ai][bj][m][0], v1 = acc[ai][bj][m][1];
                    v4u w; w.x = pk2(v0[0], v0[1]); w.y = pk2(v0[2], v0[3]); w.z = pk2(v1[0], v1[1]); w.w = pk2(v1[2], v1[3]);
                    *(v4u*)(rowp + bj * 128) = w; } }
    }
};
struct EpiGU {
    static constexpr bool PERM = true, AFTER_DRAIN = false;
    bf16* Hd;
    DI void operator()(const f32x4 (&acc)[2][2][4][2], const pg8::Unit& u, int wr, int wc, int fr, int fq) const {
        const int row0 = u.pm * 256 + wr * 64 + fr, col0 = (u.pn & 3) * 128 + wc * 32 + 8 * fq;
#pragma unroll
        for (int ai = 0; ai < 2; ++ai)
#pragma unroll
            for (int m = 0; m < 4; ++m) { float o[8];
#pragma unroll
                for (int n = 0; n < 2; ++n)
#pragma unroll
                    for (int i = 0; i < 4; ++i) { const float gte = acc[ai][0][m][n][i], up = acc[ai][1][m][n][i]; o[4 * n + i] = gte * __builtin_amdgcn_rcpf(1.f + __expf(-gte)) * up; }
                v4u w; w.x = pk2(o[0], o[1]); w.y = pk2(o[2], o[3]); w.z = pk2(o[4], o[5]); w.w = pk2(o[6], o[7]);
                *(v4u*)(Hd + (size_t)(row0 + ai * 128 + m * 16) * 512 + col0) = w; }
    }
};
template <bool GA> struct MoeOrder {
    static constexpr bool GATHER = GA;
    const LAS int* tile_e; const LAS int* rowtab; int nunits, G, c;
    DI bool next(int i, pg8::Unit& u) const { const int L = i * G + c; if (L >= nunits) return false; const int t = L >> 2; const int e = __builtin_amdgcn_readfirstlane(tile_e[t]); u.pm = t; u.pn = e * 4 + (L & 3); return true; }
    DI unsigned rowoff(int i, int rin) const { return (unsigned)rowtab[i * 256 + rin] * 2048u; }
    DI void a_ready(const pg8::Unit&) const {}
    DI void done(const pg8::Unit&) const {}
};
template <bool GA> DI int moe_order_setup(Frame& F, int L) {
    LAS int* pst = (LAS int*)(F.lds + TAB_OFF); LAS int* cnt = pst + 40; LAS int* tile_e = pst + 128; LAS int* rowtab = pst + 512;
    moe_tables(F, L, pst, cnt);
    const int ntiles = pst[32] >> 8;
    for (int t = F.tid; t < ntiles; t += NTHR) { int e = 0;
        for (int q = 1; q < 32; ++q) if (pst[q] <= t * 256) e = q;
        tile_e[t] = e; }
    if (GA) { const int* ROWOF = (const int*)(F.ws + WS_ROWOF);
        for (int i = 0; i < 8; ++i) { const int Lu = i * F.G + F.vcu; if (Lu >= ntiles * 4) break; if (F.tid < 256) rowtab[i * 256 + F.tid] = ROWOF[(Lu >> 2) * 256 + F.tid]; } }
    __syncthreads();
    return ntiles;
}
DI void gemm_g1(Frame& F) { pg8::Gemm gm{(const bf16*)(F.ws + WS_HB), (const bf16*)(F.ws + WS_WIN), MR, NPROJ, D}; pg8::StaticOrder S; S.init(MR, NPROJ, F.G, (int)blockIdx.x);
    EpiProj E{(bf16*)(F.ws + WS_Q), (bf16*)(F.ws + WS_K), (bf16*)(F.ws + WS_V), (bf16*)(F.ws + WS_O)};
    pg8::gemm_phase<EpiProj, pg8::StaticOrder, true, true>(F.lds, gm, S, E); }
DI void gemm_g2(Frame& F) { pg8::Gemm gm{(const bf16*)(F.ws + WS_HB), (const bf16*)(F.ws + WS_WOUT), MR, D, D}; pg8::StaticOrder S; S.init(MR, D, F.G, (int)blockIdx.x);
    EpiPlain E{(bf16*)(F.ws + WS_YB)};
    pg8::gemm_phase<EpiPlain, pg8::StaticOrder, true, true>(F.lds, gm, S, E); }
DI void gemm_g3(Frame& F, int L) { const int ntiles = moe_order_setup<true>(F, L);
    pg8::Gemm gm{(const bf16*)(F.ws + WS_HB), (const bf16*)(F.ws + WS_WGU), 0, 0, D}; MoeOrder<true> S{(const LAS int*)(F.lds + TAB_OFF) + 128, (const LAS int*)(F.lds + TAB_OFF) + 512, ntiles * 4, F.G, F.vcu};
    EpiGU E{(bf16*)(F.ws + WS_HDN)};
    pg8::gemm_phase<EpiGU, MoeOrder<true>, true, true>(F.lds, gm, S, E); }
DI void gemm_g4(Frame& F, int L) { const int ntiles = moe_order_setup<false>(F, L);
    pg8::Gemm gm{(const bf16*)(F.ws + WS_HDN), (const bf16*)(F.ws + WS_WD), 0, 0, FF}; MoeOrder<false> S{(const LAS int*)(F.lds + TAB_OFF) + 128, (const LAS int*)(F.lds + TAB_OFF) + 512, ntiles * 4, F.G, F.vcu};
    EpiPlain E{(bf16*)(F.ws + WS_XB)};
    pg8::gemm_phase<EpiPlain, MoeOrder<false>, true, true>(F.lds, gm, S, E); }

constexpr int NPHASE = 23;
#ifndef PH_MASK
#define PH_MASK 0xFFFu
#endif
#define EN(i) (((PH_MASK) >> (i)) & 1u)
#ifndef PH_REP
#define PH_REP 0u
#endif
#define REPS(i) ((((PH_REP) >> (i)) & 1u) ? 2 : 1)
template <int L> DI void layer_phases(Frame& F, const XcdBarrier& bar, int lo, int hi) {
    constexpr int P = 1 + 11 * L;
#define IN(k) (lo <= (k) && (k) < hi)
#define SEAM(k) do { if (IN(k) && IN((k) + 1)) xcd_barrier(bar); } while (0)
    if (EN(0) && IN(P + 0)) { gemm_g1(F); if (REPS(0) == 2) gemm_g1(F); }
    SEAM(P + 0);
    if (EN(1) && IN(P + 1)) { if (L == 0) { phase_s1(F); if (REPS(1) == 2) { __syncthreads(); phase_s1(F); } } phase_chunk0<L>(F); }
    SEAM(P + 1);
    if (EN(2) && IN(P + 2)) { phase_aprime<L>(F); if (REPS(2) == 2) phase_aprime<L>(F); }
    SEAM(P + 2);
    if (EN(3) && IN(P + 3)) phase_scan<L>(F);
    SEAM(P + 3);
    if (EN(4) && IN(P + 4)) { phase_cprime<L>(F); if (REPS(4) == 2) phase_cprime<L>(F); }
    SEAM(P + 4);
    if (EN(5) && IN(P + 5)) { gemm_g2(F); if (REPS(5) == 2) gemm_g2(F); }
    SEAM(P + 5);
    if (EN(6) && IN(P + 6)) phase_t1<L>(F);
    SEAM(P + 6);
    if (EN(7) && IN(P + 7)) phase_d1<L>(F);
    SEAM(P + 7);
    if (EN(8) && IN(P + 8)) { gemm_g3(F, L); if (REPS(8) == 2) gemm_g3(F, L); }
    SEAM(P + 8);
    if (EN(9) && IN(P + 9)) { gemm_g4(F, L); if (REPS(9) == 2) gemm_g4(F, L); }
    SEAM(P + 9);
    if (EN(10) && IN(P + 10)) phase_t2<L>(F);
    if (L == 0) SEAM(P + 10);
#undef IN
#undef SEAM
}

__global__ void __launch_bounds__(NTHR, 2) hybrid_fwd(Args args) {
    extern __shared__ __attribute__((aligned(16))) unsigned char lds[];
    Frame F;
    F.lds = (LAS unsigned char*)lds;
    F.tid = threadIdx.x; F.lane = F.tid & 63; F.wave = __builtin_amdgcn_readfirstlane(F.tid >> 6);
    F.G = gridDim.x; { const int bx = blockIdx.x; F.vcu = (F.G % 8 == 0) ? (bx % 8) * (F.G / 8) + bx / 8 : bx; }
    F.in = args.in; F.out = args.out; F.ws = args.ws;
    F.ctl = (gu32*)(args.ws + WS_CTL);
    volatile LAS unsigned* MISC = (volatile LAS unsigned*)(F.lds + TOP_OFF);
    if (F.tid < 64) MISC[F.tid] = 0u;
    __syncthreads();
    const int lo = args.ph_lo, hi = args.ph_hi;
    XcdBarrier bar; bar.bar = (unsigned*)(F.ctl + CW_BAR); bar.x = 0; bar.st = nullptr;
    if (hi - lo > 1) bar = xcd_barrier_post((unsigned*)(F.ctl + CW_BAR), MISC + 8);
    if (lo <= 0 && 0 < hi) { if (EN(11)) { phase_p0(F); if (REPS(11) == 2) { __syncthreads(); phase_p0(F); } } if (hi > 1) xcd_barrier(bar); }
    layer_phases<0>(F, bar, lo, hi);
    layer_phases<1>(F, bar, lo, hi);
}

#ifndef MK_PER_PHASE
#define MK_PER_PHASE 0
#endif
extern "C" void kernel_launch(void* const* d_in, const int* in_sizes, int n_in, void* d_out, int out_size, void* d_ws, size_t ws_size, hipStream_t stream) {
    static int grid = 0;
    if (grid == 0) {
        if (n_in != 33 || in_sizes[0] != NMAIN * D || out_size != NMAIN * D || ws_size < WS_END) { fprintf(stderr, "kernel_launch: unexpected shapes (n_in %d, in0 %d, out %d, ws %zu)\n", n_in, n_in > 0 ? in_sizes[0] : -1, out_size, ws_size); grid = -1; return; }
        if (hipFuncSetAttribute((const void*)hybrid_fwd, hipFuncAttributeMaxDynamicSharedMemorySize, LDS_BYTES) != hipSuccess) { fprintf(stderr, "kernel_launch: hipFuncSetAttribute failed\n"); grid = -1; return; }
        int dev = 0, cus = 0, per_cu = 0;
        (void)hipGetDevice(&dev); (void)hipDeviceGetAttribute(&cus, hipDeviceAttributeMultiprocessorCount, dev);
        if (hipOccupancyMaxActiveBlocksPerMultiprocessor(&per_cu, (const void*)hybrid_fwd, NTHR, LDS_BYTES) != hipSuccess || per_cu < 1) fprintf(stderr, "kernel_launch: occupancy query reports %d blocks per CU\n", per_cu);
        (void)hipGetLastError();
        grid = 256;
        if (cus < 256) { fprintf(stderr, "kernel_launch: device has %d CUs, need 256\n", cus); grid = -1; return; }
    }
    if (grid < 0) return;
    (void)hipMemsetAsync((char*)d_ws + WS_CTL, 0, CTL_ZERO_BYTES, stream);
    Args a{};
    for (int i = 0; i < 33; ++i) a.in[i] = (const float*)d_in[i];
    a.out = (float*)d_out; a.ws = (unsigned char*)d_ws;
#if MK_PER_PHASE
    for (int p = 0; p < NPHASE; ++p) { a.ph_lo = p; a.ph_hi = p + 1; hipLaunchKernelGGL(hybrid_fwd, dim3(grid), dim3(NTHR), LDS_BYTES, stream, a); }
#else
    a.ph_lo = 0; a.ph_hi = NPHASE;
    hipLaunchKernelGGL(hybrid_fwd, dim3(grid), dim3(NTHR), LDS_BYTES, stream, a);
#endif
}
```

```cpp
#include <hip/hip_runtime.h>
#include <cstdio>
#include <cstdint>
namespace pg8 {
#define PG8_LAS __attribute__((address_space(3)))
typedef unsigned short bf16_t;
typedef short bf16x8 __attribute__((ext_vector_type(8)));
typedef float f32x4 __attribute__((ext_vector_type(4)));
typedef unsigned u32x4 __attribute__((ext_vector_type(4)));
constexpr int BM = 256, BK = 64, HALF = 128, HTB = HALF * BK * 2  , STAGE_BYTES = 8 * HTB, NXCD = 8, WGM = 8;

__host__ __device__ __forceinline__ int lds_byte(int r, int c) { const int st = (r >> 4) * 2 + (c >> 5), rr = r & 15, cc = c & 31, ob = rr * 64 + cc * 2; return st * 1024 + (ob ^ (((ob >> 9) & 1) << 5)); }
__host__ __device__ __forceinline__ void stage_rc(int b, int& R, int& C) { const int st = b / 1024, sb = b % 1024, swz = sb ^ (((sb >> 9) & 1) << 5); R = (st >> 1) * 16 + swz / 64; C = (st & 1) * 32 + (swz % 64) / 2; }
__host__ __device__ __forceinline__ int perm32(int rho) { const int n = rho >> 4, i = rho & 15; return 8 * (i >> 2) + 4 * n + (i & 3); }

struct Unit { int pm, pn; };
struct Gemm { const bf16_t* A; const bf16_t* Bt; int M, N, K; };

struct StaticOrder {
    static constexpr bool GATHER = false;
    int nM, nN, nwg, G, c;
    __host__ __device__ void init(int M, int N, int G_, int c_) { nM = M / BM; nN = N / BM; nwg = nM * nN; G = G_; c = c_; }
    __host__ __device__ bool next(int i, Unit& u) const {
        const long L = (long)i * G + c; if (L >= nwg) return false;
        int wgid = (int)L; { const int q = nwg / NXCD, r = nwg % NXCD, xcd = wgid % NXCD, off = wgid / NXCD; wgid = (xcd < r ? xcd * (q + 1) : r * (q + 1) + (xcd - r) * q) + off; }
        const int nig = WGM * nN, gid = wgid / nig, fm = gid * WGM, gsz = (nM - fm) < WGM ? (nM - fm) : WGM;
        u.pm = fm + ((wgid % nig) % gsz); u.pn = (wgid % nig) / gsz; return true;
    }
    __device__ __forceinline__ void a_ready(const Unit&) const {}
    __device__ __forceinline__ void done(const Unit&) const {}
};

__device__ __forceinline__ unsigned cvt_pk_bf16(float lo, float hi) { unsigned r; asm volatile("v_cvt_pk_bf16_f32 %0, %1, %2" : "=v"(r) : "v"(lo), "v"(hi)); return r; }
template <class Epi, class Sched, bool ALIGN_EPI = false, bool SP2 = false>
__device__ __forceinline__ void gemm_phase(PG8_LAS unsigned char* lds, const Gemm g, const Sched& S, const Epi& E) {
    const int tid = threadIdx.x, wid = __builtin_amdgcn_readfirstlane(tid >> 6), lane = tid & 63, wr = wid >> 2, wc = wid & 3, fr = lane & 15, fq = lane >> 4;
    const int K = g.K, nt = K / BK;
    unsigned voffA[2], voffB[2];
#pragma unroll
    for (int i = 0; i < 2; ++i) { int R, C; stage_rc(tid * 16 + i * 8192, R, C); const int Rb = Epi::PERM ? ((R & ~31) + perm32(R & 31)) : R;
        voffA[i] = (unsigned)(R * K + C) * 2u; voffB[i] = (unsigned)(Rb * K + C) * 2u; }
    unsigned gc[2][2] = {{0u, 0u}, {0u, 0u}}, gn[2][2] = {{0u, 0u}, {0u, 0u}}; int gR[2] = {0, 0}; unsigned gC[2] = {0u, 0u};
    if constexpr (Sched::GATHER) { static_assert(SP2, "GATHER is written for the SP2 loop only");
#pragma unroll
        for (int i = 0; i < 2; ++i) { int R, C; stage_rc(tid * 16 + i * 8192, R, C); gR[i] = R; gC[i] = (unsigned)C * 2u; } }
    const char* gA0 = (const char*)g.A;
    const size_t kstep = (size_t)(BK * 2);
    const size_t hstep = (size_t)HALF * K * 2;
    const size_t tstep = 2 * hstep;
    const unsigned ldsw = (unsigned)wid * 1024u;
    const int aoff = lds_byte(wr * 64 + fr, fq * 8), boff = lds_byte(wc * 32 + fr, fq * 8);
#define PG8_SA(b, h) (((b) * 2 + (h)) * HTB)
#define PG8_SB(b, h) ((4 + (b) * 2 + (h)) * HTB)
#define PG8_STAGE(bufoff, gbase, voff) do { _Pragma("unroll") for (int _i = 0; _i < 2; ++_i) \
        __builtin_amdgcn_global_load_lds((const unsigned*)((const char*)(gbase) + (voff)[_i]), (PG8_LAS unsigned*)(lds + (bufoff) + ldsw + _i * 8192), 16, 0, 0); } while (0)
#define PG8_LDA(dst, b, h) do { _Pragma("unroll") for (int m = 0; m < 4; ++m) _Pragma("unroll") for (int k = 0; k < 2; ++k) dst[m][k] = *(const PG8_LAS bf16x8*)(lds + PG8_SA(b, h) + aoff + m * 2048 + k * 1024); } while (0)
#define PG8_LDB(dst, b, h) do { _Pragma("unroll") for (int n = 0; n < 2; ++n) _Pragma("unroll") for (int k = 0; k < 2; ++k) dst[n][k] = *(const PG8_LAS bf16x8*)(lds + PG8_SB(b, h) + boff + n * 2048 + k * 1024); } while (0)
#define PG8_MMA(ai, bj, At, Bt) do { __builtin_amdgcn_s_setprio(1); _Pragma("unroll") for (int m = 0; m < 4; ++m) _Pragma("unroll") for (int n = 0; n < 2; ++n) _Pragma("unroll") for (int k = 0; k < 2; ++k) \
        acc[ai][bj][m][n] = __builtin_amdgcn_mfma_f32_16x16x32_bf16(Bt[n][k], At[m][k], acc[ai][bj][m][n], 0, 0, 0); __builtin_amdgcn_s_setprio(0); } while (0)
#define PG8_WAIT_V(n) asm volatile("s_waitcnt vmcnt(" #n ")" ::: "memory")
#define PG8_WAIT_L(n) asm volatile("s_waitcnt lgkmcnt(" #n ")" ::: "memory")
#define PG8_BAR __builtin_amdgcn_s_barrier()
#define PG8_SCHED __builtin_amdgcn_sched_barrier(0)
    Unit cur, nxt; int ui = 0;
    if (!S.next(0, cur)) return;
    f32x4 acc[2][2][4][2];
#pragma unroll
    for (int a = 0; a < 2; ++a)
#pragma unroll
        for (int b = 0; b < 2; ++b)
#pragma unroll
            for (int m = 0; m < 4; ++m)
#pragma unroll
                for (int n = 0; n < 2; ++n) acc[a][b][m][n] = (f32x4){0.f, 0.f, 0.f, 0.f};
    bf16x8 At[4][2], B0[2][2], B1[2][2];
    const char* cA = (const char*)g.A + (size_t)cur.pm * tstep; const char* cB = (const char*)g.Bt + (size_t)cur.pn * tstep;
    S.a_ready(cur);
    if constexpr (Sched::GATHER) {
#pragma unroll
        for (int h = 0; h < 2; ++h)
#pragma unroll
            for (int i = 0; i < 2; ++i) gc[h][i] = S.rowoff(0, h * HALF + gR[i]) + gC[i]; }
    if constexpr (SP2) {
        PG8_STAGE(PG8_SB(0, 0), cB, voffB); PG8_STAGE(PG8_SB(0, 1), cB + hstep, voffB);
        if constexpr (Sched::GATHER) { PG8_STAGE(PG8_SA(0, 0), gA0, gc[0]); PG8_STAGE(PG8_SA(0, 1), gA0, gc[1]); } else { PG8_STAGE(PG8_SA(0, 0), cA, voffA); PG8_STAGE(PG8_SA(0, 1), cA + hstep, voffA); }
        if (wr == 1) PG8_BAR;
        PG8_WAIT_V(2); PG8_BAR;
        PG8_STAGE(PG8_SB(1, 0), cB + kstep, voffB); if constexpr (Sched::GATHER) { PG8_STAGE(PG8_SA(1, 0), gA0 + kstep, gc[0]); } else { PG8_STAGE(PG8_SA(1, 0), cA + kstep, voffA); } PG8_STAGE(PG8_SB(1, 1), cB + hstep + kstep, voffB);
        PG8_WAIT_V(6); PG8_BAR;
    } else {
        PG8_STAGE(PG8_SB(0, 0), cB, voffB); PG8_STAGE(PG8_SA(0, 0), cA, voffA); PG8_STAGE(PG8_SB(0, 1), cB + hstep, voffB); PG8_STAGE(PG8_SA(0, 1), cA + hstep, voffA);
        if (wr == 1) PG8_BAR;
        PG8_WAIT_V(4); PG8_BAR;
        PG8_STAGE(PG8_SB(1, 0), cB + kstep, voffB); PG8_STAGE(PG8_SA(1, 0), cA + kstep, voffA); PG8_STAGE(PG8_SB(1, 1), cB + hstep + kstep, voffB);
        PG8_WAIT_V(6); PG8_BAR;
    }
    for (;;) {
        const bool has_next = S.next(ui + 1, nxt);
        const char* nA = has_next ? (const char*)g.A + (size_t)nxt.pm * tstep : cA; const char* nB = has_next ? (const char*)g.Bt + (size_t)nxt.pn * tstep : cB;
        if constexpr (Sched::GATHER) {
#pragma unroll
            for (int h = 0; h < 2; ++h)
#pragma unroll
                for (int i = 0; i < 2; ++i) gn[h][i] = has_next ? S.rowoff(ui + 1, h * HALF + gR[i]) + gC[i] : gc[h][i]; }
        for (int t = 0; t < nt; t += 2) {
            const bool last = (t == nt - 2);
            const char* a1 = cA + (size_t)(t + 1) * kstep;
            const char* a2 = last ? nA : cA + (size_t)(t + 2) * kstep; const char* b2 = last ? nB : cB + (size_t)(t + 2) * kstep;
            const char* a3 = a2 + kstep; const char* b3 = b2 + kstep;
            if (last && has_next) S.a_ready(nxt);
            if constexpr (SP2) {
            const size_t gk2 = last ? (size_t)0 : (size_t)(t + 2) * kstep;
            unsigned g2[2][2];
            if constexpr (Sched::GATHER) {
#pragma unroll
                for (int h = 0; h < 2; ++h)
#pragma unroll
                    for (int i = 0; i < 2; ++i) g2[h][i] = last ? gn[h][i] : gc[h][i]; }
            PG8_LDB(B0, 0, 0); PG8_LDB(B1, 0, 1); PG8_SCHED; PG8_LDA(At, 0, 0); if constexpr (Sched::GATHER) { PG8_STAGE(PG8_SA(1, 1), gA0 + (size_t)(t + 1) * kstep, gc[1]); } else { PG8_STAGE(PG8_SA(1, 1), a1 + hstep, voffA); }
            PG8_WAIT_V(8); PG8_WAIT_L(0); PG8_BAR; PG8_MMA(0, 0, At, B0); PG8_MMA(0, 1, At, B1); PG8_BAR; PG8_SCHED;
            PG8_LDA(At, 0, 1); PG8_STAGE(PG8_SB(0, 0), b2, voffB); PG8_STAGE(PG8_SB(0, 1), b2 + hstep, voffB); if constexpr (Sched::GATHER) { PG8_STAGE(PG8_SA(0, 0), gA0 + gk2, g2[0]); } else { PG8_STAGE(PG8_SA(0, 0), a2, voffA); }
            PG8_WAIT_V(8); PG8_WAIT_L(0); PG8_BAR; PG8_MMA(1, 0, At, B0); PG8_MMA(1, 1, At, B1); PG8_BAR; PG8_SCHED;
            PG8_LDB(B0, 1, 0); PG8_LDB(B1, 1, 1); PG8_SCHED; PG8_LDA(At, 1, 0); if constexpr (Sched::GATHER) { PG8_STAGE(PG8_SA(0, 1), gA0 + gk2, g2[1]); } else { PG8_STAGE(PG8_SA(0, 1), a2 + hstep, voffA); }
            PG8_WAIT_V(8); PG8_WAIT_L(0); PG8_BAR; PG8_MMA(0, 0, At, B0); PG8_MMA(0, 1, At, B1); PG8_BAR; PG8_SCHED;
            PG8_LDA(At, 1, 1); PG8_STAGE(PG8_SB(1, 0), b3, voffB); PG8_STAGE(PG8_SB(1, 1), b3 + hstep, voffB); if constexpr (Sched::GATHER) { PG8_STAGE(PG8_SA(1, 0), gA0 + gk2 + kstep, g2[0]); } else { PG8_STAGE(PG8_SA(1, 0), a3, voffA); }
            PG8_WAIT_V(8); PG8_WAIT_L(0); PG8_BAR; PG8_MMA(1, 0, At, B0); PG8_MMA(1, 1, At, B1); PG8_BAR; PG8_SCHED;
            } else {
            PG8_LDB(B0, 0, 0); PG8_SCHED; PG8_LDA(At, 0, 0); PG8_STAGE(PG8_SA(1, 1), a1 + hstep, voffA);
            PG8_WAIT_L(8); PG8_BAR; PG8_WAIT_L(0); PG8_MMA(0, 0, At, B0); PG8_BAR; PG8_SCHED;
            PG8_LDB(B1, 0, 1); PG8_STAGE(PG8_SB(0, 0), b2, voffB);
            PG8_BAR; PG8_WAIT_L(0); PG8_MMA(0, 1, At, B1); PG8_BAR;
            PG8_LDA(At, 0, 1); PG8_STAGE(PG8_SA(0, 0), a2, voffA);
            PG8_BAR; PG8_WAIT_L(0); PG8_MMA(1, 0, At, B0); PG8_BAR; PG8_SCHED;
            PG8_STAGE(PG8_SB(0, 1), b2 + hstep, voffB);
            PG8_WAIT_V(6); PG8_BAR; PG8_MMA(1, 1, At, B1); PG8_BAR;
            PG8_LDB(B0, 1, 0); PG8_SCHED; PG8_LDA(At, 1, 0); PG8_STAGE(PG8_SA(0, 1), a2 + hstep, voffA);
            PG8_WAIT_L(8); PG8_BAR; PG8_WAIT_L(0); PG8_MMA(0, 0, At, B0); PG8_BAR; PG8_SCHED;
            PG8_LDB(B1, 1, 1); PG8_STAGE(PG8_SB(1, 0), b3, voffB);
            PG8_BAR; PG8_WAIT_L(0); PG8_MMA(0, 1, At, B1); PG8_BAR;
            PG8_LDA(At, 1, 1); PG8_STAGE(PG8_SA(1, 0), a3, voffA);
            PG8_BAR; PG8_WAIT_L(0); PG8_MMA(1, 0, At, B0); PG8_BAR; PG8_SCHED;
            PG8_STAGE(PG8_SB(1, 1), b3 + hstep, voffB);
            PG8_WAIT_V(6); PG8_BAR; PG8_MMA(1, 1, At, B1); PG8_BAR;
            }
        }
        if constexpr (ALIGN_EPI) { if (wr == 0) PG8_BAR; }
        if constexpr (!Epi::AFTER_DRAIN) { E(acc, cur, wr, wc, fr, fq); S.done(cur); }
        if (!has_next) break;
#pragma unroll
        for (int a = 0; a < 2; ++a)
#pragma unroll
            for (int b = 0; b < 2; ++b)
#pragma unroll
                for (int m = 0; m < 4; ++m)
#pragma unroll
                    for (int n = 0; n < 2; ++n) acc[a][b][m][n] = (f32x4){0.f, 0.f, 0.f, 0.f};
        cur = nxt; cA = nA; cB = nB; ++ui;
        if constexpr (Sched::GATHER) {
#pragma unroll
            for (int h = 0; h < 2; ++h)
#pragma unroll
                for (int i = 0; i < 2; ++i) gc[h][i] = gn[h][i]; }
        if constexpr (ALIGN_EPI) { if (wr == 1) PG8_BAR; }
    }
    PG8_WAIT_V(0);
    if constexpr (!ALIGN_EPI) { if (wr == 0) PG8_BAR; }
    PG8_BAR;
    if constexpr (Epi::AFTER_DRAIN) { E.fused(acc, cur, wr, wc, fr, fq, lds, wid, lane); S.done(cur); }
#undef PG8_SA
#undef PG8_SB
#undef PG8_STAGE
#undef PG8_LDA
#undef PG8_LDB
#undef PG8_MMA
#undef PG8_WAIT_V
#undef PG8_WAIT_L
#undef PG8_BAR
#undef PG8_SCHED
}
}

#define DI __device__ __forceinline__
#define GAS __attribute__((address_space(1)))
#define LAS __attribute__((address_space(3)))
typedef unsigned short bf16;
typedef unsigned v4u __attribute__((ext_vector_type(4)));
typedef unsigned v2u __attribute__((ext_vector_type(2)));
typedef float f32x4 __attribute__((ext_vector_type(4)));
typedef short bf16x8 __attribute__((ext_vector_type(8)));
typedef GAS unsigned gu32;

constexpr int D = 1024, NMAIN = 32768, SEQ = 16384, MR = 33024, CH0ROW = 32768, METAROW = 32816, NMETA = 16, NTOK = NMAIN + NMETA;
constexpr int NCHUNK = 257, NUNIT = 2 * NCHUNK * 4;
constexpr int NPROJ = 3072, NE = 32, FF = 512, PMAXT = 289;
constexpr float ALPHA = 1.41421356237f, LN_EPS = 1e-5f, QSCALE = 0.08838834764831845f, NEGBIG = -1e30f;
constexpr int NWAVES = 8, NTHR = 512;

constexpr size_t MiB = 1u << 20;
constexpr size_t WS_CTL = 0, CTL_ZERO_BYTES = 1 * MiB;
constexpr size_t WS_GATES = 1 * MiB;
constexpr size_t WS_A = WS_GATES + (size_t)MR * 32;
constexpr size_t WS_MX = WS_A + (size_t)MR * 16;
constexpr size_t WS_MT = WS_MX + (size_t)MR * 16;
constexpr size_t WS_GLR = WS_MT + (size_t)MR * 16;
constexpr size_t WS_EID = WS_GLR + (size_t)MR * 64;
constexpr size_t WS_EW = WS_EID + (size_t)NTOK * 8;
constexpr size_t WS_SLOT = WS_EW + (size_t)NTOK * 8;
constexpr size_t WS_GDEC = WS_SLOT + (size_t)NTOK * 8;
constexpr size_t WS_DN = WS_GDEC + (size_t)NUNIT * 512;
constexpr size_t WS_METAF = WS_DN + (size_t)NUNIT * 512;
constexpr size_t WS_ROWOF = WS_METAF + 65536;
static_assert(WS_ROWOF + (size_t)PMAXT * 1024 <= 10 * MiB, "small buffers");
constexpr size_t WS_WIN = 10 * MiB, WS_WOUT = 16 * MiB, WS_WGU = 18 * MiB, WS_WD = 82 * MiB;
constexpr size_t WS_HB = 114 * MiB;
constexpr size_t WS_ARENA = 179 * MiB;
constexpr size_t WS_Q = WS_ARENA, WS_K = WS_Q + (size_t)MR * 1024, WS_V = WS_K + (size_t)MR * 1024, WS_O = WS_V + (size_t)MR * 2048, WS_ST = WS_O + (size_t)MR * 2048;
constexpr size_t WS_YB = WS_Q;
constexpr size_t WS_XB = WS_V;
constexpr size_t WS_HDN = WS_XB + (size_t)PMAXT * 256 * 2048;
constexpr size_t WS_END = WS_ST + (size_t)NUNIT * 65536;
static_assert(WS_HDN + (size_t)PMAXT * 256 * 1024 <= WS_END, "moe overlay");
static_assert(WS_END == 501 * MiB, "ws map");
constexpr int CW_BAR = 4096;
constexpr int CW_CNT = 16384;
constexpr int CW_CUR = 16384 + 256;
constexpr int LDS_BYTES = 155648, TAB_OFF = 131072, TOP_OFF = 154624;

typedef __bf16 bf16x2_t __attribute__((ext_vector_type(2)));
typedef float f32x2_t __attribute__((ext_vector_type(2)));
DI unsigned pk2(float lo, float hi) { const f32x2_t v = {lo, hi}; return __builtin_bit_cast(unsigned, __builtin_convertvector(v, bf16x2_t)); }
DI unsigned f2bf(float f) { return pk2(f, 0.f) & 0xffffu; }
DI float bflo(unsigned w) { return __builtin_bit_cast(float, w << 16); }
DI float bfhi(unsigned w) { return __builtin_bit_cast(float, w & 0xffff0000u); }
DI float bf2f(bf16 b) { return __builtin_bit_cast(float, (unsigned)b << 16); }
#define LDS_WAIT() asm volatile("s_waitcnt lgkmcnt(0)" ::: "memory")
DI float wave_sum(float v) {
#pragma unroll
    for (int o = 1; o < 64; o <<= 1) v += __shfl_xor(v, o);
    return v;
}
template <int N, int OFF> struct FoldStep {
    template <int NP> static DI float run(float (&p)[NP], int lane) {
        constexpr int half = N / 2; const bool hi = (lane & OFF) != 0;
#pragma unroll
        for (int i = 0; i < half; ++i) { const float keep = hi ? p[half + i] : p[i], send = hi ? p[i] : p[half + i]; p[i] = keep + __shfl_xor(send, OFF); }
        return FoldStep<half, OFF / 2>::run(p, lane);
    }
};
template <int OFF> struct FoldStep<1, OFF> {
    template <int NP> static DI float run(float (&p)[NP], int lane) { float r = p[0];
#pragma unroll
        for (int off = OFF; off >= 1; off >>= 1) r += __shfl_xor(r, off);
        return r; }
};
template <int N> DI float fold_reduce(float (&p)[N], int lane) { return FoldStep<N, 32>::run(p, lane); }
DI float logsig(float z) { return fminf(z, 0.f) - log1pf(expf(-fabsf(z))); }
DI f32x4 mma16(bf16x8 x, bf16x8 y, f32x4 c) { return __builtin_amdgcn_mfma_f32_16x16x32_bf16(x, y, c, 0, 0, 0); }
#define XB_TMO      128
#define XB_XCNT(j)  (256  + 64 * (j))
#define XB_XSUB(j)  (1280 + 64 * (j))
#define XB_XGEN(j)  (2304 + 64 * (j))
#define XB_TOP      3328
#define XB_TOPGEN   3392
#define XCD_BAR_WORDS 3456
#define XB_SPIN_CAP (1u << 18)

__device__ __forceinline__ unsigned xb_ld(unsigned* p)              { return __hip_atomic_load(p, __ATOMIC_RELAXED, __HIP_MEMORY_SCOPE_AGENT); }
__device__ __forceinline__ unsigned xb_add(unsigned* p, unsigned v) { return __hip_atomic_fetch_add(p, v, __ATOMIC_RELAXED, __HIP_MEMORY_SCOPE_AGENT); }
__device__ __forceinline__ unsigned xb_xcc_id() { return (unsigned)__builtin_amdgcn_s_getreg((3 << 11) | 20) & 0xFu; }
#define XB_SPIN(cond, bar) do { unsigned _sp = 0; while (cond) { __builtin_amdgcn_s_sleep(1); \
    if ((++_sp & 255u) == 0u) { if (xb_ld(&(bar)[XB_TMO])) break; if (_sp > XB_SPIN_CAP) { atomicAdd(&(bar)[XB_TMO], 1u); break; } } } } while (0)

struct XcdBarrier {
    unsigned* bar; unsigned x;
    volatile LAS unsigned* st;
};

__device__ __forceinline__ XcdBarrier xcd_barrier_post(unsigned* bar, volatile LAS unsigned* st) {
    XcdBarrier b; b.bar = bar; b.x = xb_xcc_id(); b.st = st;
    if (threadIdx.x == 0) (void)xb_add(&bar[XB_XCNT(b.x)], 1u);
    return b;
}
__device__ __forceinline__ void xcd_barrier_complete(unsigned* bar, unsigned x, unsigned& nloc, unsigned& nx) {
    const unsigned G = gridDim.x * gridDim.y * gridDim.z;
    unsigned sum, cnt, mine, sp = 0u;
    for (;;) {
        sum = 0u; cnt = 0u; mine = 0u;
#pragma unroll
        for (unsigned j = 0; j < 16; ++j) { const unsigned c = xb_ld(&bar[XB_XCNT(j)]); sum += c; cnt += (c > 0u) ? 1u : 0u; mine = (j == x) ? c : mine; }
        if (sum == G) break;
        __builtin_amdgcn_s_sleep(1);
        if ((++sp & 255u) == 0u) { if (xb_ld(&bar[XB_TMO])) break; if (sp > XB_SPIN_CAP) { atomicAdd(&bar[XB_TMO], 1u); break; } }
    }
    nloc = mine > 0u ? mine : 1u; nx = cnt > 0u ? cnt : 1u;
}

__device__ __forceinline__ void xcd_barrier(const XcdBarrier& b) {
    asm volatile("s_waitcnt vmcnt(0)" ::: "memory");
    __syncthreads();
    if (threadIdx.x == 0) {
        unsigned* bar = b.bar;
        __builtin_amdgcn_s_waitcnt(0);
        unsigned nloc = b.st[0], nx = b.st[1];
        if (nloc == 0u) { xcd_barrier_complete(bar, b.x, nloc, nx); b.st[0] = nloc; b.st[1] = nx; }
        const unsigned old = xb_add(&bar[XB_XSUB(b.x)], 1u);
        const unsigned gen = old / nloc;
        if (old + 1u == (gen + 1u) * nloc) {
            __builtin_amdgcn_fence(__ATOMIC_RELEASE, "agent");
            asm volatile("s_waitcnt vmcnt(0)" ::: "memory");
            const unsigned og = xb_add(&bar[XB_TOP], 1u);
            const unsigned tg = og / nx;
            if (og + 1u == (tg + 1u) * nx) xb_add(&bar[XB_TOPGEN], 1u);
            else XB_SPIN(xb_ld(&bar[XB_TOPGEN]) == tg, bar);
            __builtin_amdgcn_fence(__ATOMIC_ACQUIRE, "agent");
            xb_add(&bar[XB_XGEN(b.x)], 1u);
            asm volatile("s_waitcnt vmcnt(0)" ::: "memory");
        } else {
            XB_SPIN(xb_ld(&bar[XB_XGEN(b.x)]) == gen, bar);
            __builtin_amdgcn_fence(__ATOMIC_ACQUIRE, "agent");
            asm volatile("s_waitcnt vmcnt(0)" ::: "memory");
        }
    }
    __syncthreads();
}

struct Args { const float* in[33]; float* out; unsigned char* ws; int ph_lo, ph_hi; };
struct Frame {
    LAS unsigned char* lds;
    gu32* ctl;
    int tid, lane, wave, G, vcu;
    const float* const* in;
    float* out; unsigned char* ws;
};
DI int tok_row(int tok) { return tok < NMAIN ? tok : tok + (METAROW - NMAIN); }

DI void transpose_item(const float* W, int ldw, int k0, int n0, bf16* WT, int Kd, int drow0, LAS float* scr, int lane) {
#pragma unroll 8
    for (int i = 0; i < 32; ++i) { const int kk = 2 * i + (lane >> 5); scr[kk * 33 + (lane & 31)] = W[(size_t)(k0 + kk) * ldw + n0 + (lane & 31)]; }
    LDS_WAIT(); asm volatile("" ::: "memory");
    const int c = lane & 7;
#pragma unroll
    for (int j = 0; j < 4; ++j) { const int n = (lane >> 3) + 8 * j; const LAS float* s = scr + (8 * c) * 33 + n;
        v4u o; o.x = pk2(s[0 * 33], s[1 * 33]); o.y = pk2(s[2 * 33], s[3 * 33]); o.z = pk2(s[4 * 33], s[5 * 33]); o.w = pk2(s[6 * 33], s[7 * 33]);
        *(v4u*)(WT + (size_t)(drow0 + n) * Kd + k0 + 8 * c) = o; }
    LDS_WAIT(); asm volatile("" ::: "memory");
}
template <int L> DI void convert_weights(Frame& F) {
    constexpr int IB = L ? 17 : 2;
    const float* w_in = F.in[IB]; const int ld_in = L ? 3088 : 3080;
    const float* w_out = F.in[L ? 21 : 5];
    const float* w_g = F.in[L ? 28 : 12]; const float* w_u = F.in[L ? 29 : 13]; const float* w_d = F.in[L ? 30 : 14];
    bf16* WIN = (bf16*)(F.ws + WS_WIN); bf16* WOUT = (bf16*)(F.ws + WS_WOUT); bf16* WGU = (bf16*)(F.ws + WS_WGU); bf16* WD = (bf16*)(F.ws + WS_WD);
    LAS float* scr = (LAS float*)(F.lds + F.wave * 16384);
    const int gw = F.vcu * NWAVES + F.wave, NGW = F.G * NWAVES;
    constexpr int I_IN = 16 * 96, I_OUT = 16 * 32, I_G = 32 * 256, I_D = 32 * 256, NITEMS = I_IN + I_OUT + 2 * I_G + I_D;
    for (int it = gw; it < NITEMS; it += NGW) {
        int r = it;
        if (r < I_IN) { const int kb = r / 96, nb = r % 96; transpose_item(w_in, ld_in, 64 * kb, 32 * nb, WIN, 1024, 32 * nb, scr, F.lane); continue; } r -= I_IN;
        if (r < I_OUT) { const int kb = r / 32, nb = r % 32; transpose_item(w_out, 1024, 64 * kb, 32 * nb, WOUT, 1024, 32 * nb, scr, F.lane); continue; } r -= I_OUT;
        if (r < 2 * I_G) { const int up = r >= I_G; if (up) r -= I_G; const int e = r >> 8, rr = r & 255, kb = rr >> 4, nb = rr & 15, n0 = 32 * nb;
            transpose_item((up ? w_u : w_g) + (size_t)e * 1024 * 512, 512, 64 * kb, n0, WGU, 1024, e * 1024 + (n0 >> 7) * 256 + up * 128 + (n0 & 127), scr, F.lane); continue; } r -= 2 * I_G;
        { const int e = r >> 8, rr = r & 255, kb = rr >> 5, nb = rr & 31; transpose_item(w_d + (size_t)e * 512 * 1024, 1024, 64 * kb, 32 * nb, WD, 512, e * 1024 + 32 * nb, scr, F.lane); }
    }
}
template <int NC, int STR> DI void stage_cols(const float* W, int ldw, int col0, LAS float* dst, int tid) {
#pragma unroll 4
    for (int idx = tid; idx < NC * 1024; idx += NTHR) { const int e = idx % NC, k = idx / NC; dst[e * STR + k] = W[(size_t)k * ldw + col0 + e]; }
}
DI void ln_row(f32x4 (&v)[4], const float* lg, const float* lb, int lane) {
    float s = 0.f;
#pragma unroll
    for (int j = 0; j < 4; ++j) s += (v[j].x + v[j].y) + (v[j].z + v[j].w);
    const float mean = wave_sum(s) * (1.f / D); float s2 = 0.f;
#pragma unroll
    for (int j = 0; j < 4; ++j) { v[j] = v[j] - mean; s2 += (v[j].x * v[j].x + v[j].y * v[j].y) + (v[j].z * v[j].z + v[j].w * v[j].w); }
    const float rstd = 1.f / sqrtf(wave_sum(s2) * (1.f / D) + LN_EPS);
#pragma unroll
    for (int j = 0; j < 4; ++j) { const f32x4 g = *(const f32x4*)(lg + 256 * j + 4 * lane), b = *(const f32x4*)(lb + 256 * j + 4 * lane); v[j] = v[j] * rstd * g + b; }
}
DI void store_row_bf16(bf16* orow, const f32x4 (&v)[4], int lane) {
    unsigned long long* o8 = (unsigned long long*)orow + lane;
#pragma unroll
    for (int j = 0; j < 4; ++j) o8[64 * j] = (unsigned long long)pk2(v[j].x, v[j].y) | ((unsigned long long)pk2(v[j].z, v[j].w) << 32);
}
template <int NC, int STR> DI float row_dots(const f32x4 (&v)[4], const LAS float* wl, int lane) {
    float p[NC];
#pragma unroll
    for (int e = 0; e < NC; ++e) { float a = 0.f;
#pragma unroll
        for (int j = 0; j < 4; ++j) { const f32x4 w = *(const LAS f32x4*)(wl + e * STR + 256 * j + 4 * lane); a += (v[j].x * w.x + v[j].y * w.y) + (v[j].z * w.z + v[j].w * w.w); }
        p[e] = a; if ((e & 3) == 3) asm volatile("" : "+v"(p[e - 3]), "+v"(p[e - 2]), "+v"(p[e - 1]), "+v"(p[e]) :: "memory"); }
    return fold_reduce<NC>(p, lane);
}

DI void phase_p0(Frame& F) {
    bf16* HB = (bf16*)(F.ws + WS_HB);
    for (int i = blockIdx.x * NTHR + F.tid; i < 240 * 128; i += F.G * NTHR) { const int ri = i >> 7, r = ri < 48 ? CH0ROW + ri : 32832 + (ri - 48);
        *(v4u*)(HB + (size_t)r * D + (i & 127) * 8) = (v4u){0u, 0u, 0u, 0u}; }
    convert_weights<0>(F);
    __syncthreads();
    LAS float* wg = (LAS float*)F.lds;
    stage_cols<8, 1028>(F.in[2], 3080, 3072, wg, F.tid);
    __syncthreads();
    const float* x = F.in[0]; const float* meta = F.in[1]; const float* bg = F.in[3];
    float* GATES = (float*)(F.ws + WS_GATES);
    const int gw = F.vcu * NWAVES + F.wave, NGW = F.G * NWAVES;
#pragma unroll 1
    for (int tok = gw; tok < NTOK; tok += NGW) {
        const float* src = tok < NMAIN ? x + (size_t)tok * D : meta + (size_t)(tok - NMAIN) * D; const int row = tok_row(tok);
        f32x4 v[4];
#pragma unroll
        for (int j = 0; j < 4; ++j) v[j] = *(const f32x4*)(src + 256 * j + 4 * F.lane);
        store_row_bf16(HB + (size_t)row * D, v, F.lane);
        const float r = row_dots<8, 1028>(v, wg, F.lane);
        if ((F.lane & 7) == 0) GATES[(size_t)row * 8 + (F.lane >> 3)] = r + bg[F.lane >> 3];
    }
}

template <bool MAXOP> DI float block_scan_excl(float val, LAS float* sb, int tid) {
    sb[tid] = val; __syncthreads();
#pragma unroll 1
    for (int off = 1; off < NTHR; off <<= 1) { float t = MAXOP ? -3.0e38f : 0.f; if (tid >= off) t = sb[tid - off]; __syncthreads(); sb[tid] = MAXOP ? fmaxf(sb[tid], t) : sb[tid] + t; __syncthreads(); }
    const float r = tid ? sb[tid - 1] : (MAXOP ? -3.0e38f : 0.f); __syncthreads();
    return r;
}
DI void phase_s1(Frame& F) {
    if (blockIdx.x >= 8) return;
    const int b = blockIdx.x >> 2, h = blockIdx.x & 3, tid = F.tid;
    const float* GATES = (const float*)(F.ws + WS_GATES);
    float* A = (float*)(F.ws + WS_A); float* MX = (float*)(F.ws + WS_MX); float* MT = (float*)(F.ws + WS_MT);
    LAS float* sb = (LAS float*)F.lds; LAS float* bc = sb + 512;
    if (tid == 0) { float B = 0.f, M = 0.f;
        for (int j = 0; j < NMETA; ++j) { const int row = METAROW + j; const float li = GATES[row * 8 + h], lf = logsig(GATES[row * 8 + 4 + h]); B += lf; const float a = li - B; M = fmaxf(M, a);
            if (b == 0) { A[row * 4 + h] = a; MX[row * 4 + h] = M; MT[row * 4 + h] = B + M; } }
        bc[0] = B; bc[1] = M; }
    if (b == 0 && tid < 48) { const int row = CH0ROW + tid; A[row * 4 + h] = NEGBIG; MX[row * 4 + h] = 0.f; MT[row * 4 + h] = 0.f; }
    __syncthreads();
    const float Bm = bc[0], Mm = bc[1];
    const int r0 = b * SEQ + 32 * tid;
    float run = 0.f;
#pragma unroll 4
    for (int j = 0; j < 32; ++j) run += logsig(GATES[(size_t)(r0 + j) * 8 + 4 + h]);
    const float off = block_scan_excl<false>(run, sb, tid) + Bm;
    float Bc = off, mx = -3.0e38f;
#pragma unroll 4
    for (int j = 0; j < 32; ++j) { const size_t row = r0 + j; Bc += logsig(GATES[row * 8 + 4 + h]); const float a = GATES[row * 8 + h] - Bc; mx = fmaxf(mx, a); A[row * 4 + h] = a; MT[row * 4 + h] = Bc; }
    const float pre = fmaxf(block_scan_excl<true>(mx, sb, tid), Mm);
    float M = pre;
#pragma unroll 4
    for (int j = 0; j < 32; ++j) { const size_t row = r0 + j; M = fmaxf(M, A[row * 4 + h]); MX[row * 4 + h] = M; MT[row * 4 + h] += M; }
}

template <int L> DI void phase_t1(Frame& F) {
    LAS float* wr = (LAS float*)F.lds;
    LAS int* hist = (LAS int*)(F.lds + 148032);
    stage_cols<32, 1028>(F.in[L ? 26 : 10], 32, 0, wr, F.tid);
    stage_cols<4, 1028>(F.in[L ? 24 : 8], 4, 0, wr + 32 * 1028, F.tid);
    if (F.tid < 32) hist[F.tid] = 0;
    __syncthreads();
    const float* lg = F.in[L ? 22 : 6]; const float* lb = F.in[L ? 23 : 7]; const float* b_grp = F.in[L ? 25 : 9]; const float* b_rt = F.in[L ? 27 : 11];
    const bf16* YB = (const bf16*)(F.ws + WS_YB); bf16* HB = (bf16*)(F.ws + WS_HB); float* METAF = (float*)(F.ws + WS_METAF);
    int* EID = (int*)(F.ws + WS_EID); float* EW = (float*)(F.ws + WS_EW);
    const int gw = F.vcu * NWAVES + F.wave, NGW = F.G * NWAVES;
#pragma unroll 1
    for (int tok = gw; tok < NTOK; tok += NGW) {
        const int row = tok_row(tok);
        const float* hp = (L == 0) ? (tok < NMAIN ? F.in[0] + (size_t)tok * D : F.in[1] + (size_t)(tok - NMAIN) * D)
                                   : (tok < NMAIN ? F.out + (size_t)tok * D : METAF + (size_t)(tok - NMAIN) * D);
        float* hf = tok < NMAIN ? F.out + (size_t)tok * D : METAF + (size_t)(tok - NMAIN) * D;
        f32x4 v[4];
#pragma unroll
        for (int j = 0; j < 4; ++j) { const f32x4 hv = *(const f32x4*)(hp + 256 * j + 4 * F.lane); const v2u yw = *(const v2u*)(YB + (size_t)row * D + 256 * j + 4 * F.lane);
            v[j].x = ALPHA * hv.x + bflo(yw.x); v[j].y = ALPHA * hv.y + bfhi(yw.x); v[j].z = ALPHA * hv.z + bflo(yw.y); v[j].w = ALPHA * hv.w + bfhi(yw.y); }
        ln_row(v, lg, lb, F.lane);
#pragma unroll
        for (int j = 0; j < 4; ++j) *(f32x4*)(hf + 256 * j + 4 * F.lane) = v[j];
        store_row_bf16(HB + (size_t)row * D, v, F.lane);
        const float r16a = row_dots<16, 1028>(v, wr, F.lane);
        const float r16b = row_dots<16, 1028>(v, wr + 16 * 1028, F.lane);
        const float r4 = row_dots<4, 1028>(v, wr + 32 * 1028, F.lane);
        float gl[4];
#pragma unroll
        for (int j = 0; j < 4; ++j) gl[j] = __shfl(r4, 16 * j) + b_grp[j];
        int gt = 0; float gm = gl[0];
#pragma unroll
        for (int j = 1; j < 4; ++j) if (gl[j] > gm) { gm = gl[j]; gt = j; }
        float se = 0.f;
#pragma unroll
        for (int j = 0; j < 4; ++j) se += expf(gl[j] - gm);
        const float pg = 1.f / se;
        float wv[8];
#pragma unroll
        for (int i = 0; i < 8; ++i) wv[i] = __shfl(gt < 2 ? r16a : r16b, 4 * ((gt & 1) * 8 + i)) + b_rt[gt * 8 + i];
        int i0 = 0; float v0 = wv[0];
#pragma unroll
        for (int i = 1; i < 8; ++i) if (wv[i] > v0) { v0 = wv[i]; i0 = i; }
        int i1 = -1; float v1 = -3.0e38f;
#pragma unroll
        for (int i = 0; i < 8; ++i) if (i != i0 && wv[i] > v1) { v1 = wv[i]; i1 = i; }
        const float e1 = expf(v1 - v0), w0 = 1.f / (1.f + e1), w1 = e1 * w0;
        if (F.lane == 0) { const int ea = gt * 8 + i0, eb = gt * 8 + i1; EID[tok * 2] = ea; EID[tok * 2 + 1] = eb; EW[tok * 2] = pg * w0; EW[tok * 2 + 1] = pg * w1;
            __hip_atomic_fetch_add(&hist[ea], 1, __ATOMIC_RELAXED, __HIP_MEMORY_SCOPE_WORKGROUP); __hip_atomic_fetch_add(&hist[eb], 1, __ATOMIC_RELAXED, __HIP_MEMORY_SCOPE_WORKGROUP); }
    }
    __syncthreads();
    if (F.tid < 32 && hist[F.tid]) atomicAdd((unsigned*)(F.ctl + CW_CNT + 64 * L + F.tid), (unsigned)hist[F.tid]);
}

DI void moe_tables(Frame& F, int L, LAS int* pst, LAS int* cnt) {
    if (F.tid < 32) cnt[F.tid] = (int)__hip_atomic_load(F.ctl + CW_CNT + 64 * L + F.tid, __ATOMIC_RELAXED, __HIP_MEMORY_SCOPE_AGENT);
    __syncthreads();
    if (F.tid == 0) { int s = 0; for (int e = 0; e < 32; ++e) { pst[e] = s; s += ((cnt[e] + 255) >> 8) << 8; } pst[32] = s; }
    __syncthreads();
}
template <int L> DI void phase_d1(Frame& F) {
    LAS int* pst = (LAS int*)F.lds; LAS int* cnt = pst + 40; LAS int* lh = cnt + 32; LAS int* lbase = lh + 32;
    if (F.tid < 32) lh[F.tid] = 0;
    moe_tables(F, L, pst, cnt);
    const int* EID = (const int*)(F.ws + WS_EID); int* SLOT = (int*)(F.ws + WS_SLOT); int* ROWOF = (int*)(F.ws + WS_ROWOF);
    const int TPB = (NTOK + F.G - 1) / F.G;
    const int t0 = blockIdx.x * TPB; int nt = NTOK - t0; nt = nt < 0 ? 0 : (nt > TPB ? TPB : nt);
    const int i = F.tid; const bool valid = i < 2 * nt; const int tok = t0 + (i >> 1);
    int e = 0, rank = 0;
    if (valid) { e = EID[tok * 2 + (i & 1)]; rank = __hip_atomic_fetch_add(&lh[e], 1, __ATOMIC_RELAXED, __HIP_MEMORY_SCOPE_WORKGROUP); }
    __syncthreads();
    if (F.tid < 32) lbase[F.tid] = lh[F.tid] ? (int)atomicAdd((unsigned*)(F.ctl + CW_CUR + 64 * L + F.tid), (unsigned)lh[F.tid]) : 0;
    __syncthreads();
    if (valid) { const int slot = pst[e] + lbase[e] + rank; SLOT[tok * 2 + (i & 1)] = slot; ROWOF[slot] = tok_row(tok); }
    for (int j = blockIdx.x; j < 32; j += F.G) { const int npad = (((cnt[j] + 255) >> 8) << 8) - cnt[j];
        for (int q = F.tid; q < npad; q += NTHR) ROWOF[pst[j] + cnt[j] + q] = 32832; }
}

template <int L> DI void phase_t2(Frame& F) {
    LAS float* wl = (LAS float*)F.lds;
#ifndef T2_NOCONV
    if (L == 0) { convert_weights<1>(F); __syncthreads(); }
#endif
    if (L == 0) { stage_cols<16, 1028>(F.in[17], 3088, 3072, wl, F.tid); __syncthreads(); }
    const float* lg = F.in[L ? 31 : 15]; const float* lb = F.in[L ? 32 : 16];
    const bf16* Y2 = (const bf16*)(F.ws + WS_XB); bf16* HB = (bf16*)(F.ws + WS_HB); float* METAF = (float*)(F.ws + WS_METAF); float* GLR = (float*)(F.ws + WS_GLR);
    const int* SLOT = (const int*)(F.ws + WS_SLOT); const float* EW = (const float*)(F.ws + WS_EW);
    const int gw = F.vcu * NWAVES + F.wave, NGW = F.G * NWAVES;
    const int ntok = L ? NMAIN : NTOK;
#pragma unroll 1
    for (int tok = gw; tok < ntok; tok += NGW) {
        const int row = tok_row(tok);
        float* hf = tok < NMAIN ? F.out + (size_t)tok * D : METAF + (size_t)(tok - NMAIN) * D;
        const int s0 = SLOT[tok * 2], s1 = SLOT[tok * 2 + 1]; const float w0 = EW[tok * 2], w1 = EW[tok * 2 + 1];
        f32x4 v[4];
#pragma unroll
        for (int j = 0; j < 4; ++j) { const f32x4 hv = *(const f32x4*)(hf + 256 * j + 4 * F.lane);
            const v2u ya = *(const v2u*)(Y2 + (size_t)s0 * D + 256 * j + 4 * F.lane), yb = *(const v2u*)(Y2 + (size_t)s1 * D + 256 * j + 4 * F.lane);
            v[j].x = ALPHA * hv.x + (w0 * bflo(ya.x) + w1 * bflo(yb.x)); v[j].y = ALPHA * hv.y + (w0 * bfhi(ya.x) + w1 * bfhi(yb.x));
            v[j].z = ALPHA * hv.z + (w0 * bflo(ya.y) + w1 * bflo(yb.y)); v[j].w = ALPHA * hv.w + (w0 * bfhi(ya.y) + w1 * bfhi(yb.y)); }
        ln_row(v, lg, lb, F.lane);
#pragma unroll
        for (int j = 0; j < 4; ++j) *(f32x4*)(hf + 256 * j + 4 * F.lane) = v[j];
        if (L == 0) {
            store_row_bf16(HB + (size_t)row * D, v, F.lane);
            const float r = row_dots<16, 1028>(v, wl, F.lane);
            if ((F.lane & 3) == 0) GLR[(size_t)row * 16 + (F.lane >> 2)] = r;
        }
    }
}

DI void unit_decode(int u, int& b, int& c, int& h, int& row0) { h = u & 3; const int bc = u >> 2; b = bc / NCHUNK; c = bc - b * NCHUNK; row0 = c == 0 ? CH0ROW : b * SEQ + (c - 1) * 64; }
DI int prev_last_row(int c, int row0) { return c == 1 ? METAROW + NMETA - 1 : row0 - 1; }
DI int main_unit(int i) { return i + 4 + (i >= 1024 ? 4 : 0); }
DI float fexp(float x) { return __builtin_amdgcn_exp2f(x * 1.44269504089f); }
DI float flogsig(float z) { return fminf(z, 0.f) - __builtin_amdgcn_logf(1.f + fexp(-fabsf(z))) * 0.69314718056f; }
DI float frcp(float x) { return __builtin_amdgcn_rcpf(x); }
DI float wscan_add(float x, int lane) {
#pragma unroll
    for (int off = 1; off < 64; off <<= 1) { const float y = __shfl_up(x, off); if (lane >= off) x += y; }
    return x;
}
DI float wscan_max(float x, int lane) {
#pragma unroll
    for (int off = 1; off < 64; off <<= 1) { const float y = __shfl_up(x, off); if (lane >= off) x = fmaxf(x, y); }
    return x;
}
constexpr int LD_QS = 136, LD_VT = 72;
constexpr int L_QS = 0, L_KS = 17408, L_VT = 34816, L_PS = 71680, L_WG = 80896, L_BG = 113664, L_SC = 116736, L_KT = 0;
static_assert(L_SC + 8192 <= TAB_OFF, "chunk lds map");

DI void mlstm_scalars(Frame& F, int c, int h, int row0, int lane, float& a, float& M, float& mt, float& Mprev) {
    if (c != 0) { const size_t row = row0 + lane; a = ((const float*)(F.ws + WS_A))[row * 4 + h]; M = ((const float*)(F.ws + WS_MX))[row * 4 + h]; mt = ((const float*)(F.ws + WS_MT))[row * 4 + h];
        Mprev = ((const float*)(F.ws + WS_MX))[(size_t)prev_last_row(c, row0) * 4 + h]; }
    else { const float* GATES = (const float*)(F.ws + WS_GATES); const bool real = lane >= 48; const size_t row = row0 + lane;
        const float li = real ? GATES[row * 8 + h] : NEGBIG, lf = real ? logsig(GATES[row * 8 + 4 + h]) : 0.f;
        const float B = wscan_add(lf, lane); a = real ? li - B : NEGBIG; M = fmaxf(wscan_max(a, lane), 0.f); mt = B + M; Mprev = 0.f; }
}
DI void gla_bc(float (&bc)[16], const f32x4 (&gl)[4], const LAS float* WG, const LAS float* BG, int h, int w, int lane, bool ch0) {
    f32x4 z[4];
#pragma unroll
    for (int q = 0; q < 4; ++q) z[q] = *(const LAS f32x4*)(BG + h * 128 + 16 * w + 4 * q);
#pragma unroll
    for (int r = 0; r < 16; ++r) { const float gv = gl[r >> 2][r & 3];
#pragma unroll
        for (int q = 0; q < 4; ++q) z[q] += gv * *(const LAS f32x4*)(WG + r * 512 + h * 128 + 16 * w + 4 * q);
        if (r & 1) asm volatile("" : "+v"(z[0]), "+v"(z[1]), "+v"(z[2]), "+v"(z[3]) :: "memory"); }
    const bool dead = ch0 && lane < 48;
#pragma unroll
    for (int j = 0; j < 16; ++j) { const float la = dead ? 0.f : flogsig(z[j >> 2][j & 3]) * (1.f / 16.f); bc[j] = wscan_add(la, lane); }
}
template <int MIX> DI void chunk_phase_setup(Frame& F) {
    if (MIX == 1) { LAS float* WG = (LAS float*)(F.lds + L_WG); LAS float* BG = (LAS float*)(F.lds + L_BG); const float* wgu = F.in[18]; const float* bgate = F.in[19];
#pragma unroll 4
        for (int i = F.tid; i < 16 * 512; i += NTHR) WG[i] = wgu[i];
        BG[F.tid] = bgate[F.tid]; }
}

template <int MIX> DI void aprime_unit(Frame& F, int u) {
    LAS bf16* KT = (LAS bf16*)(F.lds + L_KT); LAS bf16* VT = (LAS bf16*)(F.lds + L_VT); const LAS float* WG = (const LAS float*)(F.lds + L_WG); const LAS float* BG = (const LAS float*)(F.lds + L_BG);
    const bf16* Kp = (const bf16*)(F.ws + WS_K); const bf16* Vp = (const bf16*)(F.ws + WS_V); bf16* ST = (bf16*)(F.ws + WS_ST);
    float* GDEC = (float*)(F.ws + WS_GDEC); float* DN = (float*)(F.ws + WS_DN); const float* GLR = (const float*)(F.ws + WS_GLR);
    const int s = F.lane, w = F.wave, r = s & 15, g = s >> 4;
    int b, c, h, row0; unit_decode(u, b, c, h, row0);
    const v4u* ksrc = (const v4u*)(Kp + (size_t)(row0 + s) * 512 + h * 128 + 16 * w); const v4u kx0 = ksrc[0], kx1 = ksrc[1];
    const v4u* vsrc = (const v4u*)(Vp + (size_t)(row0 + s) * 1024 + h * 256 + 32 * w);
    v4u vx[4];
#pragma unroll
    for (int j = 0; j < 4; ++j) vx[j] = vsrc[j];
    float a = 0.f, M = 0.f, mt = 0.f, Mprev = 0.f; f32x4 gl[4];
    if (MIX == 0) mlstm_scalars(F, c, h, row0, s, a, M, mt, Mprev);
    else {
#pragma unroll
        for (int q = 0; q < 4; ++q) gl[q] = *(const f32x4*)(GLR + (size_t)(row0 + s) * 16 + 4 * q); }
    __syncthreads();
    float kv[16];
    { const unsigned wv[8] = {kx0.x, kx0.y, kx0.z, kx0.w, kx1.x, kx1.y, kx1.z, kx1.w};
#pragma unroll
      for (int q = 0; q < 8; ++q) { kv[2 * q] = bflo(wv[q]); kv[2 * q + 1] = bfhi(wv[q]); } }
    float vscale = 1.f;
    if (MIX == 0) {
        const float Mend = __shfl(M, 63), ws = fexp(a - Mend); vscale = ws;
        float p[16];
#pragma unroll
        for (int j = 0; j < 16; ++j) p[j] = ws * kv[j];
        const float dn = fold_reduce<16>(p, s);
        if ((s & 3) == 0) DN[(size_t)u * 128 + 16 * w + (s >> 2)] = dn;
        if (F.tid < 128) GDEC[(size_t)u * 128 + F.tid] = fexp(Mprev - Mend);
    } else {
        float bc[16]; gla_bc(bc, gl, WG, BG, h, w, s, c == 0);
#pragma unroll
        for (int j = 0; j < 16; ++j) { const float blast = __shfl(bc[j], 63); kv[j] *= fexp(blast - bc[j]); if (s == 63) GDEC[(size_t)u * 128 + 16 * w + j] = fexp(bc[j]); }
    }
#pragma unroll
    for (int j = 0; j < 16; ++j) KT[(16 * w + j) * LD_VT + s] = (bf16)f2bf(kv[j]);
#pragma unroll
    for (int j = 0; j < 4; ++j) { const unsigned wv[4] = {vx[j].x, vx[j].y, vx[j].z, vx[j].w};
#pragma unroll
        for (int q = 0; q < 4; ++q) { const int dv = 32 * w + 8 * j + 2 * q;
            if (MIX == 0) { VT[dv * LD_VT + s] = (bf16)f2bf(bflo(wv[q]) * vscale); VT[(dv + 1) * LD_VT + s] = (bf16)f2bf(bfhi(wv[q]) * vscale); }
            else { VT[dv * LD_VT + s] = (bf16)(wv[q] & 0xffffu); VT[(dv + 1) * LD_VT + s] = (bf16)(wv[q] >> 16); } } }
    __syncthreads();
    f32x4 acc[4][2][2];
#pragma unroll
    for (int p = 0; p < 4; ++p)
#pragma unroll
        for (int e = 0; e < 2; ++e)
#pragma unroll
            for (int nt = 0; nt < 2; ++nt) acc[p][e][nt] = (f32x4){0.f, 0.f, 0.f, 0.f};
#pragma unroll
    for (int ks = 0; ks < 2; ++ks) {
        bf16x8 y[2];
#pragma unroll
        for (int nt = 0; nt < 2; ++nt) y[nt] = *(const LAS bf16x8*)(VT + (32 * w + 16 * nt + r) * LD_VT + 32 * ks + 8 * g);
#pragma unroll
        for (int p = 0; p < 4; ++p)
#pragma unroll
            for (int e = 0; e < 2; ++e) { const bf16x8 x = *(const LAS bf16x8*)(KT + (32 * p + 8 * (r >> 2) + 4 * e + (r & 3)) * LD_VT + 32 * ks + 8 * g);
#pragma unroll
                for (int nt = 0; nt < 2; ++nt) acc[p][e][nt] = mma16(x, y[nt], acc[p][e][nt]); }
    }
    bf16* stu = ST + (size_t)u * 32768;
#pragma unroll
    for (int nt = 0; nt < 2; ++nt) { const int dv = 32 * w + 16 * nt + r;
#pragma unroll
        for (int p = 0; p < 4; ++p) { v4u o; o.x = pk2(acc[p][0][nt].x, acc[p][0][nt].y); o.y = pk2(acc[p][0][nt].z, acc[p][0][nt].w); o.z = pk2(acc[p][1][nt].x, acc[p][1][nt].y); o.w = pk2(acc[p][1][nt].z, acc[p][1][nt].w);
            *(v4u*)(stu + dv * 128 + 32 * p + 8 * g) = o; } }
}
template <int MIX> DI void phase_aprime(Frame& F) {
    chunk_phase_setup<MIX>(F);
    for (int i = blockIdx.x; i < 2048; i += F.G) aprime_unit<MIX>(F, main_unit(i));
}

template <int MIX> DI void phase_scan(Frame& F) {
    unsigned* ST = (unsigned*)(F.ws + WS_ST); const float* GDEC = (const float*)(F.ws + WS_GDEC); float* DN = (float*)(F.ws + WS_DN);
    for (int gid = blockIdx.x * NTHR + F.tid; gid < 8 * 16384; gid += F.G * NTHR) {
        const int bh = gid >> 14, e2 = gid & 16383, b = bh >> 2, h = bh & 3, d = (2 * e2) & 127;
        float s0 = 0.f, s1 = 0.f;
        size_t ub = (size_t)(b * NCHUNK) * 4 + h;
        int c = 0;
#pragma unroll 1
        for (; c + 8 <= NCHUNK; c += 8) {
            unsigned x[8]; float g0[8], g1[8];
#pragma unroll
            for (int j = 0; j < 8; ++j) { const size_t u = ub + (size_t)(c + j) * 4; x[j] = ST[u * 16384 + e2]; const float2 gg = *(const float2*)(GDEC + u * 128 + d); g0[j] = gg.x; g1[j] = gg.y; }
#pragma unroll
            for (int j = 0; j < 8; ++j) { const size_t u = ub + (size_t)(c + j) * 4; ST[u * 16384 + e2] = pk2(s0, s1); s0 = g0[j] * s0 + bflo(x[j]); s1 = g1[j] * s1 + bfhi(x[j]); }
        }
        for (; c < NCHUNK; ++c) { const size_t u = ub + (size_t)c * 4; const unsigned x = ST[u * 16384 + e2]; const float2 gg = *(const float2*)(GDEC + u * 128 + d);
            ST[u * 16384 + e2] = pk2(s0, s1); s0 = gg.x * s0 + bflo(x); s1 = gg.y * s1 + bfhi(x); }
    }
    if (MIX == 0) {
        const int gid = blockIdx.x * NTHR + F.tid;
        if (gid < 1024) { const int bh = gid >> 7, d = gid & 127, b = bh >> 2, h = bh & 3; float s = 0.f;
            for (int c = 0; c < NCHUNK; ++c) { const size_t u = (size_t)(b * NCHUNK + c) * 4 + h; const float x = DN[u * 128 + d], gg = GDEC[u * 128 + d]; DN[u * 128 + d] = s; s = gg * s + x; } }
    }
}

template <int MIX> DI void cprime_unit(Frame& F, int u) {
    LAS bf16* QS = (LAS bf16*)(F.lds + L_QS); LAS bf16* KS = (LAS bf16*)(F.lds + L_KS); LAS bf16* VT = (LAS bf16*)(F.lds + L_VT); LAS bf16* PS = (LAS bf16*)(F.lds + L_PS);
    const LAS float* WG = (const LAS float*)(F.lds + L_WG); const LAS float* BG = (const LAS float*)(F.lds + L_BG); LAS float* SC = (LAS float*)(F.lds + L_SC);
    LAS float* sa = SC, *sM = SC + 64, *smt = SC + 128, *sf = SC + 192, *red = SC + 256;
    const bf16* Qp = (const bf16*)(F.ws + WS_Q); const bf16* Kp = (const bf16*)(F.ws + WS_K); const bf16* Vp = (const bf16*)(F.ws + WS_V); const bf16* Op = (const bf16*)(F.ws + WS_O); bf16* Mo = (bf16*)(F.ws + WS_HB);
    const bf16* ST = (const bf16*)(F.ws + WS_ST); const float* NH = (const float*)(F.ws + WS_DN); const float* GLR = (const float*)(F.ws + WS_GLR);
    const float* hnw = F.in[MIX ? 20 : 4];
    const int t = F.lane, w = F.wave, r = t & 15, g = t >> 4;
    int b, c, h, row0; unit_decode(u, b, c, h, row0);
    const v4u* qsrc = (const v4u*)(Qp + (size_t)(row0 + t) * 512 + h * 128 + 16 * w); const v4u* ksrc = (const v4u*)(Kp + (size_t)(row0 + t) * 512 + h * 128 + 16 * w);
    v4u q0 = qsrc[0], q1 = qsrc[1], k0 = ksrc[0], k1 = ksrc[1];
    const v4u* vsrc = (const v4u*)(Vp + (size_t)(row0 + t) * 1024 + h * 256 + 32 * w);
    v4u vx[4];
#pragma unroll
    for (int j = 0; j < 4; ++j) vx[j] = vsrc[j];
    const bf16* stu = ST + (size_t)u * 32768;
    bf16x8 sx[4][2];
#pragma unroll
    for (int ks = 0; ks < 4; ++ks)
#pragma unroll
        for (int nt = 0; nt < 2; ++nt) { if (c != 0) sx[ks][nt] = *(const bf16x8*)(stu + (32 * w + 16 * nt + r) * 128 + 32 * ks + 8 * g); else sx[ks][nt] = (bf16x8){0, 0, 0, 0, 0, 0, 0, 0}; }
    v2u gwv[4][2];
#pragma unroll
    for (int mt = 0; mt < 4; ++mt)
#pragma unroll
        for (int nt = 0; nt < 2; ++nt) gwv[mt][nt] = *(const v2u*)(Op + (size_t)(row0 + 16 * mt + r) * 1024 + h * 256 + 32 * w + 16 * nt + 4 * g);
    float a = 0.f, M = 0.f, mtv = 0.f, Mprev = 0.f; f32x4 gl[4]; bf16x8 nx[4];
    if (MIX == 0) {
        mlstm_scalars(F, c, h, row0, t, a, M, mtv, Mprev);
#pragma unroll
        for (int ks = 0; ks < 4; ++ks) { nx[ks] = (bf16x8){0, 0, 0, 0, 0, 0, 0, 0};
            if (r == 0 && c != 0) { const f32x4 n0 = *(const f32x4*)(NH + (size_t)u * 128 + 32 * ks + 8 * g), n1 = *(const f32x4*)(NH + (size_t)u * 128 + 32 * ks + 8 * g + 4);
                v4u pw; pw.x = pk2(n0.x, n0.y); pw.y = pk2(n0.z, n0.w); pw.z = pk2(n1.x, n1.y); pw.w = pk2(n1.z, n1.w); nx[ks] = __builtin_bit_cast(bf16x8, pw); } }
    } else {
#pragma unroll
        for (int q = 0; q < 4; ++q) gl[q] = *(const f32x4*)(GLR + (size_t)(row0 + t) * 16 + 4 * q); }
    __syncthreads();
    if (MIX == 0) { if (w == 0) { sa[t] = a; sM[t] = M; smt[t] = mtv; sf[t] = fexp(Mprev - M); } }
    else {
        float bc[16]; gla_bc(bc, gl, WG, BG, h, w, t, c == 0);
        unsigned qw[8] = {q0.x, q0.y, q0.z, q0.w, q1.x, q1.y, q1.z, q1.w}, kw[8] = {k0.x, k0.y, k0.z, k0.w, k1.x, k1.y, k1.z, k1.w};
#pragma unroll
        for (int j = 0; j < 8; ++j) { const float b0 = bc[2 * j], b1 = bc[2 * j + 1];
            qw[j] = pk2(bflo(qw[j]) * fexp(b0), bfhi(qw[j]) * fexp(b1)); kw[j] = pk2(bflo(kw[j]) * fexp(-b0), bfhi(kw[j]) * fexp(-b1)); }
        q0 = (v4u){qw[0], qw[1], qw[2], qw[3]}; q1 = (v4u){qw[4], qw[5], qw[6], qw[7]}; k0 = (v4u){kw[0], kw[1], kw[2], kw[3]}; k1 = (v4u){kw[4], kw[5], kw[6], kw[7]};
    }
    *(LAS v4u*)(QS + t * LD_QS + 16 * w) = q0; *(LAS v4u*)(QS + t * LD_QS + 16 * w + 8) = q1;
    *(LAS v4u*)(KS + t * LD_QS + 16 * w) = k0; *(LAS v4u*)(KS + t * LD_QS + 16 * w + 8) = k1;
#pragma unroll
    for (int j = 0; j < 4; ++j) { const unsigned wv[4] = {vx[j].x, vx[j].y, vx[j].z, vx[j].w};
#pragma unroll
        for (int q = 0; q < 4; ++q) { const int dv = 32 * w + 8 * j + 2 * q; VT[dv * LD_VT + t] = (bf16)(wv[q] & 0xffffu); VT[(dv + 1) * LD_VT + t] = (bf16)(wv[q] >> 16); } }
    __syncthreads();
    { const int st = w >> 1;
#pragma unroll
      for (int tti = 0; tti < 2; ++tti) { const int tt = 2 * (w & 1) + tti; f32x4 acc = (f32x4){0.f, 0.f, 0.f, 0.f};
          if (st <= tt) {
#pragma unroll
              for (int ks = 0; ks < 4; ++ks) { const bf16x8 x = *(const LAS bf16x8*)(KS + (16 * st + r) * LD_QS + 32 * ks + 8 * g), y = *(const LAS bf16x8*)(QS + (16 * tt + r) * LD_QS + 32 * ks + 8 * g); acc = mma16(x, y, acc); } }
          const int tq = 16 * tt + r, s0 = 16 * st + 4 * g; float p[4];
#pragma unroll
          for (int i = 0; i < 4; ++i) { float v = acc[i]; if (MIX == 0) v *= fexp(sa[s0 + i] - sM[tq]); p[i] = (s0 + i <= tq) ? v : 0.f; }
          v2u o; o.x = pk2(p[0], p[1]); o.y = pk2(p[2], p[3]); *(LAS v2u*)(PS + tq * LD_VT + s0) = o; } }
    __syncthreads();
    f32x4 hnv[2];
#pragma unroll
    for (int nt = 0; nt < 2; ++nt) hnv[nt] = *(const f32x4*)(hnw + h * 256 + 32 * w + 16 * nt + 4 * g);
    f32x4 acc1[2][4], acc2[2][4], accd1[4], accd2[4];
#pragma unroll
    for (int mt = 0; mt < 4; ++mt) { accd1[mt] = (f32x4){0.f, 0.f, 0.f, 0.f}; accd2[mt] = (f32x4){0.f, 0.f, 0.f, 0.f};
#pragma unroll
        for (int nt = 0; nt < 2; ++nt) { acc1[nt][mt] = (f32x4){0.f, 0.f, 0.f, 0.f}; acc2[nt][mt] = (f32x4){0.f, 0.f, 0.f, 0.f}; } }
    const short one = r == 0 ? (short)0x3F80 : (short)0;
    const bf16x8 ones = (bf16x8){one, one, one, one, one, one, one, one};
#pragma unroll
    for (int ks = 0; ks < 4; ++ks) {
        bf16x8 y[4];
#pragma unroll
        for (int mt = 0; mt < 4; ++mt) y[mt] = *(const LAS bf16x8*)(QS + (16 * mt + r) * LD_QS + 32 * ks + 8 * g);
#pragma unroll
        for (int mt = 0; mt < 4; ++mt) {
#pragma unroll
            for (int nt = 0; nt < 2; ++nt) acc2[nt][mt] = mma16(sx[ks][nt], y[mt], acc2[nt][mt]);
            if (MIX == 0) accd2[mt] = mma16(nx[ks], y[mt], accd2[mt]); }
    }
#pragma unroll
    for (int ks = 0; ks < 2; ++ks) {
        bf16x8 x[2], y[4];
#pragma unroll
        for (int nt = 0; nt < 2; ++nt) x[nt] = *(const LAS bf16x8*)(VT + (32 * w + 16 * nt + r) * LD_VT + 32 * ks + 8 * g);
#pragma unroll
        for (int mt = 0; mt < 4; ++mt) y[mt] = *(const LAS bf16x8*)(PS + (16 * mt + r) * LD_VT + 32 * ks + 8 * g);
#pragma unroll
        for (int mt = 0; mt < 4; ++mt) {
#pragma unroll
            for (int nt = 0; nt < 2; ++nt) acc1[nt][mt] = mma16(x[nt], y[mt], acc1[nt][mt]);
            if (MIX == 0) accd1[mt] = mma16(ones, y[mt], accd1[mt]); }
    }
#pragma unroll
    for (int mt = 0; mt < 4; ++mt) { const int tq = 16 * mt + r; float s1 = 0.f, s2 = 0.f, ft = 1.f, rd = 1.f;
        if (MIX == 0) { ft = sf[tq]; const float dl = accd1[mt].x + ft * accd2[mt].x; const float den = __shfl(dl, r); rd = frcp(fmaxf(fabsf(den), fexp(-smt[tq]))); }
#pragma unroll
        for (int nt = 0; nt < 2; ++nt) { f32x4 hv = (acc1[nt][mt] + acc2[nt][mt] * ft) * rd; acc1[nt][mt] = hv; s1 += (hv.x + hv.y) + (hv.z + hv.w); s2 += (hv.x * hv.x + hv.y * hv.y) + (hv.z * hv.z + hv.w * hv.w); }
        s1 += __shfl_xor(s1, 16); s1 += __shfl_xor(s1, 32); s2 += __shfl_xor(s2, 16); s2 += __shfl_xor(s2, 32);
        if (g == 0) *(LAS f32x2_t*)(red + (w * 64 + tq) * 2) = (f32x2_t){s1, s2}; }
    __syncthreads();
#pragma unroll
    for (int mt = 0; mt < 4; ++mt) { const int tq = 16 * mt + r; float s1 = 0.f, s2 = 0.f;
#pragma unroll
        for (int ww = 0; ww < 8; ++ww) { const f32x2_t pr = *(const LAS f32x2_t*)(red + (ww * 64 + tq) * 2); s1 += pr.x; s2 += pr.y; }
        float mean = 0.f, rstd;
        if (MIX == 0) { mean = s1 * (1.f / 256.f); rstd = __builtin_amdgcn_rsqf(fmaxf(s2 * (1.f / 256.f) - mean * mean, 0.f) + LN_EPS); }
        else rstd = __builtin_amdgcn_rsqf(s2 * (1.f / 256.f) + LN_EPS);
#pragma unroll
        for (int nt = 0; nt < 2; ++nt) { const int dv = 32 * w + 16 * nt + 4 * g; const size_t oi = (size_t)(row0 + tq) * 1024 + h * 256 + dv;
            const v2u gw = gwv[mt][nt]; const f32x4 hn = hnv[nt]; const f32x4 hv = acc1[nt][mt];
            const float gi[4] = {bflo(gw.x), bfhi(gw.x), bflo(gw.y), bfhi(gw.y)}; float o[4];
#pragma unroll
            for (int i = 0; i < 4; ++i) { const float sg = frcp(1.f + fexp(-gi[i])); o[i] = (hv[i] - mean) * rstd * hn[i] * (MIX == 0 ? sg : gi[i] * sg); }
            v2u ow; ow.x = pk2(o[0], o[1]); ow.y = pk2(o[2], o[3]); *(v2u*)(Mo + oi) = ow; } }
}
template <int MIX> DI void phase_cprime(Frame& F) {
    chunk_phase_setup<MIX>(F);
    for (int i = blockIdx.x; i < 2048; i += F.G) cprime_unit<MIX>(F, main_unit(i));
}
template <int MIX> DI void phase_chunk0(Frame& F) {
    const int bid = blockIdx.x;
    if (bid >= 8 && bid < 20) { chunk_phase_setup<MIX>(F);
        if (bid < 16) { const int k = bid - 8; aprime_unit<MIX>(F, k < 4 ? k : 1028 + (k - 4)); }
        else cprime_unit<MIX>(F, bid - 16); }
}

struct EpiProj {
    static constexpr bool PERM = true, AFTER_DRAIN = false;
    bf16 *Q, *K, *V, *O;
    DI void operator()(const f32x4 (&acc)[2][2][4][2], const pg8::Unit& u, int wr, int wc, int fr, int fq) const {
        bf16* base; int ld, colt; float sc = 1.f; const int pn = u.pn;
        if (pn < 2) { base = Q; ld = 512; colt = pn * 256; sc = QSCALE; } else if (pn < 4) { base = K; ld = 512; colt = (pn - 2) * 256; }
        else if (pn < 8) { base = V; ld = 1024; colt = (pn - 4) * 256; } else { base = O; ld = 1024; colt = (pn - 8) * 256; }
        const int row0 = u.pm * 256 + wr * 64 + fr, col0 = colt + wc * 32 + 8 * fq;
#pragma unroll
        for (int ai = 0; ai < 2; ++ai)
#pragma unroll
            for (int m = 0; m < 4; ++m) { bf16* rowp = base + (size_t)(row0 + ai * 128 + m * 16) * ld + col0;
#pragma unroll
                for (int bj = 0; bj < 2; ++bj) { const f32x4 v0 = acc[ai][bj][m][0] * sc, v1 = acc[ai][bj][m][1] * sc;
                    v4u w; w.x = pk2(v0[0], v0[1]); w.y = pk2(v0[2], v0[3]); w.z = pk2(v1[0], v1[1]); w.w = pk2(v1[2], v1[3]);
                    *(v4u*)(rowp + bj * 128) = w; } }
    }
};
struct EpiPlain {
    static constexpr bool PERM = true, AFTER_DRAIN = false;
    bf16* O;
    DI void operator()(const f32x4 (&acc)[2][2][4][2], const pg8::Unit& u, int wr, int wc, int fr, int fq) const {
        const int row0 = u.pm * 256 + wr * 64 + fr, col0 = (u.pn & 3) * 256 + wc * 32 + 8 * fq;
#pragma unroll
        for (int ai = 0; ai < 2; ++ai)
#pragma unroll
            for (int m = 0; m < 4; ++m) { bf16* rowp = O + (size_t)(row0 + ai * 128 + m * 16) * 1024 + col0;
#pragma unroll
                for (int bj = 0; bj < 2; ++bj) { const f32x4 v0 = acc[ai][bj][m][0], v1 = acc[ai][bj][m][1];
                    v4u w; w.x = pk2(v0[0], v0[1]); w.y = pk2(v0[2], v0[3]); w.z = pk2(v1[0], v1[1]); w.w = pk2(v1[2], v1[3]);
                    *(v4u*)(rowp + bj * 128) = w; } }
    }
};
struct EpiGU {
    static constexpr bool PERM = true, AFTER_DRAIN = false;
    bf16* Hd;
    DI void operator()(const f32x4 (&acc)[2][2][4][2], const pg8::Unit& u, int wr, int wc, int fr, int fq) const {
        const int row0 = u.pm * 256 + wr * 64 + fr, col0 = (u.pn & 3) * 128 + wc * 32 + 8 * fq;
#pragma unroll
        for (int ai = 0; ai < 2; ++ai)
#pragma unroll
            for (int m = 0; m < 4; ++m) { float o[8];
#pragma unroll
                for (int n = 0; n < 2; ++n)
#pragma unroll
                    for (int i = 0; i < 4; ++i) { const float gte = acc[ai][0][m][n][i], up = acc[ai][1][m][n][i]; o[4 * n + i] = gte * __builtin_amdgcn_rcpf(1.f + __expf(-gte)) * up; }
                v4u w; w.x = pk2(o[0], o[1]); w.y = pk2(o[2], o[3]); w.z = pk2(o[4], o[5]); w.w = pk2(o[6], o[7]);
                *(v4u*)(Hd + (size_t)(row0 + ai * 128 + m * 16) * 512 + col0) = w; }
    }
};
template <bool GA> struct MoeOrder {
    static constexpr bool GATHER = GA;
    const LAS int* tile_e; const LAS int* rowtab; int nunits, G, c;
    DI bool next(int i, pg8::Unit& u) const { const int L = i * G + c; if (L >= nunits) return false; const int t = L >> 2; const int e = __builtin_amdgcn_readfirstlane(tile_e[t]); u.pm = t; u.pn = e * 4 + (L & 3); return true; }
    DI unsigned rowoff(int i, int rin) const { return (unsigned)rowtab[i * 256 + rin] * 2048u; }
    DI void a_ready(const pg8::Unit&) const {}
    DI void done(const pg8::Unit&) const {}
};
template <bool GA> DI int moe_order_setup(Frame& F, int L) {
    LAS int* pst = (LAS int*)(F.lds + TAB_OFF); LAS int* cnt = pst + 40; LAS int* tile_e = pst + 128; LAS int* rowtab = pst + 512;
    moe_tables(F, L, pst, cnt);
    const int ntiles = pst[32] >> 8;
    for (int t = F.tid; t < ntiles; t += NTHR) { int e = 0;
        for (int q = 1; q < 32; ++q) if (pst[q] <= t * 256) e = q;
        tile_e[t] = e; }
    if (GA) { const int* ROWOF = (const int*)(F.ws + WS_ROWOF);
        for (int i = 0; i < 8; ++i) { const int Lu = i * F.G + F.vcu; if (Lu >= ntiles * 4) break; if (F.tid < 256) rowtab[i * 256 + F.tid] = ROWOF[(Lu >> 2) * 256 + F.tid]; } }
    __syncthreads();
    return ntiles;
}
DI f32x4 small_tile16(const bf16* A16  , const bf16* Bt  , int n0, int lane) {
    const int r = lane & 15, g = lane >> 4;
    const bf16* xp = Bt + (size_t)(n0 + r) * 1024 + 8 * g; const bf16* yp = A16 + (size_t)r * 1024 + 8 * g;
    f32x4 acc = (f32x4){0.f, 0.f, 0.f, 0.f};
#pragma unroll 1
    for (int kb = 0; kb < 4; ++kb) {
        bf16x8 x[8], y[8];
#pragma unroll
        for (int j = 0; j < 8; ++j) { x[j] = *(const bf16x8*)(xp + (kb * 8 + j) * 32); y[j] = *(const bf16x8*)(yp + (kb * 8 + j) * 32); }
#pragma unroll
        for (int j = 0; j < 8; ++j) acc = mma16(x[j], y[j], acc);
    }
    return acc;
}
DI void small_g1(Frame& F) {
    const int gw = blockIdx.x * NWAVES + F.wave; if (gw >= NPROJ / 16) return;
    const int n0 = 16 * gw, r = F.lane & 15, g = F.lane >> 4;
    const f32x4 acc = small_tile16((const bf16*)(F.ws + WS_HB) + (size_t)METAROW * D, (const bf16*)(F.ws + WS_WIN), n0, F.lane);
    bf16* base; int ld, col; float sc = 1.f;
    if (n0 < 512) { base = (bf16*)(F.ws + WS_Q); ld = 512; col = n0; sc = QSCALE; } else if (n0 < 1024) { base = (bf16*)(F.ws + WS_K); ld = 512; col = n0 - 512; }
    else if (n0 < 2048) { base = (bf16*)(F.ws + WS_V); ld = 1024; col = n0 - 1024; } else { base = (bf16*)(F.ws + WS_O); ld = 1024; col = n0 - 2048; }
    v2u o; o.x = pk2(acc.x * sc, acc.y * sc); o.y = pk2(acc.z * sc, acc.w * sc);
    *(v2u*)(base + (size_t)(METAROW + r) * ld + col + 4 * g) = o;
    if (F.lane < 48) { v4u* z = (v4u*)(base + (size_t)(CH0ROW + F.lane) * ld + col); z[0] = (v4u){0u, 0u, 0u, 0u}; z[1] = (v4u){0u, 0u, 0u, 0u}; }
}
DI void small_g2(Frame& F) {
    const int gw = blockIdx.x * NWAVES + F.wave; if (gw >= D / 16) return;
    const int n0 = 16 * gw, r = F.lane & 15, g = F.lane >> 4;
    const f32x4 acc = small_tile16((const bf16*)(F.ws + WS_HB) + (size_t)METAROW * D, (const bf16*)(F.ws + WS_WOUT), n0, F.lane);
    v2u o; o.x = pk2(acc.x, acc.y); o.y = pk2(acc.z, acc.w);
    *(v2u*)((bf16*)(F.ws + WS_YB) + (size_t)(METAROW + r) * D + n0 + 4 * g) = o;
}
DI void gemm_g1(Frame& F) { small_g1(F); pg8::Gemm gm{(const bf16*)(F.ws + WS_HB), (const bf16*)(F.ws + WS_WIN), NMAIN, NPROJ, D}; pg8::StaticOrder S; S.init(NMAIN, NPROJ, F.G, (int)blockIdx.x);
    EpiProj E{(bf16*)(F.ws + WS_Q), (bf16*)(F.ws + WS_K), (bf16*)(F.ws + WS_V), (bf16*)(F.ws + WS_O)};
    pg8::gemm_phase<EpiProj, pg8::StaticOrder, true, true>(F.lds, gm, S, E); }
DI void gemm_g2(Frame& F) { small_g2(F); pg8::Gemm gm{(const bf16*)(F.ws + WS_HB), (const bf16*)(F.ws + WS_WOUT), NMAIN, D, D}; pg8::StaticOrder S; S.init(NMAIN, D, F.G, (int)blockIdx.x);
    EpiPlain E{(bf16*)(F.ws + WS_YB)};
    pg8::gemm_phase<EpiPlain, pg8::StaticOrder, true, true>(F.lds, gm, S, E); }
DI void gemm_g3(Frame& F, int L) { const int ntiles = moe_order_setup<true>(F, L);
    pg8::Gemm gm{(const bf16*)(F.ws + WS_HB), (const bf16*)(F.ws + WS_WGU), 0, 0, D}; MoeOrder<true> S{(const LAS int*)(F.lds + TAB_OFF) + 128, (const LAS int*)(F.lds + TAB_OFF) + 512, ntiles * 4, F.G, F.vcu};
    EpiGU E{(bf16*)(F.ws + WS_HDN)};
    pg8::gemm_phase<EpiGU, MoeOrder<true>, true, true>(F.lds, gm, S, E); }
DI void gemm_g4(Frame& F, int L) { const int ntiles = moe_order_setup<false>(F, L);
    pg8::Gemm gm{(const bf16*)(F.ws + WS_HDN), (const bf16*)(F.ws + WS_WD), 0, 0, FF}; MoeOrder<false> S{(const LAS int*)(F.lds + TAB_OFF) + 128, (const LAS int*)(F.lds + TAB_OFF) + 512, ntiles * 4, F.G, F.vcu};
    EpiPlain E{(bf16*)(F.ws + WS_XB)};
    pg8::gemm_phase<EpiPlain, MoeOrder<false>, true, true>(F.lds, gm, S, E); }

constexpr int NPHASE = 23;
#ifndef PH_MASK
#define PH_MASK 0xFFFu
#endif
#define EN(i) (((PH_MASK) >> (i)) & 1u)
#ifndef PH_REP
#define PH_REP 0u
#endif
#define REPS(i) ((((PH_REP) >> (i)) & 1u) ? 2 : 1)
template <int L> DI void layer_phases(Frame& F, const XcdBarrier& bar, int lo, int hi) {
    constexpr int P = 1 + 11 * L;
#define IN(k) (lo <= (k) && (k) < hi)
#define SEAM(k) do { if (IN(k) && IN((k) + 1)) xcd_barrier(bar); } while (0)
    if (EN(0) && IN(P + 0)) { gemm_g1(F); if (REPS(0) == 2) gemm_g1(F); }
    SEAM(P + 0);
    if (EN(1) && IN(P + 1)) { if (L == 0) { phase_s1(F); if (REPS(1) == 2) { __syncthreads(); phase_s1(F); } } phase_chunk0<L>(F); }
    SEAM(P + 1);
    if (EN(2) && IN(P + 2)) { phase_aprime<L>(F); if (REPS(2) == 2) phase_aprime<L>(F); }
    SEAM(P + 2);
    if (EN(3) && IN(P + 3)) phase_scan<L>(F);
    SEAM(P + 3);
    if (EN(4) && IN(P + 4)) { phase_cprime<L>(F); if (REPS(4) == 2) phase_cprime<L>(F); }
    SEAM(P + 4);
    if (EN(5) && IN(P + 5)) { gemm_g2(F); if (REPS(5) == 2) gemm_g2(F); }
    SEAM(P + 5);
    if (EN(6) && IN(P + 6)) phase_t1<L>(F);
    SEAM(P + 6);
    if (EN(7) && IN(P + 7)) phase_d1<L>(F);
    SEAM(P + 7);
    if (EN(8) && IN(P + 8)) { gemm_g3(F, L); if (REPS(8) == 2) gemm_g3(F, L); }
    SEAM(P + 8);
    if (EN(9) && IN(P + 9)) { gemm_g4(F, L); if (REPS(9) == 2) gemm_g4(F, L); }
    SEAM(P + 9);
    if (EN(10) && IN(P + 10)) phase_t2<L>(F);
    if (L == 0) SEAM(P + 10);
#undef IN
#undef SEAM
}

__global__ void __launch_bounds__(NTHR, 2) hybrid_fwd(Args args) {
    extern __shared__ __attribute__((aligned(16))) unsigned char lds[];
    Frame F;
    F.lds = (LAS unsigned char*)lds;
    F.tid = threadIdx.x; F.lane = F.tid & 63; F.wave = __builtin_amdgcn_readfirstlane(F.tid >> 6);
    F.G = gridDim.x; { const int bx = blockIdx.x; F.vcu = (F.G % 8 == 0) ? (bx % 8) * (F.G / 8) + bx / 8 : bx; }
    F.in = args.in; F.out = args.out; F.ws = args.ws;
    F.ctl = (gu32*)(args.ws + WS_CTL);
    volatile LAS unsigned* MISC = (volatile LAS unsigned*)(F.lds + TOP_OFF);
    if (F.tid < 64) MISC[F.tid] = 0u;
    __syncthreads();
    const int lo = args.ph_lo, hi = args.ph_hi;
    XcdBarrier bar; bar.bar = (unsigned*)(F.ctl + CW_BAR); bar.x = 0; bar.st = nullptr;
    if (hi - lo > 1) bar = xcd_barrier_post((unsigned*)(F.ctl + CW_BAR), MISC + 8);
    if (lo <= 0 && 0 < hi) { if (EN(11)) { phase_p0(F); if (REPS(11) == 2) { __syncthreads(); phase_p0(F); } } if (hi > 1) xcd_barrier(bar); }
    layer_phases<0>(F, bar, lo, hi);
    layer_phases<1>(F, bar, lo, hi);
}

#ifndef MK_PER_PHASE
#define MK_PER_PHASE 0
#endif
extern "C" void kernel_launch(void* const* d_in, const int* in_sizes, int n_in, void* d_out, int out_size, void* d_ws, size_t ws_size, hipStream_t stream) {
    static int grid = 0;
    if (grid == 0) {
        if (n_in != 33 || in_sizes[0] != NMAIN * D || out_size != NMAIN * D || ws_size < WS_END) { fprintf(stderr, "kernel_launch: unexpected shapes (n_in %d, in0 %d, out %d, ws %zu)\n", n_in, n_in > 0 ? in_sizes[0] : -1, out_size, ws_size); grid = -1; return; }
        if (hipFuncSetAttribute((const void*)hybrid_fwd, hipFuncAttributeMaxDynamicSharedMemorySize, LDS_BYTES) != hipSuccess) { fprintf(stderr, "kernel_launch: hipFuncSetAttribute failed\n"); grid = -1; return; }
        int dev = 0, cus = 0, per_cu = 0;
        (void)hipGetDevice(&dev); (void)hipDeviceGetAttribute(&cus, hipDeviceAttributeMultiprocessorCount, dev);
        if (hipOccupancyMaxActiveBlocksPerMultiprocessor(&per_cu, (const void*)hybrid_fwd, NTHR, LDS_BYTES) != hipSuccess || per_cu < 1) fprintf(stderr, "kernel_launch: occupancy query reports %d blocks per CU\n", per_cu);
        (void)hipGetLastError();
        grid = 256;
        if (cus < 256) { fprintf(stderr, "kernel_launch: device has %d CUs, need 256\n", cus); grid = -1; return; }
    }
    if (grid < 0) return;
    (void)hipMemsetAsync((char*)d_ws + WS_CTL, 0, CTL_ZERO_BYTES, stream);
    Args a{};
    for (int i = 0; i < 33; ++i) a.in[i] = (const float*)d_in[i];
    a.out = (float*)d_out; a.ws = (unsigned char*)d_ws;
#if MK_PER_PHASE
    for (int p = 0; p < NPHASE; ++p) { a.ph_lo = p; a.ph_hi = p + 1; hipLaunchKernelGGL(hybrid_fwd, dim3(grid), dim3(NTHR), LDS_BYTES, stream, a); }
#else
    a.ph_lo = 0; a.ph_hi = NPHASE;
    hipLaunchKernelGGL(hybrid_fwd, dim3(grid), dim3(NTHR), LDS_BYTES, stream, a);
#endif
}
```

```cpp
#include <hip/hip_runtime.h>
#include <cstdio>
#include <cstdint>
namespace pg8 {
#define PG8_LAS __attribute__((address_space(3)))
typedef unsigned short bf16_t;
typedef short bf16x8 __attribute__((ext_vector_type(8)));
typedef float f32x4 __attribute__((ext_vector_type(4)));
typedef unsigned u32x4 __attribute__((ext_vector_type(4)));
constexpr int BM = 256, BK = 64, HALF = 128, HTB = HALF * BK * 2  , STAGE_BYTES = 8 * HTB, NXCD = 8, WGM = 8;

__host__ __device__ __forceinline__ int lds_byte(int r, int c) { const int st = (r >> 4) * 2 + (c >> 5), rr = r & 15, cc = c & 31, ob = rr * 64 + cc * 2; return st * 1024 + (ob ^ (((ob >> 9) & 1) << 5)); }
__host__ __device__ __forceinline__ void stage_rc(int b, int& R, int& C) { const int st = b / 1024, sb = b % 1024, swz = sb ^ (((sb >> 9) & 1) << 5); R = (st >> 1) * 16 + swz / 64; C = (st & 1) * 32 + (swz % 64) / 2; }
__host__ __device__ __forceinline__ int perm32(int rho) { const int n = rho >> 4, i = rho & 15; return 8 * (i >> 2) + 4 * n + (i & 3); }

struct Unit { int pm, pn; };
struct Gemm { const bf16_t* A; const bf16_t* Bt; int M, N, K; };

struct StaticOrder {
    static constexpr bool GATHER = false;
    int nM, nN, nwg, G, c;
    __host__ __device__ void init(int M, int N, int G_, int c_) { nM = M / BM; nN = N / BM; nwg = nM * nN; G = G_; c = c_; }
    __host__ __device__ bool next(int i, Unit& u) const {
        const long L = (long)i * G + c; if (L >= nwg) return false;
        int wgid = (int)L; { const int q = nwg / NXCD, r = nwg % NXCD, xcd = wgid % NXCD, off = wgid / NXCD; wgid = (xcd < r ? xcd * (q + 1) : r * (q + 1) + (xcd - r) * q) + off; }
        const int nig = WGM * nN, gid = wgid / nig, fm = gid * WGM, gsz = (nM - fm) < WGM ? (nM - fm) : WGM;
        u.pm = fm + ((wgid % nig) % gsz); u.pn = (wgid % nig) / gsz; return true;
    }
    __device__ __forceinline__ void a_ready(const Unit&) const {}
    __device__ __forceinline__ void done(const Unit&) const {}
};

__device__ __forceinline__ unsigned cvt_pk_bf16(float lo, float hi) { unsigned r; asm volatile("v_cvt_pk_bf16_f32 %0, %1, %2" : "=v"(r) : "v"(lo), "v"(hi)); return r; }
template <class Epi, class Sched, bool ALIGN_EPI = false, bool SP2 = false>
__device__ __forceinline__ void gemm_phase(PG8_LAS unsigned char* lds, const Gemm g, const Sched& S, const Epi& E) {
    const int tid = threadIdx.x, wid = __builtin_amdgcn_readfirstlane(tid >> 6), lane = tid & 63, wr = wid >> 2, wc = wid & 3, fr = lane & 15, fq = lane >> 4;
    const int K = g.K, nt = K / BK;
    unsigned voffA[2], voffB[2];
#pragma unroll
    for (int i = 0; i < 2; ++i) { int R, C; stage_rc(tid * 16 + i * 8192, R, C); const int Rb = Epi::PERM ? ((R & ~31) + perm32(R & 31)) : R;
        voffA[i] = (unsigned)(R * K + C) * 2u; voffB[i] = (unsigned)(Rb * K + C) * 2u; }
    unsigned gc[2][2] = {{0u, 0u}, {0u, 0u}}, gn[2][2] = {{0u, 0u}, {0u, 0u}}; int gR[2] = {0, 0}; unsigned gC[2] = {0u, 0u};
    if constexpr (Sched::GATHER) { static_assert(SP2, "GATHER is written for the SP2 loop only");
#pragma unroll
        for (int i = 0; i < 2; ++i) { int R, C; stage_rc(tid * 16 + i * 8192, R, C); gR[i] = R; gC[i] = (unsigned)C * 2u; } }
    const char* gA0 = (const char*)g.A;
    const size_t kstep = (size_t)(BK * 2);
    const size_t hstep = (size_t)HALF * K * 2;
    const size_t tstep = 2 * hstep;
    const unsigned ldsw = (unsigned)wid * 1024u;
    const int aoff = lds_byte(wr * 64 + fr, fq * 8), boff = lds_byte(wc * 32 + fr, fq * 8);
#define PG8_SA(b, h) (((b) * 2 + (h)) * HTB)
#define PG8_SB(b, h) ((4 + (b) * 2 + (h)) * HTB)
#define PG8_STAGE(bufoff, gbase, voff) do { _Pragma("unroll") for (int _i = 0; _i < 2; ++_i) \
        __builtin_amdgcn_global_load_lds((const unsigned*)((const char*)(gbase) + (voff)[_i]), (PG8_LAS unsigned*)(lds + (bufoff) + ldsw + _i * 8192), 16, 0, 0); } while (0)
#define PG8_LDA(dst, b, h) do { _Pragma("unroll") for (int m = 0; m < 4; ++m) _Pragma("unroll") for (int k = 0; k < 2; ++k) dst[m][k] = *(const PG8_LAS bf16x8*)(lds + PG8_SA(b, h) + aoff + m * 2048 + k * 1024); } while (0)
#define PG8_LDB(dst, b, h) do { _Pragma("unroll") for (int n = 0; n < 2; ++n) _Pragma("unroll") for (int k = 0; k < 2; ++k) dst[n][k] = *(const PG8_LAS bf16x8*)(lds + PG8_SB(b, h) + boff + n * 2048 + k * 1024); } while (0)
#define PG8_MMA(ai, bj, At, Bt) do { __builtin_amdgcn_s_setprio(1); _Pragma("unroll") for (int m = 0; m < 4; ++m) _Pragma("unroll") for (int n = 0; n < 2; ++n) _Pragma("unroll") for (int k = 0; k < 2; ++k) \
        acc[ai][bj][m][n] = __builtin_amdgcn_mfma_f32_16x16x32_bf16(Bt[n][k], At[m][k], acc[ai][bj][m][n], 0, 0, 0); __builtin_amdgcn_s_setprio(0); } while (0)
#define PG8_WAIT_V(n) asm volatile("s_waitcnt vmcnt(" #n ")" ::: "memory")
#define PG8_WAIT_L(n) asm volatile("s_waitcnt lgkmcnt(" #n ")" ::: "memory")
#define PG8_BAR __builtin_amdgcn_s_barrier()
#define PG8_SCHED __builtin_amdgcn_sched_barrier(0)
    Unit cur, nxt; int ui = 0;
    if (!S.next(0, cur)) return;
    f32x4 acc[2][2][4][2];
#pragma unroll
    for (int a = 0; a < 2; ++a)
#pragma unroll
        for (int b = 0; b < 2; ++b)
#pragma unroll
            for (int m = 0; m < 4; ++m)
#pragma unroll
                for (int n = 0; n < 2; ++n) acc[a][b][m][n] = (f32x4){0.f, 0.f, 0.f, 0.f};
    bf16x8 At[4][2], B0[2][2], B1[2][2];
    const char* cA = (const char*)g.A + (size_t)cur.pm * tstep; const char* cB = (const char*)g.Bt + (size_t)cur.pn * tstep;
    S.a_ready(cur);
    if constexpr (Sched::GATHER) {
#pragma unroll
        for (int h = 0; h < 2; ++h)
#pragma unroll
            for (int i = 0; i < 2; ++i) gc[h][i] = S.rowoff(0, h * HALF + gR[i]) + gC[i]; }
    if constexpr (SP2) {
        PG8_STAGE(PG8_SB(0, 0), cB, voffB); PG8_STAGE(PG8_SB(0, 1), cB + hstep, voffB);
        if constexpr (Sched::GATHER) { PG8_STAGE(PG8_SA(0, 0), gA0, gc[0]); PG8_STAGE(PG8_SA(0, 1), gA0, gc[1]); } else { PG8_STAGE(PG8_SA(0, 0), cA, voffA); PG8_STAGE(PG8_SA(0, 1), cA + hstep, voffA); }
        if (wr == 1) PG8_BAR;
        PG8_WAIT_V(2); PG8_BAR;
        PG8_STAGE(PG8_SB(1, 0), cB + kstep, voffB); if constexpr (Sched::GATHER) { PG8_STAGE(PG8_SA(1, 0), gA0 + kstep, gc[0]); } else { PG8_STAGE(PG8_SA(1, 0), cA + kstep, voffA); } PG8_STAGE(PG8_SB(1, 1), cB + hstep + kstep, voffB);
        PG8_WAIT_V(6); PG8_BAR;
    } else {
        PG8_STAGE(PG8_SB(0, 0), cB, voffB); PG8_STAGE(PG8_SA(0, 0), cA, voffA); PG8_STAGE(PG8_SB(0, 1), cB + hstep, voffB); PG8_STAGE(PG8_SA(0, 1), cA + hstep, voffA);
        if (wr == 1) PG8_BAR;
        PG8_WAIT_V(4); PG8_BAR;
        PG8_STAGE(PG8_SB(1, 0), cB + kstep, voffB); PG8_STAGE(PG8_SA(1, 0), cA + kstep, voffA); PG8_STAGE(PG8_SB(1, 1), cB + hstep + kstep, voffB);
        PG8_WAIT_V(6); PG8_BAR;
    }
    for (;;) {
        const bool has_next = S.next(ui + 1, nxt);
        const char* nA = has_next ? (const char*)g.A + (size_t)nxt.pm * tstep : cA; const char* nB = has_next ? (const char*)g.Bt + (size_t)nxt.pn * tstep : cB;
        if constexpr (Sched::GATHER) {
#pragma unroll
            for (int h = 0; h < 2; ++h)
#pragma unroll
                for (int i = 0; i < 2; ++i) gn[h][i] = has_next ? S.rowoff(ui + 1, h * HALF + gR[i]) + gC[i] : gc[h][i]; }
        for (int t = 0; t < nt; t += 2) {
            const bool last = (t == nt - 2);
            const char* a1 = cA + (size_t)(t + 1) * kstep;
            const char* a2 = last ? nA : cA + (size_t)(t + 2) * kstep; const char* b2 = last ? nB : cB + (size_t)(t + 2) * kstep;
            const char* a3 = a2 + kstep; const char* b3 = b2 + kstep;
            if (last && has_next) S.a_ready(nxt);
            if constexpr (SP2) {
            const size_t gk2 = last ? (size_t)0 : (size_t)(t + 2) * kstep;
            unsigned g2[2][2];
            if constexpr (Sched::GATHER) {
#pragma unroll
                for (int h = 0; h < 2; ++h)
#pragma unroll
                    for (int i = 0; i < 2; ++i) g2[h][i] = last ? gn[h][i] : gc[h][i]; }
            PG8_LDB(B0, 0, 0); PG8_LDB(B1, 0, 1); PG8_SCHED; PG8_LDA(At, 0, 0); if constexpr (Sched::GATHER) { PG8_STAGE(PG8_SA(1, 1), gA0 + (size_t)(t + 1) * kstep, gc[1]); } else { PG8_STAGE(PG8_SA(1, 1), a1 + hstep, voffA); }
            PG8_WAIT_V(8); PG8_WAIT_L(0); PG8_BAR; PG8_MMA(0, 0, At, B0); PG8_MMA(0, 1, At, B1); PG8_BAR; PG8_SCHED;
            PG8_LDA(At, 0, 1); PG8_STAGE(PG8_SB(0, 0), b2, voffB); PG8_STAGE(PG8_SB(0, 1), b2 + hstep, voffB); if constexpr (Sched::GATHER) { PG8_STAGE(PG8_SA(0, 0), gA0 + gk2, g2[0]); } else { PG8_STAGE(PG8_SA(0, 0), a2, voffA); }
            PG8_WAIT_V(8); PG8_WAIT_L(0); PG8_BAR; PG8_MMA(1, 0, At, B0); PG8_MMA(1, 1, At, B1); PG8_BAR; PG8_SCHED;
            PG8_LDB(B0, 1, 0); PG8_LDB(B1, 1, 1); PG8_SCHED; PG8_LDA(At, 1, 0); if constexpr (Sched::GATHER) { PG8_STAGE(PG8_SA(0, 1), gA0 + gk2, g2[1]); } else { PG8_STAGE(PG8_SA(0, 1), a2 + hstep, voffA); }
            PG8_WAIT_V(8); PG8_WAIT_L(0); PG8_BAR; PG8_MMA(0, 0, At, B0); PG8_MMA(0, 1, At, B1); PG8_BAR; PG8_SCHED;
            PG8_LDA(At, 1, 1); PG8_STAGE(PG8_SB(1, 0), b3, voffB); PG8_STAGE(PG8_SB(1, 1), b3 + hstep, voffB); if constexpr (Sched::GATHER) { PG8_STAGE(PG8_SA(1, 0), gA0 + gk2 + kstep, g2[0]); } else { PG8_STAGE(PG8_SA(1, 0), a3, voffA); }
            PG8_WAIT_V(8); PG8_WAIT_L(0); PG8_BAR; PG8_MMA(1, 0, At, B0); PG8_MMA(1, 1, At, B1); PG8_BAR; PG8_SCHED;
            } else {
            PG8_LDB(B0, 0, 0); PG8_SCHED; PG8_LDA(At, 0, 0); PG8_STAGE(PG8_SA(1, 1), a1 + hstep, voffA);
            PG8_WAIT_L(8); PG8_BAR; PG8_WAIT_L(0); PG8_MMA(0, 0, At, B0); PG8_BAR; PG8_SCHED;
            PG8_LDB(B1, 0, 1); PG8_STAGE(PG8_SB(0, 0), b2, voffB);
            PG8_BAR; PG8_WAIT_L(0); PG8_MMA(0, 1, At, B1); PG8_BAR;
            PG8_LDA(At, 0, 1); PG8_STAGE(PG8_SA(0, 0), a2, voffA);
            PG8_BAR; PG8_WAIT_L(0); PG8_MMA(1, 0, At, B0); PG8_BAR; PG8_SCHED;
            PG8_STAGE(PG8_SB(0, 1), b2 + hstep, voffB);
            PG8_WAIT_V(6); PG8_BAR; PG8_MMA(1, 1, At, B1); PG8_BAR;
            PG8_LDB(B0, 1, 0); PG8_SCHED; PG8_LDA(At, 1, 0); PG8_STAGE(PG8_SA(0, 1), a2 + hstep, voffA);
            PG8_WAIT_L(8); PG8_BAR; PG8_WAIT_L(0); PG8_MMA(0, 0, At, B0); PG8_BAR; PG8_SCHED;
            PG8_LDB(B1, 1, 1); PG8_STAGE(PG8_SB(1, 0), b3, voffB);
            PG8_BAR; PG8_WAIT_L(0); PG8_MMA(0, 1, At, B1); PG8_BAR;
            PG8_LDA(At, 1, 1); PG8_STAGE(PG8_SA(1, 0), a3, voffA);
            PG8_BAR; PG8_WAIT_L(0); PG8_MMA(1, 0, At, B0); PG8_BAR; PG8_SCHED;
            PG8_STAGE(PG8_SB(1, 1), b3 + hstep, voffB);
            PG8_WAIT_V(6); PG8_BAR; PG8_MMA(1, 1, At, B1); PG8_BAR;
            }
        }
        if constexpr (ALIGN_EPI) { if (wr == 0) PG8_BAR; }
        if constexpr (!Epi::AFTER_DRAIN) { E(acc, cur, wr, wc, fr, fq); S.done(cur); }
        if (!has_next) break;
#pragma unroll
        for (int a = 0; a < 2; ++a)
#pragma unroll
            for (int b = 0; b < 2; ++b)
#pragma unroll
                for (int m = 0; m < 4; ++m)
#pragma unroll
                    for (int n = 0; n < 2; ++n) acc[a][b][m][n] = (f32x4){0.f, 0.f, 0.f, 0.f};
        cur = nxt; cA = nA; cB = nB; ++ui;
        if constexpr (Sched::GATHER) {
#pragma unroll
            for (int h = 0; h < 2; ++h)
#pragma unroll
                for (int i = 0; i < 2; ++i) gc[h][i] = gn[h][i]; }
        if constexpr (ALIGN_EPI) { if (wr == 1) PG8_BAR; }
    }
    PG8_WAIT_V(0);
    if constexpr (!ALIGN_EPI) { if (wr == 0) PG8_BAR; }
    PG8_BAR;
    if constexpr (Epi::AFTER_DRAIN) { E.fused(acc, cur, wr, wc, fr, fq, lds, wid, lane); S.done(cur); }
#undef PG8_SA
#undef PG8_SB
#undef PG8_STAGE
#undef PG8_LDA
#undef PG8_LDB
#undef PG8_MMA
#undef PG8_WAIT_V
#undef PG8_WAIT_L
#undef PG8_BAR
#undef PG8_SCHED
}
}

#define DI __device__ __forceinline__
#define GAS __attribute__((address_space(1)))
#define LAS __attribute__((address_space(3)))
typedef unsigned short bf16;
typedef unsigned v4u __attribute__((ext_vector_type(4)));
typedef unsigned v2u __attribute__((ext_vector_type(2)));
typedef float f32x4 __attribute__((ext_vector_type(4)));
typedef short bf16x8 __attribute__((ext_vector_type(8)));
typedef GAS unsigned gu32;

constexpr int D = 1024, NMAIN = 32768, SEQ = 16384, MR = 33024, CH0ROW = 32768, METAROW = 32816, NMETA = 16, NTOK = NMAIN + NMETA;
constexpr int NCHUNK = 257, NUNIT = 2 * NCHUNK * 4;
constexpr int NPROJ = 3072, NE = 32, FF = 512, PMAXT = 289;
constexpr float ALPHA = 1.41421356237f, LN_EPS = 1e-5f, QSCALE = 0.08838834764831845f, NEGBIG = -1e30f;
constexpr int NWAVES = 8, NTHR = 512;

constexpr size_t MiB = 1u << 20;
constexpr size_t WS_CTL = 0, CTL_ZERO_BYTES = 1 * MiB;
constexpr size_t WS_GATES = 1 * MiB;
constexpr size_t WS_A = WS_GATES + (size_t)MR * 32;
constexpr size_t WS_MX = WS_A + (size_t)MR * 16;
constexpr size_t WS_MT = WS_MX + (size_t)MR * 16;
constexpr size_t WS_GLR = WS_MT + (size_t)MR * 16;
constexpr size_t WS_EID = WS_GLR + (size_t)MR * 64;
constexpr size_t WS_EW = WS_EID + (size_t)NTOK * 8;
constexpr size_t WS_SLOT = WS_EW + (size_t)NTOK * 8;
constexpr size_t WS_GDEC = WS_SLOT + (size_t)NTOK * 8;
constexpr size_t WS_DN = WS_GDEC + (size_t)NUNIT * 512;
constexpr size_t WS_METAF = WS_DN + (size_t)NUNIT * 512;
constexpr size_t WS_ROWOF = WS_METAF + 65536;
static_assert(WS_ROWOF + (size_t)PMAXT * 1024 <= 10 * MiB, "small buffers");
constexpr size_t WS_WIN = 10 * MiB, WS_WOUT = 16 * MiB, WS_WGU = 18 * MiB, WS_WD = 82 * MiB;
constexpr size_t WS_HB = 114 * MiB;
constexpr size_t WS_ARENA = 179 * MiB;
constexpr size_t WS_Q = WS_ARENA, WS_K = WS_Q + (size_t)MR * 1024, WS_V = WS_K + (size_t)MR * 1024, WS_O = WS_V + (size_t)MR * 2048, WS_ST = WS_O + (size_t)MR * 2048;
constexpr size_t WS_YB = WS_Q;
constexpr size_t WS_XB = WS_V;
constexpr size_t WS_HDN = WS_XB + (size_t)PMAXT * 256 * 2048;
constexpr size_t WS_END = WS_ST + (size_t)NUNIT * 65536;
static_assert(WS_HDN + (size_t)PMAXT * 256 * 1024 <= WS_END, "moe overlay");
static_assert(WS_END == 501 * MiB, "ws map");
constexpr int CW_BAR = 4096;
constexpr int CW_CNT = 16384;
constexpr int CW_CUR = 16384 + 256;
constexpr int LDS_BYTES = 155648, TAB_OFF = 131072, TOP_OFF = 154624;

typedef __bf16 bf16x2_t __attribute__((ext_vector_type(2)));
typedef float f32x2_t __attribute__((ext_vector_type(2)));
DI unsigned pk2(float lo, float hi) { const f32x2_t v = {lo, hi}; return __builtin_bit_cast(unsigned, __builtin_convertvector(v, bf16x2_t)); }
DI unsigned f2bf(float f) { return pk2(f, 0.f) & 0xffffu; }
DI float bflo(unsigned w) { return __builtin_bit_cast(float, w << 16); }
DI float bfhi(unsigned w) { return __builtin_bit_cast(float, w & 0xffff0000u); }
DI float bf2f(bf16 b) { return __builtin_bit_cast(float, (unsigned)b << 16); }
#define LDS_WAIT() asm volatile("s_waitcnt lgkmcnt(0)" ::: "memory")
DI float wave_sum(float v) {
#pragma unroll
    for (int o = 1; o < 64; o <<= 1) v += __shfl_xor(v, o);
    return v;
}
template <int N, int OFF> struct FoldStep {
    template <int NP> static DI float run(float (&p)[NP], int lane) {
        constexpr int half = N / 2; const bool hi = (lane & OFF) != 0;
#pragma unroll
        for (int i = 0; i < half; ++i) { const float keep = hi ? p[half + i] : p[i], send = hi ? p[i] : p[half + i]; p[i] = keep + __shfl_xor(send, OFF); }
        return FoldStep<half, OFF / 2>::run(p, lane);
    }
};
template <int OFF> struct FoldStep<1, OFF> {
    template <int NP> static DI float run(float (&p)[NP], int lane) { float r = p[0];
#pragma unroll
        for (int off = OFF; off >= 1; off >>= 1) r += __shfl_xor(r, off);
        return r; }
};
template <int N> DI float fold_reduce(float (&p)[N], int lane) { return FoldStep<N, 32>::run(p, lane); }
DI float logsig(float z) { return fminf(z, 0.f) - log1pf(expf(-fabsf(z))); }
DI f32x4 mma16(bf16x8 x, bf16x8 y, f32x4 c) { return __builtin_amdgcn_mfma_f32_16x16x32_bf16(x, y, c, 0, 0, 0); }
#define XB_TMO      128
#define XB_XCNT(j)  (256  + 64 * (j))
#define XB_XSUB(j)  (1280 + 64 * (j))
#define XB_XGEN(j)  (2304 + 64 * (j))
#define XB_TOP      3328
#define XB_TOPGEN   3392
#define XCD_BAR_WORDS 3456
#define XB_SPIN_CAP (1u << 18)

__device__ __forceinline__ unsigned xb_ld(unsigned* p)              { return __hip_atomic_load(p, __ATOMIC_RELAXED, __HIP_MEMORY_SCOPE_AGENT); }
__device__ __forceinline__ unsigned xb_add(unsigned* p, unsigned v) { return __hip_atomic_fetch_add(p, v, __ATOMIC_RELAXED, __HIP_MEMORY_SCOPE_AGENT); }
__device__ __forceinline__ unsigned xb_xcc_id() { return (unsigned)__builtin_amdgcn_s_getreg((3 << 11) | 20) & 0xFu; }
#define XB_SPIN(cond, bar) do { unsigned _sp = 0; while (cond) { __builtin_amdgcn_s_sleep(1); \
    if ((++_sp & 255u) == 0u) { if (xb_ld(&(bar)[XB_TMO])) break; if (_sp > XB_SPIN_CAP) { atomicAdd(&(bar)[XB_TMO], 1u); break; } } } } while (0)

struct XcdBarrier {
    unsigned* bar; unsigned x;
    volatile LAS unsigned* st;
};

__device__ __forceinline__ XcdBarrier xcd_barrier_post(unsigned* bar, volatile LAS unsigned* st) {
    XcdBarrier b; b.bar = bar; b.x = xb_xcc_id(); b.st = st;
    if (threadIdx.x == 0) (void)xb_add(&bar[XB_XCNT(b.x)], 1u);
    return b;
}
__device__ __forceinline__ void xcd_barrier_complete(unsigned* bar, unsigned x, unsigned& nloc, unsigned& nx) {
    const unsigned G = gridDim.x * gridDim.y * gridDim.z;
    unsigned sum, cnt, mine, sp = 0u;
    for (;;) {
        sum = 0u; cnt = 0u; mine = 0u;
#pragma unroll
        for (unsigned j = 0; j < 16; ++j) { const unsigned c = xb_ld(&bar[XB_XCNT(j)]); sum += c; cnt += (c > 0u) ? 1u : 0u; mine = (j == x) ? c : mine; }
        if (sum == G) break;
        __builtin_amdgcn_s_sleep(1);
        if ((++sp & 255u) == 0u) { if (xb_ld(&bar[XB_TMO])) break; if (sp > XB_SPIN_CAP) { atomicAdd(&bar[XB_TMO], 1u); break; } }
    }
    nloc = mine > 0u ? mine : 1u; nx = cnt > 0u ? cnt : 1u;
}

__device__ __forceinline__ void xcd_barrier(const XcdBarrier& b) {
    asm volatile("s_waitcnt vmcnt(0)" ::: "memory");
    __syncthreads();
    if (threadIdx.x == 0) {
        unsigned* bar = b.bar;
        __builtin_amdgcn_s_waitcnt(0);
        unsigned nloc = b.st[0], nx = b.st[1];
        if (nloc == 0u) { xcd_barrier_complete(bar, b.x, nloc, nx); b.st[0] = nloc; b.st[1] = nx; }
        const unsigned old = xb_add(&bar[XB_XSUB(b.x)], 1u);
        const unsigned gen = old / nloc;
        if (old + 1u == (gen + 1u) * nloc) {
            __builtin_amdgcn_fence(__ATOMIC_RELEASE, "agent");
            asm volatile("s_waitcnt vmcnt(0)" ::: "memory");
            const unsigned og = xb_add(&bar[XB_TOP], 1u);
            const unsigned tg = og / nx;
            if (og + 1u == (tg + 1u) * nx) xb_add(&bar[XB_TOPGEN], 1u);
            else XB_SPIN(xb_ld(&bar[XB_TOPGEN]) == tg, bar);
            __builtin_amdgcn_fence(__ATOMIC_ACQUIRE, "agent");
            xb_add(&bar[XB_XGEN(b.x)], 1u);
            asm volatile("s_waitcnt vmcnt(0)" ::: "memory");
        } else {
            XB_SPIN(xb_ld(&bar[XB_XGEN(b.x)]) == gen, bar);
            __builtin_amdgcn_fence(__ATOMIC_ACQUIRE, "agent");
            asm volatile("s_waitcnt vmcnt(0)" ::: "memory");
        }
    }
    __syncthreads();
}

struct Args { const float* in[33]; float* out; unsigned char* ws; int ph_lo, ph_hi; };
struct Frame {
    LAS unsigned char* lds;
    gu32* ctl;
    int tid, lane, wave, G, vcu;
    const float* const* in;
    float* out; unsigned char* ws;
};
DI int tok_row(int tok) { return tok < NMAIN ? tok : tok + (METAROW - NMAIN); }

DI void transpose_item(const float* W, int ldw, int k0, int n0, bf16* WT, int Kd, int drow0, LAS float* scr, int lane) {
#pragma unroll 8
    for (int i = 0; i < 32; ++i) { const int kk = 2 * i + (lane >> 5); scr[kk * 33 + (lane & 31)] = W[(size_t)(k0 + kk) * ldw + n0 + (lane & 31)]; }
    LDS_WAIT(); asm volatile("" ::: "memory");
    const int c = lane & 7;
#pragma unroll
    for (int j = 0; j < 4; ++j) { const int n = (lane >> 3) + 8 * j; const LAS float* s = scr + (8 * c) * 33 + n;
        v4u o; o.x = pk2(s[0 * 33], s[1 * 33]); o.y = pk2(s[2 * 33], s[3 * 33]); o.z = pk2(s[4 * 33], s[5 * 33]); o.w = pk2(s[6 * 33], s[7 * 33]);
        *(v4u*)(WT + (size_t)(drow0 + n) * Kd + k0 + 8 * c) = o; }
    LDS_WAIT(); asm volatile("" ::: "memory");
}
template <int L> DI void convert_weights(Frame& F) {
    constexpr int IB = L ? 17 : 2;
    const float* w_in = F.in[IB]; const int ld_in = L ? 3088 : 3080;
    const float* w_out = F.in[L ? 21 : 5];
    const float* w_g = F.in[L ? 28 : 12]; const float* w_u = F.in[L ? 29 : 13]; const float* w_d = F.in[L ? 30 : 14];
    bf16* WIN = (bf16*)(F.ws + WS_WIN); bf16* WOUT = (bf16*)(F.ws + WS_WOUT); bf16* WGU = (bf16*)(F.ws + WS_WGU); bf16* WD = (bf16*)(F.ws + WS_WD);
    LAS float* scr = (LAS float*)(F.lds + F.wave * 16384);
    const int gw = F.vcu * NWAVES + F.wave, NGW = F.G * NWAVES;
    constexpr int I_IN = 16 * 96, I_OUT = 16 * 32, I_G = 32 * 256, I_D = 32 * 256, NITEMS = I_IN + I_OUT + 2 * I_G + I_D;
    for (int it = gw; it < NITEMS; it += NGW) {
        int r = it;
        if (r < I_IN) { const int kb = r / 96, nb = r % 96; transpose_item(w_in, ld_in, 64 * kb, 32 * nb, WIN, 1024, 32 * nb, scr, F.lane); continue; } r -= I_IN;
        if (r < I_OUT) { const int kb = r / 32, nb = r % 32; transpose_item(w_out, 1024, 64 * kb, 32 * nb, WOUT, 1024, 32 * nb, scr, F.lane); continue; } r -= I_OUT;
        if (r < 2 * I_G) { const int up = r >= I_G; if (up) r -= I_G; const int e = r >> 8, rr = r & 255, kb = rr >> 4, nb = rr & 15, n0 = 32 * nb;
            transpose_item((up ? w_u : w_g) + (size_t)e * 1024 * 512, 512, 64 * kb, n0, WGU, 1024, e * 1024 + (n0 >> 7) * 256 + up * 128 + (n0 & 127), scr, F.lane); continue; } r -= 2 * I_G;
        { const int e = r >> 8, rr = r & 255, kb = rr >> 5, nb = rr & 31; transpose_item(w_d + (size_t)e * 512 * 1024, 1024, 64 * kb, 32 * nb, WD, 512, e * 1024 + 32 * nb, scr, F.lane); }
    }
}
template <int NC, int STR> DI void stage_cols(const float* W, int ldw, int col0, LAS float* dst, int tid) {
#pragma unroll 4
    for (int idx = tid; idx < NC * 1024; idx += NTHR) { const int e = idx % NC, k = idx / NC; dst[e * STR + k] = W[(size_t)k * ldw + col0 + e]; }
}
DI void ln_row(f32x4 (&v)[4], const float* lg, const float* lb, int lane) {
    float s = 0.f;
#pragma unroll
    for (int j = 0; j < 4; ++j) s += (v[j].x + v[j].y) + (v[j].z + v[j].w);
    const float mean = wave_sum(s) * (1.f / D); float s2 = 0.f;
#pragma unroll
    for (int j = 0; j < 4; ++j) { v[j] = v[j] - mean; s2 += (v[j].x * v[j].x + v[j].y * v[j].y) + (v[j].z * v[j].z + v[j].w * v[j].w); }
    const float rstd = 1.f / sqrtf(wave_sum(s2) * (1.f / D) + LN_EPS);
#pragma unroll
    for (int j = 0; j < 4; ++j) { const f32x4 g = *(const f32x4*)(lg + 256 * j + 4 * lane), b = *(const f32x4*)(lb + 256 * j + 4 * lane); v[j] = v[j] * rstd * g + b; }
}
DI void store_row_bf16(bf16* orow, const f32x4 (&v)[4], int lane) {
    unsigned long long* o8 = (unsigned long long*)orow + lane;
#pragma unroll
    for (int j = 0; j < 4; ++j) o8[64 * j] = (unsigned long long)pk2(v[j].x, v[j].y) | ((unsigned long long)pk2(v[j].z, v[j].w) << 32);
}
template <int NC, int STR> DI float row_dots(const f32x4 (&v)[4], const LAS float* wl, int lane) {
    float p[NC];
#pragma unroll
    for (int e = 0; e < NC; ++e) { float a = 0.f;
#pragma unroll
        for (int j = 0; j < 4; ++j) { const f32x4 w = *(const LAS f32x4*)(wl + e * STR + 256 * j + 4 * lane); a += (v[j].x * w.x + v[j].y * w.y) + (v[j].z * w.z + v[j].w * w.w); }
        p[e] = a; if ((e & 3) == 3) asm volatile("" : "+v"(p[e - 3]), "+v"(p[e - 2]), "+v"(p[e - 1]), "+v"(p[e]) :: "memory"); }
    return fold_reduce<NC>(p, lane);
}

DI void phase_p0(Frame& F) {
    bf16* HB = (bf16*)(F.ws + WS_HB);
    for (int i = blockIdx.x * NTHR + F.tid; i < 240 * 128; i += F.G * NTHR) { const int ri = i >> 7, r = ri < 48 ? CH0ROW + ri : 32832 + (ri - 48);
        *(v4u*)(HB + (size_t)r * D + (i & 127) * 8) = (v4u){0u, 0u, 0u, 0u}; }
    convert_weights<0>(F);
    __syncthreads();
    LAS float* wg = (LAS float*)F.lds;
    stage_cols<8, 1028>(F.in[2], 3080, 3072, wg, F.tid);
    __syncthreads();
    const float* x = F.in[0]; const float* meta = F.in[1]; const float* bg = F.in[3];
    float* GATES = (float*)(F.ws + WS_GATES);
    const int gw = F.vcu * NWAVES + F.wave, NGW = F.G * NWAVES;
#pragma unroll 1
    for (int tok = gw; tok < NTOK; tok += NGW) {
        const float* src = tok < NMAIN ? x + (size_t)tok * D : meta + (size_t)(tok - NMAIN) * D; const int row = tok_row(tok);
        f32x4 v[4];
#pragma unroll
        for (int j = 0; j < 4; ++j) v[j] = *(const f32x4*)(src + 256 * j + 4 * F.lane);
        store_row_bf16(HB + (size_t)row * D, v, F.lane);
        const float r = row_dots<8, 1028>(v, wg, F.lane);
        if ((F.lane & 7) == 0) GATES[(size_t)row * 8 + (F.lane >> 3)] = r + bg[F.lane >> 3];
    }
}

template <bool MAXOP> DI float block_scan_excl(float val, LAS float* sb, int tid) {
    sb[tid] = val; __syncthreads();
#pragma unroll 1
    for (int off = 1; off < NTHR; off <<= 1) { float t = MAXOP ? -3.0e38f : 0.f; if (tid >= off) t = sb[tid - off]; __syncthreads(); sb[tid] = MAXOP ? fmaxf(sb[tid], t) : sb[tid] + t; __syncthreads(); }
    const float r = tid ? sb[tid - 1] : (MAXOP ? -3.0e38f : 0.f); __syncthreads();
    return r;
}
DI void phase_s1(Frame& F) {
    if (blockIdx.x >= 8) return;
    const int b = blockIdx.x >> 2, h = blockIdx.x & 3, tid = F.tid;
    const float* GATES = (const float*)(F.ws + WS_GATES);
    float* A = (float*)(F.ws + WS_A); float* MX = (float*)(F.ws + WS_MX); float* MT = (float*)(F.ws + WS_MT);
    LAS float* sb = (LAS float*)F.lds; LAS float* bc = sb + 512;
    if (tid == 0) { float B = 0.f, M = 0.f;
        for (int j = 0; j < NMETA; ++j) { const int row = METAROW + j; const float li = GATES[row * 8 + h], lf = logsig(GATES[row * 8 + 4 + h]); B += lf; const float a = li - B; M = fmaxf(M, a);
            if (b == 0) { A[row * 4 + h] = a; MX[row * 4 + h] = M; MT[row * 4 + h] = B + M; } }
        bc[0] = B; bc[1] = M; }
    if (b == 0 && tid < 48) { const int row = CH0ROW + tid; A[row * 4 + h] = NEGBIG; MX[row * 4 + h] = 0.f; MT[row * 4 + h] = 0.f; }
    __syncthreads();
    const float Bm = bc[0], Mm = bc[1];
    const int r0 = b * SEQ + 32 * tid;
    float run = 0.f;
#pragma unroll 4
    for (int j = 0; j < 32; ++j) run += logsig(GATES[(size_t)(r0 + j) * 8 + 4 + h]);
    const float off = block_scan_excl<false>(run, sb, tid) + Bm;
    float Bc = off, mx = -3.0e38f;
#pragma unroll 4
    for (int j = 0; j < 32; ++j) { const size_t row = r0 + j; Bc += logsig(GATES[row * 8 + 4 + h]); const float a = GATES[row * 8 + h] - Bc; mx = fmaxf(mx, a); A[row * 4 + h] = a; MT[row * 4 + h] = Bc; }
    const float pre = fmaxf(block_scan_excl<true>(mx, sb, tid), Mm);
    float M = pre;
#pragma unroll 4
    for (int j = 0; j < 32; ++j) { const size_t row = r0 + j; M = fmaxf(M, A[row * 4 + h]); MX[row * 4 + h] = M; MT[row * 4 + h] += M; }
}

template <int NR, int NC, int STR> DI void rows_dots(const f32x4 (&v)[NR][4], const LAS float* wl, int lane, float (&res)[NR]) {
    float p[NR][NC];
#pragma unroll
    for (int e = 0; e < NC; ++e) { f32x4 w[4];
#pragma unroll
        for (int j = 0; j < 4; ++j) w[j] = *(const LAS f32x4*)(wl + e * STR + 256 * j + 4 * lane);
#pragma unroll
        for (int q = 0; q < NR; ++q) { float a = 0.f;
#pragma unroll
            for (int j = 0; j < 4; ++j) a += (v[q][j].x * w[j].x + v[q][j].y * w[j].y) + (v[q][j].z * w[j].z + v[q][j].w * w[j].w);
            p[q][e] = a; }
        if (e & 1) {
#pragma unroll
            for (int q = 0; q < NR; ++q) asm volatile("" : "+v"(p[q][e - 1]), "+v"(p[q][e]) :: "memory"); } }
#pragma unroll
    for (int q = 0; q < NR; ++q) res[q] = fold_reduce<NC>(p[q], lane);
}
template <int L, int NR> DI void t1_rows(Frame& F, int tok0, const LAS float* wr, LAS int* hist, bool do_hist = true) {
    const float* lg = F.in[L ? 22 : 6]; const float* lb = F.in[L ? 23 : 7]; const float* b_grp = F.in[L ? 25 : 9]; const float* b_rt = F.in[L ? 27 : 11];
    const bf16* YB = (const bf16*)(F.ws + WS_YB); bf16* HB = (bf16*)(F.ws + WS_HB);
    int* EID = (int*)(F.ws + WS_EID); float* EW = (float*)(F.ws + WS_EW);
    f32x4 v[NR][4];
#pragma unroll
    for (int q = 0; q < NR; ++q) { const int tok = tok0 + q, row = tok_row(tok);
        if (L == 0) { const float* hp = tok < NMAIN ? F.in[0] + (size_t)tok * D : F.in[1] + (size_t)(tok - NMAIN) * D;
#pragma unroll
            for (int j = 0; j < 4; ++j) v[q][j] = *(const f32x4*)(hp + 256 * j + 4 * F.lane); }
        else {
#pragma unroll
            for (int j = 0; j < 4; ++j) { const v2u hw = *(const v2u*)(HB + (size_t)row * D + 256 * j + 4 * F.lane); v[q][j] = (f32x4){bflo(hw.x), bfhi(hw.x), bflo(hw.y), bfhi(hw.y)}; } }
#pragma unroll
        for (int j = 0; j < 4; ++j) { const v2u yw = *(const v2u*)(YB + (size_t)row * D + 256 * j + 4 * F.lane);
            v[q][j].x = ALPHA * v[q][j].x + bflo(yw.x); v[q][j].y = ALPHA * v[q][j].y + bfhi(yw.x); v[q][j].z = ALPHA * v[q][j].z + bflo(yw.y); v[q][j].w = ALPHA * v[q][j].w + bfhi(yw.y); } }
#pragma unroll
    for (int q = 0; q < NR; ++q) { ln_row(v[q], lg, lb, F.lane); store_row_bf16(HB + (size_t)tok_row(tok0 + q) * D, v[q], F.lane); }
    float rg[NR];
    rows_dots<NR, 4, 1028>(v, wr + 32 * 1028, F.lane, rg);
#pragma unroll
    for (int q = 0; q < NR; ++q) { const int tok = tok0 + q;
        float gl[4];
#pragma unroll
        for (int j = 0; j < 4; ++j) gl[j] = __shfl(rg[q], 16 * j) + b_grp[j];
        int gt = 0; float gm = gl[0];
#pragma unroll
        for (int j = 1; j < 4; ++j) if (gl[j] > gm) { gm = gl[j]; gt = j; }
        float se = 0.f;
#pragma unroll
        for (int j = 0; j < 4; ++j) se += expf(gl[j] - gm);
        const float pg = 1.f / se;
        gt = __builtin_amdgcn_readfirstlane(gt);
        float re[1]; { f32x4 vq[1][4];
#pragma unroll
            for (int j = 0; j < 4; ++j) vq[0][j] = v[q][j];
            rows_dots<1, 8, 1028>(vq, wr + gt * 8 * 1028, F.lane, re); }
        float wv[8];
#pragma unroll
        for (int i = 0; i < 8; ++i) wv[i] = __shfl(re[0], 8 * i) + b_rt[gt * 8 + i];
        int i0 = 0; float v0 = wv[0];
#pragma unroll
        for (int i = 1; i < 8; ++i) if (wv[i] > v0) { v0 = wv[i]; i0 = i; }
        int i1 = -1; float v1 = -3.0e38f;
#pragma unroll
        for (int i = 0; i < 8; ++i) if (i != i0 && wv[i] > v1) { v1 = wv[i]; i1 = i; }
        const float e1 = expf(v1 - v0), w0 = 1.f / (1.f + e1), w1 = e1 * w0;
        if (F.lane == 0 && do_hist) { const int ea = gt * 8 + i0, eb = gt * 8 + i1; EID[tok * 2] = ea; EID[tok * 2 + 1] = eb; EW[tok * 2] = pg * w0; EW[tok * 2 + 1] = pg * w1;
            __hip_atomic_fetch_add(&hist[ea], 1, __ATOMIC_RELAXED, __HIP_MEMORY_SCOPE_WORKGROUP); __hip_atomic_fetch_add(&hist[eb], 1, __ATOMIC_RELAXED, __HIP_MEMORY_SCOPE_WORKGROUP); } }
}
template <int L> DI void phase_t1(Frame& F, bool do_hist = true) {
    LAS float* wr = (LAS float*)F.lds;
    LAS int* hist = (LAS int*)(F.lds + 148032);
    stage_cols<32, 1028>(F.in[L ? 26 : 10], 32, 0, wr, F.tid);
    stage_cols<4, 1028>(F.in[L ? 24 : 8], 4, 0, wr + 32 * 1028, F.tid);
    if (F.tid < 32) hist[F.tid] = 0;
    __syncthreads();
    const int gw = F.vcu * NWAVES + F.wave, NGW = F.G * NWAVES;
#pragma unroll 1
    for (int gi = gw; gi < NMAIN / 4; gi += NGW) t1_rows<L, 4>(F, 4 * gi, wr, hist, do_hist);
    if (gw < NMETA) t1_rows<L, 1>(F, NMAIN + gw, wr, hist, do_hist);
    __syncthreads();
    if (F.tid < 32 && hist[F.tid]) atomicAdd((unsigned*)(F.ctl + CW_CNT + 64 * L + F.tid), (unsigned)hist[F.tid]);
}

DI void moe_tables(Frame& F, int L, LAS int* pst, LAS int* cnt) {
    if (F.tid < 32) cnt[F.tid] = (int)__hip_atomic_load(F.ctl + CW_CNT + 64 * L + F.tid, __ATOMIC_RELAXED, __HIP_MEMORY_SCOPE_AGENT);
    __syncthreads();
    if (F.tid == 0) { int s = 0; for (int e = 0; e < 32; ++e) { pst[e] = s; s += ((cnt[e] + 255) >> 8) << 8; } pst[32] = s; }
    __syncthreads();
}
template <int L> DI void phase_d1(Frame& F) {
    LAS int* pst = (LAS int*)F.lds; LAS int* cnt = pst + 40; LAS int* lh = cnt + 32; LAS int* lbase = lh + 32;
    if (F.tid < 32) lh[F.tid] = 0;
    moe_tables(F, L, pst, cnt);
    const int* EID = (const int*)(F.ws + WS_EID); int* SLOT = (int*)(F.ws + WS_SLOT); int* ROWOF = (int*)(F.ws + WS_ROWOF);
    const int TPB = (NTOK + F.G - 1) / F.G;
    const int t0 = blockIdx.x * TPB; int nt = NTOK - t0; nt = nt < 0 ? 0 : (nt > TPB ? TPB : nt);
    const int i = F.tid; const bool valid = i < 2 * nt; const int tok = t0 + (i >> 1);
    int e = 0, rank = 0;
    if (valid) { e = EID[tok * 2 + (i & 1)]; rank = __hip_atomic_fetch_add(&lh[e], 1, __ATOMIC_RELAXED, __HIP_MEMORY_SCOPE_WORKGROUP); }
    __syncthreads();
    if (F.tid < 32) lbase[F.tid] = lh[F.tid] ? (int)atomicAdd((unsigned*)(F.ctl + CW_CUR + 64 * L + F.tid), (unsigned)lh[F.tid]) : 0;
    __syncthreads();
    if (valid) { const int slot = pst[e] + lbase[e] + rank; SLOT[tok * 2 + (i & 1)] = slot; ROWOF[slot] = tok_row(tok); }
    for (int j = blockIdx.x; j < 32; j += F.G) { const int npad = (((cnt[j] + 255) >> 8) << 8) - cnt[j];
        for (int q = F.tid; q < npad; q += NTHR) ROWOF[pst[j] + cnt[j] + q] = 32832; }
}

template <int L> DI void phase_t2(Frame& F) {
    LAS float* wl = (LAS float*)F.lds;
#ifndef T2_NOCONV
    if (L == 0) { convert_weights<1>(F); __syncthreads(); }
#endif
    if (L == 0) { stage_cols<16, 1028>(F.in[17], 3088, 3072, wl, F.tid); __syncthreads(); }
    const float* lg = F.in[L ? 31 : 15]; const float* lb = F.in[L ? 32 : 16];
    const bf16* Y2 = (const bf16*)(F.ws + WS_XB); bf16* HB = (bf16*)(F.ws + WS_HB); float* GLR = (float*)(F.ws + WS_GLR);
    const int* SLOT = (const int*)(F.ws + WS_SLOT); const float* EW = (const float*)(F.ws + WS_EW);
    const int gw = F.vcu * NWAVES + F.wave, NGW = F.G * NWAVES;
    const int ntok = L ? NMAIN : NTOK;
#pragma unroll 1
    for (int tok = gw; tok < ntok; tok += NGW) {
        const int row = tok_row(tok);
        const int s0 = SLOT[tok * 2], s1 = SLOT[tok * 2 + 1]; const float w0 = EW[tok * 2], w1 = EW[tok * 2 + 1];
        f32x4 v[4];
#pragma unroll
        for (int j = 0; j < 4; ++j) { const v2u hw = *(const v2u*)(HB + (size_t)row * D + 256 * j + 4 * F.lane);
            const v2u ya = *(const v2u*)(Y2 + (size_t)s0 * D + 256 * j + 4 * F.lane), yb = *(const v2u*)(Y2 + (size_t)s1 * D + 256 * j + 4 * F.lane);
            v[j].x = ALPHA * bflo(hw.x) + (w0 * bflo(ya.x) + w1 * bflo(yb.x)); v[j].y = ALPHA * bfhi(hw.x) + (w0 * bfhi(ya.x) + w1 * bfhi(yb.x));
            v[j].z = ALPHA * bflo(hw.y) + (w0 * bflo(ya.y) + w1 * bflo(yb.y)); v[j].w = ALPHA * bfhi(hw.y) + (w0 * bfhi(ya.y) + w1 * bfhi(yb.y)); }
        ln_row(v, lg, lb, F.lane);
        if (L == 1) {
#pragma unroll
            for (int j = 0; j < 4; ++j) *(f32x4*)(F.out + (size_t)tok * D + 256 * j + 4 * F.lane) = v[j]; }
        if (L == 0) {
            store_row_bf16(HB + (size_t)row * D, v, F.lane);
            const float r = row_dots<16, 1028>(v, wl, F.lane);
            if ((F.lane & 3) == 0) GLR[(size_t)row * 16 + (F.lane >> 2)] = r;
        }
    }
}

DI void unit_decode(int u, int& b, int& c, int& h, int& row0) { h = u & 3; const int bc = u >> 2; b = bc / NCHUNK; c = bc - b * NCHUNK; row0 = c == 0 ? CH0ROW : b * SEQ + (c - 1) * 64; }
DI int prev_last_row(int c, int row0) { return c == 1 ? METAROW + NMETA - 1 : row0 - 1; }
DI int main_unit(int i) { return i + 4 + (i >= 1024 ? 4 : 0); }
DI float fexp(float x) { return __builtin_amdgcn_exp2f(x * 1.44269504089f); }
DI float flogsig(float z) { return fminf(z, 0.f) - __builtin_amdgcn_logf(1.f + fexp(-fabsf(z))) * 0.69314718056f; }
DI float frcp(float x) { return __builtin_amdgcn_rcpf(x); }
DI float wscan_add(float x, int lane) {
#pragma unroll
    for (int off = 1; off < 64; off <<= 1) { const float y = __shfl_up(x, off); if (lane >= off) x += y; }
    return x;
}
DI float wscan_max(float x, int lane) {
#pragma unroll
    for (int off = 1; off < 64; off <<= 1) { const float y = __shfl_up(x, off); if (lane >= off) x = fmaxf(x, y); }
    return x;
}
constexpr int LD_QS = 136, LD_VT = 72;
constexpr int L_QS = 0, L_KS = 17408, L_VT = 34816, L_PS = 71680, L_WG = 80896, L_BG = 113664, L_SC = 116736, L_KT = 0;
static_assert(L_SC + 8192 <= TAB_OFF, "chunk lds map");

DI void mlstm_scalars(Frame& F, int c, int h, int row0, int lane, float& a, float& M, float& mt, float& Mprev) {
    if (c != 0) { const size_t row = row0 + lane; a = ((const float*)(F.ws + WS_A))[row * 4 + h]; M = ((const float*)(F.ws + WS_MX))[row * 4 + h]; mt = ((const float*)(F.ws + WS_MT))[row * 4 + h];
        Mprev = ((const float*)(F.ws + WS_MX))[(size_t)prev_last_row(c, row0) * 4 + h]; }
    else { const float* GATES = (const float*)(F.ws + WS_GATES); const bool real = lane >= 48; const size_t row = row0 + lane;
        const float li = real ? GATES[row * 8 + h] : NEGBIG, lf = real ? logsig(GATES[row * 8 + 4 + h]) : 0.f;
        const float B = wscan_add(lf, lane); a = real ? li - B : NEGBIG; M = fmaxf(wscan_max(a, lane), 0.f); mt = B + M; Mprev = 0.f; }
}
DI void gla_bc(float (&bc)[16], const f32x4 (&gl)[4], const LAS float* WG, const LAS float* BG, int h, int w, int lane, bool ch0) {
    f32x4 z[4];
#pragma unroll
    for (int q = 0; q < 4; ++q) z[q] = *(const LAS f32x4*)(BG + h * 128 + 16 * w + 4 * q);
#pragma unroll
    for (int r = 0; r < 16; ++r) { const float gv = gl[r >> 2][r & 3];
#pragma unroll
        for (int q = 0; q < 4; ++q) z[q] += gv * *(const LAS f32x4*)(WG + r * 512 + h * 128 + 16 * w + 4 * q);
        if (r & 1) asm volatile("" : "+v"(z[0]), "+v"(z[1]), "+v"(z[2]), "+v"(z[3]) :: "memory"); }
    const bool dead = ch0 && lane < 48;
#pragma unroll
    for (int j = 0; j < 16; ++j) { const float la = dead ? 0.f : flogsig(z[j >> 2][j & 3]) * (1.f / 16.f); bc[j] = wscan_add(la, lane); }
}
template <int MIX> DI void chunk_phase_setup(Frame& F) {
    if (MIX == 1) { LAS float* WG = (LAS float*)(F.lds + L_WG); LAS float* BG = (LAS float*)(F.lds + L_BG); const float* wgu = F.in[18]; const float* bgate = F.in[19];
#pragma unroll 4
        for (int i = F.tid; i < 16 * 512; i += NTHR) WG[i] = wgu[i];
        BG[F.tid] = bgate[F.tid]; }
}

template <int MIX> DI void aprime_unit(Frame& F, int u) {
    LAS bf16* KT = (LAS bf16*)(F.lds + L_KT); LAS bf16* VT = (LAS bf16*)(F.lds + L_VT); const LAS float* WG = (const LAS float*)(F.lds + L_WG); const LAS float* BG = (const LAS float*)(F.lds + L_BG);
    const bf16* Kp = (const bf16*)(F.ws + WS_K); const bf16* Vp = (const bf16*)(F.ws + WS_V); bf16* ST = (bf16*)(F.ws + WS_ST);
    float* GDEC = (float*)(F.ws + WS_GDEC); float* DN = (float*)(F.ws + WS_DN); const float* GLR = (const float*)(F.ws + WS_GLR);
    const int s = F.lane, w = F.wave, r = s & 15, g = s >> 4;
    int b, c, h, row0; unit_decode(u, b, c, h, row0);
    const v4u* ksrc = (const v4u*)(Kp + (size_t)(row0 + s) * 512 + h * 128 + 16 * w); const v4u kx0 = ksrc[0], kx1 = ksrc[1];
    const v4u* vsrc = (const v4u*)(Vp + (size_t)(row0 + s) * 1024 + h * 256 + 32 * w);
    v4u vx[4];
#pragma unroll
    for (int j = 0; j < 4; ++j) vx[j] = vsrc[j];
    float a = 0.f, M = 0.f, mt = 0.f, Mprev = 0.f; f32x4 gl[4];
    if (MIX == 0) mlstm_scalars(F, c, h, row0, s, a, M, mt, Mprev);
    else {
#pragma unroll
        for (int q = 0; q < 4; ++q) gl[q] = *(const f32x4*)(GLR + (size_t)(row0 + s) * 16 + 4 * q); }
    __syncthreads();
    float kv[16];
    { const unsigned wv[8] = {kx0.x, kx0.y, kx0.z, kx0.w, kx1.x, kx1.y, kx1.z, kx1.w};
#pragma unroll
      for (int q = 0; q < 8; ++q) { kv[2 * q] = bflo(wv[q]); kv[2 * q + 1] = bfhi(wv[q]); } }
    float vscale = 1.f;
    if (MIX == 0) {
        const float Mend = __shfl(M, 63), ws = fexp(a - Mend); vscale = ws;
        float p[16];
#pragma unroll
        for (int j = 0; j < 16; ++j) p[j] = ws * kv[j];
        const float dn = fold_reduce<16>(p, s);
        if ((s & 3) == 0) DN[(size_t)u * 128 + 16 * w + (s >> 2)] = dn;
        if (F.tid < 128) GDEC[(size_t)u * 128 + F.tid] = fexp(Mprev - Mend);
    } else {
        float bc[16]; gla_bc(bc, gl, WG, BG, h, w, s, c == 0);
#pragma unroll
        for (int j = 0; j < 16; ++j) { const float blast = __shfl(bc[j], 63); kv[j] *= fexp(blast - bc[j]); if (s == 63) GDEC[(size_t)u * 128 + 16 * w + j] = fexp(bc[j]); }
    }
#pragma unroll
    for (int j = 0; j < 16; ++j) KT[(16 * w + j) * LD_VT + s] = (bf16)f2bf(kv[j]);
#pragma unroll
    for (int j = 0; j < 4; ++j) { const unsigned wv[4] = {vx[j].x, vx[j].y, vx[j].z, vx[j].w};
#pragma unroll
        for (int q = 0; q < 4; ++q) { const int dv = 32 * w + 8 * j + 2 * q;
            if (MIX == 0) { VT[dv * LD_VT + s] = (bf16)f2bf(bflo(wv[q]) * vscale); VT[(dv + 1) * LD_VT + s] = (bf16)f2bf(bfhi(wv[q]) * vscale); }
            else { VT[dv * LD_VT + s] = (bf16)(wv[q] & 0xffffu); VT[(dv + 1) * LD_VT + s] = (bf16)(wv[q] >> 16); } } }
    __syncthreads();
    f32x4 acc[4][2][2];
#pragma unroll
    for (int p = 0; p < 4; ++p)
#pragma unroll
        for (int e = 0; e < 2; ++e)
#pragma unroll
            for (int nt = 0; nt < 2; ++nt) acc[p][e][nt] = (f32x4){0.f, 0.f, 0.f, 0.f};
#pragma unroll
    for (int ks = 0; ks < 2; ++ks) {
        bf16x8 y[2];
#pragma unroll
        for (int nt = 0; nt < 2; ++nt) y[nt] = *(const LAS bf16x8*)(VT + (32 * w + 16 * nt + r) * LD_VT + 32 * ks + 8 * g);
#pragma unroll
        for (int p = 0; p < 4; ++p)
#pragma unroll
            for (int e = 0; e < 2; ++e) { const bf16x8 x = *(const LAS bf16x8*)(KT + (32 * p + 8 * (r >> 2) + 4 * e + (r & 3)) * LD_VT + 32 * ks + 8 * g);
#pragma unroll
                for (int nt = 0; nt < 2; ++nt) acc[p][e][nt] = mma16(x, y[nt], acc[p][e][nt]); }
    }
    bf16* stu = ST + (size_t)u * 32768;
#pragma unroll
    for (int nt = 0; nt < 2; ++nt) { const int dv = 32 * w + 16 * nt + r;
#pragma unroll
        for (int p = 0; p < 4; ++p) { v4u o; o.x = pk2(acc[p][0][nt].x, acc[p][0][nt].y); o.y = pk2(acc[p][0][nt].z, acc[p][0][nt].w); o.z = pk2(acc[p][1][nt].x, acc[p][1][nt].y); o.w = pk2(acc[p][1][nt].z, acc[p][1][nt].w);
            *(v4u*)(stu + dv * 128 + 32 * p + 8 * g) = o; } }
}
template <int MIX> DI void phase_aprime(Frame& F) {
    chunk_phase_setup<MIX>(F);
    for (int i = blockIdx.x; i < 2048; i += F.G) aprime_unit<MIX>(F, main_unit(i));
}

template <int MIX> DI void phase_scan(Frame& F) {
    unsigned* ST = (unsigned*)(F.ws + WS_ST); const float* GDEC = (const float*)(F.ws + WS_GDEC); float* DN = (float*)(F.ws + WS_DN);
    for (int gid = blockIdx.x * NTHR + F.tid; gid < 8 * 16384; gid += F.G * NTHR) {
        const int bh = gid >> 14, e2 = gid & 16383, b = bh >> 2, h = bh & 3, d = (2 * e2) & 127;
        float s0 = 0.f, s1 = 0.f;
        size_t ub = (size_t)(b * NCHUNK) * 4 + h;
        int c = 0;
#pragma unroll 1
        for (; c + 8 <= NCHUNK; c += 8) {
            unsigned x[8]; float g0[8], g1[8];
#pragma unroll
            for (int j = 0; j < 8; ++j) { const size_t u = ub + (size_t)(c + j) * 4; x[j] = ST[u * 16384 + e2]; const float2 gg = *(const float2*)(GDEC + u * 128 + d); g0[j] = gg.x; g1[j] = gg.y; }
#pragma unroll
            for (int j = 0; j < 8; ++j) { const size_t u = ub + (size_t)(c + j) * 4; ST[u * 16384 + e2] = pk2(s0, s1); s0 = g0[j] * s0 + bflo(x[j]); s1 = g1[j] * s1 + bfhi(x[j]); }
        }
        for (; c < NCHUNK; ++c) { const size_t u = ub + (size_t)c * 4; const unsigned x = ST[u * 16384 + e2]; const float2 gg = *(const float2*)(GDEC + u * 128 + d);
            ST[u * 16384 + e2] = pk2(s0, s1); s0 = gg.x * s0 + bflo(x); s1 = gg.y * s1 + bfhi(x); }
    }
    if (MIX == 0) {
        const int gid = blockIdx.x * NTHR + F.tid;
        if (gid < 1024) { const int bh = gid >> 7, d = gid & 127, b = bh >> 2, h = bh & 3; float s = 0.f;
            for (int c = 0; c < NCHUNK; ++c) { const size_t u = (size_t)(b * NCHUNK + c) * 4 + h; const float x = DN[u * 128 + d], gg = GDEC[u * 128 + d]; DN[u * 128 + d] = s; s = gg * s + x; } }
    }
}

template <int MIX> DI void cprime_unit(Frame& F, int u) {
    LAS bf16* QS = (LAS bf16*)(F.lds + L_QS); LAS bf16* KS = (LAS bf16*)(F.lds + L_KS); LAS bf16* VT = (LAS bf16*)(F.lds + L_VT); LAS bf16* PS = (LAS bf16*)(F.lds + L_PS);
    const LAS float* WG = (const LAS float*)(F.lds + L_WG); const LAS float* BG = (const LAS float*)(F.lds + L_BG); LAS float* SC = (LAS float*)(F.lds + L_SC);
    LAS float* sa = SC, *sM = SC + 64, *smt = SC + 128, *sf = SC + 192, *red = SC + 256;
    const bf16* Qp = (const bf16*)(F.ws + WS_Q); const bf16* Kp = (const bf16*)(F.ws + WS_K); const bf16* Vp = (const bf16*)(F.ws + WS_V); const bf16* Op = (const bf16*)(F.ws + WS_O); bf16* Mo = (bf16*)(F.ws + WS_O);
    const bf16* ST = (const bf16*)(F.ws + WS_ST); const float* NH = (const float*)(F.ws + WS_DN); const float* GLR = (const float*)(F.ws + WS_GLR);
    const float* hnw = F.in[MIX ? 20 : 4];
    const int t = F.lane, w = F.wave, r = t & 15, g = t >> 4;
    int b, c, h, row0; unit_decode(u, b, c, h, row0);
    const v4u* qsrc = (const v4u*)(Qp + (size_t)(row0 + t) * 512 + h * 128 + 16 * w); const v4u* ksrc = (const v4u*)(Kp + (size_t)(row0 + t) * 512 + h * 128 + 16 * w);
    v4u q0 = qsrc[0], q1 = qsrc[1], k0 = ksrc[0], k1 = ksrc[1];
    const v4u* vsrc = (const v4u*)(Vp + (size_t)(row0 + t) * 1024 + h * 256 + 32 * w);
    v4u vx[4];
#pragma unroll
    for (int j = 0; j < 4; ++j) vx[j] = vsrc[j];
    const bf16* stu = ST + (size_t)u * 32768;
    bf16x8 sx[4][2];
#pragma unroll
    for (int ks = 0; ks < 4; ++ks)
#pragma unroll
        for (int nt = 0; nt < 2; ++nt) { if (c != 0) sx[ks][nt] = *(const bf16x8*)(stu + (32 * w + 16 * nt + r) * 128 + 32 * ks + 8 * g); else sx[ks][nt] = (bf16x8){0, 0, 0, 0, 0, 0, 0, 0}; }
    v2u gwv[4][2];
#pragma unroll
    for (int mt = 0; mt < 4; ++mt)
#pragma unroll
        for (int nt = 0; nt < 2; ++nt) gwv[mt][nt] = *(const v2u*)(Op + (size_t)(row0 + 16 * mt + r) * 1024 + h * 256 + 32 * w + 16 * nt + 4 * g);
    float a = 0.f, M = 0.f, mtv = 0.f, Mprev = 0.f; f32x4 gl[4]; bf16x8 nx[4];
    if (MIX == 0) {
        mlstm_scalars(F, c, h, row0, t, a, M, mtv, Mprev);
#pragma unroll
        for (int ks = 0; ks < 4; ++ks) { nx[ks] = (bf16x8){0, 0, 0, 0, 0, 0, 0, 0};
            if (r == 0 && c != 0) { const f32x4 n0 = *(const f32x4*)(NH + (size_t)u * 128 + 32 * ks + 8 * g), n1 = *(const f32x4*)(NH + (size_t)u * 128 + 32 * ks + 8 * g + 4);
                v4u pw; pw.x = pk2(n0.x, n0.y); pw.y = pk2(n0.z, n0.w); pw.z = pk2(n1.x, n1.y); pw.w = pk2(n1.z, n1.w); nx[ks] = __builtin_bit_cast(bf16x8, pw); } }
    } else {
#pragma unroll
        for (int q = 0; q < 4; ++q) gl[q] = *(const f32x4*)(GLR + (size_t)(row0 + t) * 16 + 4 * q); }
    __syncthreads();
    if (MIX == 0) { if (w == 0) { sa[t] = a; sM[t] = M; smt[t] = mtv; sf[t] = fexp(Mprev - M); } }
    else {
        float bc[16]; gla_bc(bc, gl, WG, BG, h, w, t, c == 0);
        unsigned qw[8] = {q0.x, q0.y, q0.z, q0.w, q1.x, q1.y, q1.z, q1.w}, kw[8] = {k0.x, k0.y, k0.z, k0.w, k1.x, k1.y, k1.z, k1.w};
#pragma unroll
        for (int j = 0; j < 8; ++j) { const float b0 = bc[2 * j], b1 = bc[2 * j + 1];
            qw[j] = pk2(bflo(qw[j]) * fexp(b0), bfhi(qw[j]) * fexp(b1)); kw[j] = pk2(bflo(kw[j]) * fexp(-b0), bfhi(kw[j]) * fexp(-b1)); }
        q0 = (v4u){qw[0], qw[1], qw[2], qw[3]}; q1 = (v4u){qw[4], qw[5], qw[6], qw[7]}; k0 = (v4u){kw[0], kw[1], kw[2], kw[3]}; k1 = (v4u){kw[4], kw[5], kw[6], kw[7]};
    }
    *(LAS v4u*)(QS + t * LD_QS + 16 * w) = q0; *(LAS v4u*)(QS + t * LD_QS + 16 * w + 8) = q1;
    *(LAS v4u*)(KS + t * LD_QS + 16 * w) = k0; *(LAS v4u*)(KS + t * LD_QS + 16 * w + 8) = k1;
#pragma unroll
    for (int j = 0; j < 4; ++j) { const unsigned wv[4] = {vx[j].x, vx[j].y, vx[j].z, vx[j].w};
#pragma unroll
        for (int q = 0; q < 4; ++q) { const int dv = 32 * w + 8 * j + 2 * q; VT[dv * LD_VT + t] = (bf16)(wv[q] & 0xffffu); VT[(dv + 1) * LD_VT + t] = (bf16)(wv[q] >> 16); } }
    __syncthreads();
    { const int st = w >> 1;
#pragma unroll
      for (int tti = 0; tti < 2; ++tti) { const int tt = 2 * (w & 1) + tti; f32x4 acc = (f32x4){0.f, 0.f, 0.f, 0.f};
          if (st <= tt) {
#pragma unroll
              for (int ks = 0; ks < 4; ++ks) { const bf16x8 x = *(const LAS bf16x8*)(KS + (16 * st + r) * LD_QS + 32 * ks + 8 * g), y = *(const LAS bf16x8*)(QS + (16 * tt + r) * LD_QS + 32 * ks + 8 * g); acc = mma16(x, y, acc); } }
          const int tq = 16 * tt + r, s0 = 16 * st + 4 * g; float p[4];
#pragma unroll
          for (int i = 0; i < 4; ++i) { float v = acc[i]; if (MIX == 0) v *= fexp(sa[s0 + i] - sM[tq]); p[i] = (s0 + i <= tq) ? v : 0.f; }
          v2u o; o.x = pk2(p[0], p[1]); o.y = pk2(p[2], p[3]); *(LAS v2u*)(PS + tq * LD_VT + s0) = o; } }
    __syncthreads();
    f32x4 hnv[2];
#pragma unroll
    for (int nt = 0; nt < 2; ++nt) hnv[nt] = *(const f32x4*)(hnw + h * 256 + 32 * w + 16 * nt + 4 * g);
    f32x4 acc1[2][4], acc2[2][4], accd1[4], accd2[4];
#pragma unroll
    for (int mt = 0; mt < 4; ++mt) { accd1[mt] = (f32x4){0.f, 0.f, 0.f, 0.f}; accd2[mt] = (f32x4){0.f, 0.f, 0.f, 0.f};
#pragma unroll
        for (int nt = 0; nt < 2; ++nt) { acc1[nt][mt] = (f32x4){0.f, 0.f, 0.f, 0.f}; acc2[nt][mt] = (f32x4){0.f, 0.f, 0.f, 0.f}; } }
    const short one = r == 0 ? (short)0x3F80 : (short)0;
    const bf16x8 ones = (bf16x8){one, one, one, one, one, one, one, one};
#pragma unroll
    for (int ks = 0; ks < 4; ++ks) {
        bf16x8 y[4];
#pragma unroll
        for (int mt = 0; mt < 4; ++mt) y[mt] = *(const LAS bf16x8*)(QS + (16 * mt + r) * LD_QS + 32 * ks + 8 * g);
#pragma unroll
        for (int mt = 0; mt < 4; ++mt) {
#pragma unroll
            for (int nt = 0; nt < 2; ++nt) acc2[nt][mt] = mma16(sx[ks][nt], y[mt], acc2[nt][mt]);
            if (MIX == 0) accd2[mt] = mma16(nx[ks], y[mt], accd2[mt]); }
    }
#pragma unroll
    for (int ks = 0; ks < 2; ++ks) {
        bf16x8 x[2], y[4];
#pragma unroll
        for (int nt = 0; nt < 2; ++nt) x[nt] = *(const LAS bf16x8*)(VT + (32 * w + 16 * nt + r) * LD_VT + 32 * ks + 8 * g);
#pragma unroll
        for (int mt = 0; mt < 4; ++mt) y[mt] = *(const LAS bf16x8*)(PS + (16 * mt + r) * LD_VT + 32 * ks + 8 * g);
#pragma unroll
        for (int mt = 0; mt < 4; ++mt) {
#pragma unroll
            for (int nt = 0; nt < 2; ++nt) acc1[nt][mt] = mma16(x[nt], y[mt], acc1[nt][mt]);
            if (MIX == 0) accd1[mt] = mma16(ones, y[mt], accd1[mt]); }
    }
#pragma unroll
    for (int mt = 0; mt < 4; ++mt) { const int tq = 16 * mt + r; float s1 = 0.f, s2 = 0.f, ft = 1.f, rd = 1.f;
        if (MIX == 0) { ft = sf[tq]; const float dl = accd1[mt].x + ft * accd2[mt].x; const float den = __shfl(dl, r); rd = frcp(fmaxf(fabsf(den), fexp(-smt[tq]))); }
#pragma unroll
        for (int nt = 0; nt < 2; ++nt) { f32x4 hv = (acc1[nt][mt] + acc2[nt][mt] * ft) * rd; acc1[nt][mt] = hv; s1 += (hv.x + hv.y) + (hv.z + hv.w); s2 += (hv.x * hv.x + hv.y * hv.y) + (hv.z * hv.z + hv.w * hv.w); }
        s1 += __shfl_xor(s1, 16); s1 += __shfl_xor(s1, 32); s2 += __shfl_xor(s2, 16); s2 += __shfl_xor(s2, 32);
        if (g == 0) *(LAS f32x2_t*)(red + (w * 64 + tq) * 2) = (f32x2_t){s1, s2}; }
    __syncthreads();
#pragma unroll
    for (int mt = 0; mt < 4; ++mt) { const int tq = 16 * mt + r; float s1 = 0.f, s2 = 0.f;
#pragma unroll
        for (int ww = 0; ww < 8; ++ww) { const f32x2_t pr = *(const LAS f32x2_t*)(red + (ww * 64 + tq) * 2); s1 += pr.x; s2 += pr.y; }
        float mean = 0.f, rstd;
        if (MIX == 0) { mean = s1 * (1.f / 256.f); rstd = __builtin_amdgcn_rsqf(fmaxf(s2 * (1.f / 256.f) - mean * mean, 0.f) + LN_EPS); }
        else rstd = __builtin_amdgcn_rsqf(s2 * (1.f / 256.f) + LN_EPS);
#pragma unroll
        for (int nt = 0; nt < 2; ++nt) { const int dv = 32 * w + 16 * nt + 4 * g; const size_t oi = (size_t)(row0 + tq) * 1024 + h * 256 + dv;
            const v2u gw = gwv[mt][nt]; const f32x4 hn = hnv[nt]; const f32x4 hv = acc1[nt][mt];
            const float gi[4] = {bflo(gw.x), bfhi(gw.x), bflo(gw.y), bfhi(gw.y)}; float o[4];
#pragma unroll
            for (int i = 0; i < 4; ++i) { const float sg = frcp(1.f + fexp(-gi[i])); o[i] = (hv[i] - mean) * rstd * hn[i] * (MIX == 0 ? sg : gi[i] * sg); }
            v2u ow; ow.x = pk2(o[0], o[1]); ow.y = pk2(o[2], o[3]); *(v2u*)(Mo + oi) = ow; } }
}
template <int MIX> DI void phase_cprime(Frame& F) {
    chunk_phase_setup<MIX>(F);
    for (int i = blockIdx.x; i < 2048; i += F.G) cprime_unit<MIX>(F, main_unit(i));
}
template <int MIX> DI void phase_chunk0(Frame& F) {
    const int bid = blockIdx.x;
    if (bid >= 8 && bid < 20) { chunk_phase_setup<MIX>(F);
        if (bid < 16) { const int k = bid - 8; aprime_unit<MIX>(F, k < 4 ? k : 1028 + (k - 4)); }
        else cprime_unit<MIX>(F, bid - 16); }
}

struct EpiProj {
    static constexpr bool PERM = true, AFTER_DRAIN = false;
    bf16 *Q, *K, *V, *O;
    DI void operator()(const f32x4 (&acc)[2][2][4][2], const pg8::Unit& u, int wr, int wc, int fr, int fq) const {
        bf16* base; int ld, colt; float sc = 1.f; const int pn = u.pn;
        if (pn < 2) { base = Q; ld = 512; colt = pn * 256; sc = QSCALE; } else if (pn < 4) { base = K; ld = 512; colt = (pn - 2) * 256; }
        else if (pn < 8) { base = V; ld = 1024; colt = (pn - 4) * 256; } else { base = O; ld = 1024; colt = (pn - 8) * 256; }
        const int row0 = u.pm * 256 + wr * 64 + fr, col0 = colt + wc * 32 + 8 * fq;
#pragma unroll
        for (int ai = 0; ai < 2; ++ai)
#pragma unroll
            for (int m = 0; m < 4; ++m) { bf16* rowp = base + (size_t)(row0 + ai * 128 + m * 16) * ld + col0;
#pragma unroll
                for (int bj = 0; bj < 2; ++bj) { const f32x4 v0 = acc[ai][bj][m][0] * sc, v1 = acc[ai][bj][m][1] * sc;
                    v4u w; w.x = pk2(v0[0], v0[1]); w.y = pk2(v0[2], v0[3]); w.z = pk2(v1[0], v1[1]); w.w = pk2(v1[2], v1[3]);
                    *(v4u*)(rowp + bj * 128) = w; } }
    }
};
struct EpiPlain {
    static constexpr bool PERM = true, AFTER_DRAIN = false;
    bf16* O;
    DI void operator()(const f32x4 (&acc)[2][2][4][2], const pg8::Unit& u, int wr, int wc, int fr, int fq) const {
        const int row0 = u.pm * 256 + wr * 64 + fr, col0 = (u.pn & 3) * 256 + wc * 32 + 8 * fq;
#pragma unroll
        for (int ai = 0; ai < 2; ++ai)
#pragma unroll
            for (int m = 0; m < 4; ++m) { bf16* rowp = O + (size_t)(row0 + ai * 128 + m * 16) * 1024 + col0;
#pragma unroll
                for (int bj = 0; bj < 2; ++bj) { const f32x4 v0 = acc[ai][bj][m][0], v1 = acc[ai][bj][m][1];
                    v4u w; w.x = pk2(v0[0], v0[1]); w.y = pk2(v0[2], v0[3]); w.z = pk2(v1[0], v1[1]); w.w = pk2(v1[2], v1[3]);
                    *(v4u*)(rowp + bj * 128) = w; } }
    }
};
struct EpiGU {
    static constexpr bool PERM = true, AFTER_DRAIN = false;
    bf16* Hd;
    DI void operator()(const f32x4 (&acc)[2][2][4][2], const pg8::Unit& u, int wr, int wc, int fr, int fq) const {
        const int row0 = u.pm * 256 + wr * 64 + fr, col0 = (u.pn & 3) * 128 + wc * 32 + 8 * fq;
#pragma unroll
        for (int ai = 0; ai < 2; ++ai)
#pragma unroll
            for (int m = 0; m < 4; ++m) { float o[8];
#pragma unroll
                for (int n = 0; n < 2; ++n)
#pragma unroll
                    for (int i = 0; i < 4; ++i) { const float gte = acc[ai][0][m][n][i], up = acc[ai][1][m][n][i]; o[4 * n + i] = gte * __builtin_amdgcn_rcpf(1.f + __expf(-gte)) * up; }
                v4u w; w.x = pk2(o[0], o[1]); w.y = pk2(o[2], o[3]); w.z = pk2(o[4], o[5]); w.w = pk2(o[6], o[7]);
                *(v4u*)(Hd + (size_t)(row0 + ai * 128 + m * 16) * 512 + col0) = w; }
    }
};
template <bool GA> struct MoeOrder {
    static constexpr bool GATHER = GA;
    const LAS int* tile_e; const LAS int* rowtab; int nunits, G, c;
    DI bool next(int i, pg8::Unit& u) const { const int L = i * G + c; if (L >= nunits) return false; const int t = L >> 2; const int e = __builtin_amdgcn_readfirstlane(tile_e[t]); u.pm = t; u.pn = e * 4 + (L & 3); return true; }
    DI unsigned rowoff(int i, int rin) const { return (unsigned)rowtab[i * 256 + rin] * 2048u; }
    DI void a_ready(const pg8::Unit&) const {}
    DI void done(const pg8::Unit&) const {}
};
template <bool GA> DI int moe_order_setup(Frame& F, int L) {
    LAS int* pst = (LAS int*)(F.lds + TAB_OFF); LAS int* cnt = pst + 40; LAS int* tile_e = pst + 128; LAS int* rowtab = pst + 512;
    moe_tables(F, L, pst, cnt);
    const int ntiles = pst[32] >> 8;
    for (int t = F.tid; t < ntiles; t += NTHR) { int e = 0;
        for (int q = 1; q < 32; ++q) if (pst[q] <= t * 256) e = q;
        tile_e[t] = e; }
    if (GA) { const int* ROWOF = (const int*)(F.ws + WS_ROWOF);
        for (int i = 0; i < 8; ++i) { const int Lu = i * F.G + F.vcu; if (Lu >= ntiles * 4) break; if (F.tid < 256) rowtab[i * 256 + F.tid] = ROWOF[(Lu >> 2) * 256 + F.tid]; } }
    __syncthreads();
    return ntiles;
}
DI f32x4 small_tile16(const bf16* A16  , const bf16* Bt  , int n0, int lane) {
    const int r = lane & 15, g = lane >> 4;
    const bf16* xp = Bt + (size_t)(n0 + r) * 1024 + 8 * g; const bf16* yp = A16 + (size_t)r * 1024 + 8 * g;
    f32x4 acc = (f32x4){0.f, 0.f, 0.f, 0.f};
#pragma unroll 1
    for (int kb = 0; kb < 4; ++kb) {
        bf16x8 x[8], y[8];
#pragma unroll
        for (int j = 0; j < 8; ++j) { x[j] = *(const bf16x8*)(xp + (kb * 8 + j) * 32); y[j] = *(const bf16x8*)(yp + (kb * 8 + j) * 32); }
#pragma unroll
        for (int j = 0; j < 8; ++j) acc = mma16(x[j], y[j], acc);
    }
    return acc;
}
DI void small_g1(Frame& F) {
    const int gw = blockIdx.x * NWAVES + F.wave; if (gw >= NPROJ / 16) return;
    const int n0 = 16 * gw, r = F.lane & 15, g = F.lane >> 4;
    const f32x4 acc = small_tile16((const bf16*)(F.ws + WS_HB) + (size_t)METAROW * D, (const bf16*)(F.ws + WS_WIN), n0, F.lane);
    bf16* base; int ld, col; float sc = 1.f;
    if (n0 < 512) { base = (bf16*)(F.ws + WS_Q); ld = 512; col = n0; sc = QSCALE; } else if (n0 < 1024) { base = (bf16*)(F.ws + WS_K); ld = 512; col = n0 - 512; }
    else if (n0 < 2048) { base = (bf16*)(F.ws + WS_V); ld = 1024; col = n0 - 1024; } else { base = (bf16*)(F.ws + WS_O); ld = 1024; col = n0 - 2048; }
    v2u o; o.x = pk2(acc.x * sc, acc.y * sc); o.y = pk2(acc.z * sc, acc.w * sc);
    *(v2u*)(base + (size_t)(METAROW + r) * ld + col + 4 * g) = o;
    if (F.lane < 48) { v4u* z = (v4u*)(base + (size_t)(CH0ROW + F.lane) * ld + col); z[0] = (v4u){0u, 0u, 0u, 0u}; z[1] = (v4u){0u, 0u, 0u, 0u}; }
}
DI void small_g2(Frame& F) {
    const int gw = blockIdx.x * NWAVES + F.wave; if (gw >= D / 16) return;
    const int n0 = 16 * gw, r = F.lane & 15, g = F.lane >> 4;
    const f32x4 acc = small_tile16((const bf16*)(F.ws + WS_O) + (size_t)METAROW * D, (const bf16*)(F.ws + WS_WOUT), n0, F.lane);
    v2u o; o.x = pk2(acc.x, acc.y); o.y = pk2(acc.z, acc.w);
    *(v2u*)((bf16*)(F.ws + WS_YB) + (size_t)(METAROW + r) * D + n0 + 4 * g) = o;
}
DI void gemm_g1(Frame& F) { small_g1(F); pg8::Gemm gm{(const bf16*)(F.ws + WS_HB), (const bf16*)(F.ws + WS_WIN), NMAIN, NPROJ, D}; pg8::StaticOrder S; S.init(NMAIN, NPROJ, F.G, (int)blockIdx.x);
    EpiProj E{(bf16*)(F.ws + WS_Q), (bf16*)(F.ws + WS_K), (bf16*)(F.ws + WS_V), (bf16*)(F.ws + WS_O)};
    pg8::gemm_phase<EpiProj, pg8::StaticOrder, true, true>(F.lds, gm, S, E); }
DI void gemm_g2(Frame& F) { small_g2(F); pg8::Gemm gm{(const bf16*)(F.ws + WS_O), (const bf16*)(F.ws + WS_WOUT), NMAIN, D, D}; pg8::StaticOrder S; S.init(NMAIN, D, F.G, (int)blockIdx.x);
    EpiPlain E{(bf16*)(F.ws + WS_YB)};
    pg8::gemm_phase<EpiPlain, pg8::StaticOrder, true, true>(F.lds, gm, S, E); }
DI void gemm_g3(Frame& F, int L) { const int ntiles = moe_order_setup<true>(F, L);
    pg8::Gemm gm{(const bf16*)(F.ws + WS_HB), (const bf16*)(F.ws + WS_WGU), 0, 0, D}; MoeOrder<true> S{(const LAS int*)(F.lds + TAB_OFF) + 128, (const LAS int*)(F.lds + TAB_OFF) + 512, ntiles * 4, F.G, F.vcu};
    EpiGU E{(bf16*)(F.ws + WS_HDN)};
    pg8::gemm_phase<EpiGU, MoeOrder<true>, true, true>(F.lds, gm, S, E); }
DI void gemm_g4(Frame& F, int L) { const int ntiles = moe_order_setup<false>(F, L);
    pg8::Gemm gm{(const bf16*)(F.ws + WS_HDN), (const bf16*)(F.ws + WS_WD), 0, 0, FF}; MoeOrder<false> S{(const LAS int*)(F.lds + TAB_OFF) + 128, (const LAS int*)(F.lds + TAB_OFF) + 512, ntiles * 4, F.G, F.vcu};
    EpiPlain E{(bf16*)(F.ws + WS_XB)};
    pg8::gemm_phase<EpiPlain, MoeOrder<false>, true, true>(F.lds, gm, S, E); }

constexpr int NPHASE = 23;
#ifndef PH_MASK
#define PH_MASK 0xFFFu
#endif
#define EN(i) (((PH_MASK) >> (i)) & 1u)
#ifndef PH_REP
#define PH_REP 0u
#endif
#define REPS(i) ((((PH_REP) >> (i)) & 1u) ? 2 : 1)
template <int L> DI void layer_phases(Frame& F, const XcdBarrier& bar, int lo, int hi) {
    constexpr int P = 1 + 11 * L;
#define IN(k) (lo <= (k) && (k) < hi)
#define SEAM(k) do { if (IN(k) && IN((k) + 1)) xcd_barrier(bar); } while (0)
    if (EN(0) && IN(P + 0)) { gemm_g1(F); if (REPS(0) == 2) gemm_g1(F); }
    SEAM(P + 0);
    if (EN(1) && IN(P + 1)) { if (L == 0) { phase_s1(F); if (REPS(1) == 2) { __syncthreads(); phase_s1(F); } } phase_chunk0<L>(F); }
    SEAM(P + 1);
    if (EN(2) && IN(P + 2)) { phase_aprime<L>(F); if (REPS(2) == 2) phase_aprime<L>(F); }
    SEAM(P + 2);
    if (EN(3) && IN(P + 3)) phase_scan<L>(F);
    SEAM(P + 3);
    if (EN(4) && IN(P + 4)) phase_cprime<L>(F);
    SEAM(P + 4);
    if (EN(5) && IN(P + 5)) { gemm_g2(F); if (REPS(5) == 2) gemm_g2(F); }
    SEAM(P + 5);
    if (EN(6) && IN(P + 6)) { phase_t1<L>(F); if (REPS(6) == 2 && L == 0) { __syncthreads(); phase_t1<L>(F, false); } }
    SEAM(P + 6);
    if (EN(7) && IN(P + 7)) phase_d1<L>(F);
    SEAM(P + 7);
    if (EN(8) && IN(P + 8)) { gemm_g3(F, L); if (REPS(8) == 2) gemm_g3(F, L); }
    SEAM(P + 8);
    if (EN(9) && IN(P + 9)) { gemm_g4(F, L); if (REPS(9) == 2) gemm_g4(F, L); }
    SEAM(P + 9);
    if (EN(10) && IN(P + 10)) phase_t2<L>(F);
    if (L == 0) SEAM(P + 10);
#undef IN
#undef SEAM
}

__global__ void __launch_bounds__(NTHR, 2) hybrid_fwd(Args args) {
    extern __shared__ __attribute__((aligned(16))) unsigned char lds[];
    Frame F;
    F.lds = (LAS unsigned char*)lds;
    F.tid = threadIdx.x; F.lane = F.tid & 63; F.wave = __builtin_amdgcn_readfirstlane(F.tid >> 6);
    F.G = gridDim.x; { const int bx = blockIdx.x; F.vcu = (F.G % 8 == 0) ? (bx % 8) * (F.G / 8) + bx / 8 : bx; }
    F.in = args.in; F.out = args.out; F.ws = args.ws;
    F.ctl = (gu32*)(args.ws + WS_CTL);
    volatile LAS unsigned* MISC = (volatile LAS unsigned*)(F.lds + TOP_OFF);
    if (F.tid < 64) MISC[F.tid] = 0u;
    __syncthreads();
    const int lo = args.ph_lo, hi = args.ph_hi;
    XcdBarrier bar; bar.bar = (unsigned*)(F.ctl + CW_BAR); bar.x = 0; bar.st = nullptr;
    if (hi - lo > 1) bar = xcd_barrier_post((unsigned*)(F.ctl + CW_BAR), MISC + 8);
    if (lo <= 0 && 0 < hi) { if (EN(11)) { phase_p0(F); if (REPS(11) == 2) { __syncthreads(); phase_p0(F); } } if (hi > 1) xcd_barrier(bar); }
    layer_phases<0>(F, bar, lo, hi);
    layer_phases<1>(F, bar, lo, hi);
#ifdef PROBE_XBAR
    if (hi - lo > 1) { for (int i = 0; i < PROBE_XBAR; ++i) xcd_barrier(bar); }
#endif
}

#ifndef MK_PER_PHASE
#define MK_PER_PHASE 0
#endif
extern "C" void kernel_launch(void* const* d_in, const int* in_sizes, int n_in, void* d_out, int out_size, void* d_ws, size_t ws_size, hipStream_t stream) {
    static int grid = 0;
    if (grid == 0) {
        if (n_in != 33 || in_sizes[0] != NMAIN * D || out_size != NMAIN * D || ws_size < WS_END) { fprintf(stderr, "kernel_launch: unexpected shapes (n_in %d, in0 %d, out %d, ws %zu)\n", n_in, n_in > 0 ? in_sizes[0] : -1, out_size, ws_size); grid = -1; return; }
        if (hipFuncSetAttribute((const void*)hybrid_fwd, hipFuncAttributeMaxDynamicSharedMemorySize, LDS_BYTES) != hipSuccess) { fprintf(stderr, "kernel_launch: hipFuncSetAttribute failed\n"); grid = -1; return; }
        int dev = 0, cus = 0, per_cu = 0;
        (void)hipGetDevice(&dev); (void)hipDeviceGetAttribute(&cus, hipDeviceAttributeMultiprocessorCount, dev);
        if (hipOccupancyMaxActiveBlocksPerMultiprocessor(&per_cu, (const void*)hybrid_fwd, NTHR, LDS_BYTES) != hipSuccess || per_cu < 1) fprintf(stderr, "kernel_launch: occupancy query reports %d blocks per CU\n", per_cu);
        (void)hipGetLastError();
        grid = 256;
        if (cus < 256) { fprintf(stderr, "kernel_launch: device has %d CUs, need 256\n", cus); grid = -1; return; }
    }
    if (grid < 0) return;
    (void)hipMemsetAsync((char*)d_ws + WS_CTL, 0, CTL_ZERO_BYTES, stream);
    Args a{};
    for (int i = 0; i < 33; ++i) a.in[i] = (const float*)d_in[i];
    a.out = (float*)d_out; a.ws = (unsigned char*)d_ws;
#if MK_PER_PHASE
    for (int p = 0; p < NPHASE; ++p) { a.ph_lo = p; a.ph_hi = p + 1; hipLaunchKernelGGL(hybrid_fwd, dim3(grid), dim3(NTHR), LDS_BYTES, stream, a); }
#else
    a.ph_lo = 0; a.ph_hi = NPHASE;
    hipLaunchKernelGGL(hybrid_fwd, dim3(grid), dim3(NTHR), LDS_BYTES, stream, a);
#endif
}
```
